# Optimizing an MI355X kernel written in HIP

```python
import math
import jax, jax.numpy as jnp
from jax import lax
import numpy as np

D_MODEL = 1024
BATCH = 2
SEQ = 8192
DEPTH = 2

RMS_EPS = 1e-6
CHUNK = 128
A_HEADS = 4
A_HEAD_DIM = D_MODEL // 8
A_WIDTH = A_HEADS * A_HEAD_DIM
B_GROUP = 16
B_WIDTH = D_MODEL // 2
B_GROUPS = B_WIDTH // B_GROUP
B_STATE = 64
DT_MIN = 1e-3
DT_MAX = 1e-1
AB_IN = 2 * A_WIDTH + B_WIDTH
AB_OUT = A_WIDTH + B_WIDTH
C_HEADS = 8
QK_NOPE = 128
QK_ROPE = 64
V_HEAD = 128
Q_LORA = 384
KV_LORA = 256
C_IN = Q_LORA + KV_LORA + QK_ROPE
ROPE_THETA = 10000.0
Q_BLOCK = 128
D_FF = 2816
N_EXPERTS = 8
TOP_K = 2
D_FF_EXPERT = 3584
MOE_BLOCK = 128

kernel_name = "hybrid_sgu_s5_mla_moe_encoder"


def rmsnorm(x, g):
    xf = x.astype(jnp.float32)
    y = xf * lax.rsqrt(jnp.mean(xf * xf, axis=-1, keepdims=True) + RMS_EPS)
    return (y * g.astype(jnp.float32)).astype(x.dtype)


def modulate(h, shift, scale):
    return h * (1.0 + scale[:, None, :]) + shift[:, None, :]


def chunked_sgu(u, v, v_g, w_s, b_s):
    bn, seq = u.shape[:2]
    v = rmsnorm(v, v_g)
    vc = v.reshape(bn, seq // CHUNK, CHUNK, A_HEADS, A_HEAD_DIM)
    s = jnp.einsum('gqk,bnkgc->bnqgc', w_s, vc) + b_s.T[None, None, :, :, None]
    return u * s.reshape(u.shape)


def s5_scan(u, lam_re, lam_im, log_dt, b_re, b_im, c_re, c_im, reverse):
    f32 = jnp.float32
    lam_re, lam_im = lam_re.astype(f32), lam_im.astype(f32)
    dt = jnp.exp(log_dt.astype(f32))[:, None]
    mag = jnp.exp(lam_re * dt)
    ang = lam_im * dt
    abar_re, abar_im = mag * jnp.cos(ang), mag * jnp.sin(ang)
    den = lam_re * lam_re + lam_im * lam_im
    fr = ((abar_re - 1.0) * lam_re + abar_im * lam_im) / den
    fi = (abar_im * lam_re - (abar_re - 1.0) * lam_im) / den
    b_re, b_im = b_re.astype(f32), b_im.astype(f32)
    bb_re = fr[:, :, None] * b_re - fi[:, :, None] * b_im
    bb_im = fr[:, :, None] * b_im + fi[:, :, None] * b_re
    bu_re = jnp.einsum('gph,blgh->blgp', bb_re, u)
    bu_im = jnp.einsum('gph,blgh->blgp', bb_im, u)
    a_re = jnp.broadcast_to(abar_re, bu_re.shape)
    a_im = jnp.broadcast_to(abar_im, bu_im.shape)

    def combine(e1, e2):
        a1r, a1i, b1r, b1i = e1
        a2r, a2i, b2r, b2i = e2
        return (a2r * a1r - a2i * a1i,
                a2r * a1i + a2i * a1r,
                a2r * b1r - a2i * b1i + b2r,
                a2r * b1i + a2i * b1r + b2i)

    _, _, x_re, x_im = lax.associative_scan(combine, (a_re, a_im, bu_re, bu_im),
                                            reverse=reverse, axis=1)
    return (jnp.einsum('ghp,blgp->blgh', c_re.astype(f32), x_re)
            - jnp.einsum('ghp,blgp->blgh', c_im.astype(f32), x_im))


def s5_mixer(u, lam_re, lam_im, log_dt, b_re, b_im, c_re, c_im, d_skip, w_glu):
    bn, seq, _ = u.shape
    uf = u.astype(jnp.float32)
    ug = uf.reshape(bn, seq, B_GROUPS, B_GROUP)
    y = (s5_scan(ug, lam_re[0], lam_im[0], log_dt[0], b_re[0], b_im[0], c_re[0], c_im[0], False)
         + s5_scan(ug, lam_re[1], lam_im[1], log_dt[1], b_re[1], b_im[1], c_re[1], c_im[1], True))
    y = y.reshape(bn, seq, B_WIDTH) + d_skip.astype(jnp.float32) * uf
    y = jax.nn.gelu(y).astype(u.dtype)
    return y * jax.nn.sigmoid(y @ w_glu)


def ab_mixer(h, w_in, v_g, w_s, b_s, lam_re, lam_im, log_dt, b_re, b_im, c_re, c_im,
             d_skip, w_glu, w_out):
    bn, seq, _ = h.shape
    z = h @ w_in
    za = jax.nn.gelu(z[..., :2 * A_WIDTH])
    u_a = za[..., :A_WIDTH].reshape(bn, seq, A_HEADS, A_HEAD_DIM)
    v_a = za[..., A_WIDTH:].reshape(bn, seq, A_HEADS, A_HEAD_DIM)
    a_out = chunked_sgu(u_a, v_a, v_g, w_s, b_s).reshape(bn, seq, A_WIDTH)
    b_out = s5_mixer(z[..., 2 * A_WIDTH:], lam_re, lam_im, log_dt, b_re, b_im, c_re, c_im,
                     d_skip, w_glu)
    return jnp.concatenate([a_out, b_out], axis=-1) @ w_out


def rope(x, cos, sin):
    xf = x.astype(jnp.float32)
    half = xf.shape[-1] // 2
    x1, x2 = xf[..., :half], xf[..., half:]
    return jnp.concatenate([x1 * cos - x2 * sin, x1 * sin + x2 * cos], axis=-1).astype(x.dtype)


def mla_mixer(h, w_in, q_norm_g, kv_norm_g, w_uq, w_ukv, w_o):
    bn, seq, _ = h.shape
    z = h @ w_in
    cq = rmsnorm(z[..., :Q_LORA], q_norm_g)
    ckv = rmsnorm(z[..., Q_LORA:Q_LORA + KV_LORA], kv_norm_g)
    k_rope = z[..., Q_LORA + KV_LORA:]
    q = (cq @ w_uq).reshape(bn, seq, C_HEADS, QK_NOPE + QK_ROPE)
    kv = (ckv @ w_ukv).reshape(bn, seq, C_HEADS, QK_NOPE + V_HEAD)
    q_nope, q_rope = q[..., :QK_NOPE], q[..., QK_NOPE:]
    k_nope, v = kv[..., :QK_NOPE], kv[..., QK_NOPE:]

    pos = jnp.arange(seq, dtype=jnp.float32)
    inv_freq = ROPE_THETA ** (-jnp.arange(0, QK_ROPE, 2, dtype=jnp.float32) / QK_ROPE)
    ang = pos[:, None] * inv_freq[None, :]
    cos, sin = jnp.cos(ang), jnp.sin(ang)
    q_rope = rope(q_rope, cos[None, :, None, :], sin[None, :, None, :])
    k_rope = rope(k_rope, cos[None], sin[None])

    scale = 1.0 / math.sqrt(QK_NOPE + QK_ROPE)
    nb = seq // Q_BLOCK
    qn_b = q_nope.reshape(bn, nb, Q_BLOCK, C_HEADS, QK_NOPE).transpose(1, 0, 2, 3, 4)
    qr_b = q_rope.reshape(bn, nb, Q_BLOCK, C_HEADS, QK_ROPE).transpose(1, 0, 2, 3, 4)

    def attend(blk):
        qn, qr = blk
        s = (jnp.einsum('bqhd,bkhd->bhqk', qn, k_nope)
             + jnp.einsum('bqhr,bkr->bhqk', qr, k_rope))
        p = jax.nn.softmax(s.astype(jnp.float32) * scale, axis=-1).astype(v.dtype)
        return jnp.einsum('bhqk,bkhd->bqhd', p, v)

    o = lax.map(attend, (qn_b, qr_b))
    o = o.transpose(1, 0, 2, 3, 4).reshape(bn, seq, C_HEADS * V_HEAD)
    return o @ w_o


def swiglu(h, w1, w3, w2):
    return (jax.nn.silu(h @ w1) * (h @ w3)) @ w2


def moe_swiglu(h, w_router, w1, w3, w2):
    bn, seq, d = h.shape
    t = bn * seq
    xf = h.reshape(t, d)
    logits = (xf @ w_router).astype(jnp.float32)
    top_val, top_idx = lax.top_k(logits, TOP_K)
    gates = jax.nn.softmax(top_val, axis=-1)
    e_flat = top_idx.reshape(-1).astype(jnp.int32)
    tok_flat = jnp.repeat(jnp.arange(t, dtype=jnp.int32), TOP_K)
    g_flat = gates.reshape(-1)
    order = jnp.argsort(e_flat, stable=True)
    e_sorted = e_flat[order]
    counts = jax.ops.segment_sum(jnp.ones_like(e_flat), e_flat, num_segments=N_EXPERTS)
    padded = ((counts + MOE_BLOCK - 1) // MOE_BLOCK) * MOE_BLOCK
    pad_end = jnp.cumsum(padded)
    pad_start = pad_end - padded
    start = jnp.cumsum(counts) - counts
    dest = pad_start[e_sorted] + (jnp.arange(t * TOP_K, dtype=jnp.int32) - start[e_sorted])
    n_rows = t * TOP_K + N_EXPERTS * MOE_BLOCK
    row_tok = jnp.full((n_rows,), t, jnp.int32).at[dest].set(tok_flat[order])
    row_gate = jnp.zeros((n_rows,), jnp.float32).at[dest].set(g_flat[order])
    nb = n_rows // MOE_BLOCK
    blk_start = jnp.arange(nb, dtype=jnp.int32) * MOE_BLOCK
    blk_expert = jnp.minimum(jnp.searchsorted(pad_end, blk_start, side='right'), N_EXPERTS - 1)
    x_pad = jnp.concatenate([xf, jnp.zeros((1, d), xf.dtype)], axis=0)
    xr = x_pad[row_tok].reshape(nb, MOE_BLOCK, d)

    def expert_block(args):
        xb, e = args
        return swiglu(xb, w1[e], w3[e], w2[e])

    yr = lax.map(expert_block, (xr, blk_expert)).reshape(n_rows, d)
    yr = yr * row_gate[:, None].astype(yr.dtype)
    y = jax.ops.segment_sum(yr, row_tok, num_segments=t + 1)[:t]
    return y.reshape(bn, seq, d)


def setup_inputs(seed: int = 0) -> dict:
    key = jax.random.key(seed)
    ks = iter(jax.random.split(key, 40))
    f32 = jnp.float32
    n_even = (DEPTH + 1) // 2
    n_odd = DEPTH // 2
    D = D_MODEL

    def nrm(shape, scale):
        return jax.random.normal(next(ks), shape, f32) * scale

    x = nrm((BATCH, SEQ, D), 1.0)
    c = nrm((BATCH, D), 1.0)
    gate_offset = jnp.repeat(jnp.array([0., 0., 1., 0., 0., 1.], f32), D)
    ada_w = nrm((DEPTH, D, 6 * D), 0.02)
    ada_b = nrm((DEPTH, 6 * D), 0.02) + gate_offset[None]
    norm_mix_g = 1.0 + nrm((DEPTH, D), 0.05)
    norm_ffn_g = 1.0 + nrm((DEPTH, D), 0.05)
    final_g = 1.0 + nrm((D,), 0.05)

    ab_w_in = nrm((n_even, D, AB_IN), D ** -0.5)
    sgu_v_g = 1.0 + nrm((n_even, A_HEADS, A_HEAD_DIM), 0.05)
    sgu_w_s = nrm((n_even, A_HEADS, CHUNK, CHUNK), CHUNK ** -0.5)
    sgu_b_s = 1.0 + nrm((n_even, A_HEADS, CHUNK), 0.1)
    s5_lam_re = -0.5 + nrm((n_even, 2, B_GROUPS, B_STATE), 0.01)
    s5_lam_im = (math.pi * jnp.arange(B_STATE, dtype=f32))[None, None, None, :] \
        + nrm((n_even, 2, B_GROUPS, B_STATE), 0.01)
    s5_log_dt = jax.random.uniform(next(ks), (n_even, 2, B_GROUPS), f32,
                                   math.log(DT_MIN), math.log(DT_MAX))
    s5_b_re = nrm((n_even, 2, B_GROUPS, B_STATE, B_GROUP), (2 * B_GROUP) ** -0.5)
    s5_b_im = nrm((n_even, 2, B_GROUPS, B_STATE, B_GROUP), (2 * B_GROUP) ** -0.5)
    s5_c_re = nrm((n_even, 2, B_GROUPS, B_GROUP, B_STATE), 0.5)
    s5_c_im = nrm((n_even, 2, B_GROUPS, B_GROUP, B_STATE), 0.5)
    s5_d = nrm((n_even, B_WIDTH), 1.0)
    s5_w_glu = nrm((n_even, B_WIDTH, B_WIDTH), B_WIDTH ** -0.5)
    ab_w_out = nrm((n_even, AB_OUT, D), AB_OUT ** -0.5)

    ffn_w1 = nrm((n_even, D, D_FF), D ** -0.5)
    ffn_w3 = nrm((n_even, D, D_FF), D ** -0.5)
    ffn_w2 = nrm((n_even, D_FF, D), D_FF ** -0.5)

    mla_w_in = nrm((n_odd, D, C_IN), D ** -0.5)
    mla_q_norm_g = 1.0 + nrm((n_odd, Q_LORA), 0.05)
    mla_kv_norm_g = 1.0 + nrm((n_odd, KV_LORA), 0.05)
    mla_w_uq = nrm((n_odd, Q_LORA, C_HEADS * (QK_NOPE + QK_ROPE)), Q_LORA ** -0.5)
    mla_w_ukv = nrm((n_odd, KV_LORA, C_HEADS * (QK_NOPE + V_HEAD)), KV_LORA ** -0.5)
    mla_w_o = nrm((n_odd, C_HEADS * V_HEAD, D), (C_HEADS * V_HEAD) ** -0.5)

    moe_w_router = nrm((n_odd, D, N_EXPERTS), D ** -0.5)
    moe_w1 = nrm((n_odd, N_EXPERTS, D, D_FF_EXPERT), D ** -0.5)
    moe_w3 = nrm((n_odd, N_EXPERTS, D, D_FF_EXPERT), D ** -0.5)
    moe_w2 = nrm((n_odd, N_EXPERTS, D_FF_EXPERT, D), D_FF_EXPERT ** -0.5)

    return {"x": x, "c": c, "ada_w": ada_w, "ada_b": ada_b,
            "norm_mix_g": norm_mix_g, "norm_ffn_g": norm_ffn_g, "final_g": final_g,
            "ab_w_in": ab_w_in, "sgu_v_g": sgu_v_g, "sgu_w_s": sgu_w_s, "sgu_b_s": sgu_b_s,
            "s5_lam_re": s5_lam_re, "s5_lam_im": s5_lam_im, "s5_log_dt": s5_log_dt,
            "s5_b_re": s5_b_re, "s5_b_im": s5_b_im, "s5_c_re": s5_c_re, "s5_c_im": s5_c_im,
            "s5_d": s5_d, "s5_w_glu": s5_w_glu, "ab_w_out": ab_w_out,
            "ffn_w1": ffn_w1, "ffn_w3": ffn_w3, "ffn_w2": ffn_w2,
            "mla_w_in": mla_w_in, "mla_q_norm_g": mla_q_norm_g, "mla_kv_norm_g": mla_kv_norm_g,
            "mla_w_uq": mla_w_uq, "mla_w_ukv": mla_w_ukv, "mla_w_o": mla_w_o,
            "moe_w_router": moe_w_router, "moe_w1": moe_w1, "moe_w3": moe_w3, "moe_w2": moe_w2}


def reference(x, c, ada_w, ada_b, norm_mix_g, norm_ffn_g, final_g,
              ab_w_in, sgu_v_g, sgu_w_s, sgu_b_s,
              s5_lam_re, s5_lam_im, s5_log_dt, s5_b_re, s5_b_im, s5_c_re, s5_c_im,
              s5_d, s5_w_glu, ab_w_out,
              ffn_w1, ffn_w3, ffn_w2,
              mla_w_in, mla_q_norm_g, mla_kv_norm_g, mla_w_uq, mla_w_ukv, mla_w_o,
              moe_w_router, moe_w1, moe_w3, moe_w2):
    c_act = jax.nn.silu(c)
    for layer in range(DEPTH):
        i = layer // 2
        mod = c_act @ ada_w[layer] + ada_b[layer]
        sh_m, sc_m, g_m, sh_f, sc_f, g_f = jnp.split(mod, 6, axis=-1)

        h = modulate(rmsnorm(x, norm_mix_g[layer]), sh_m, sc_m)
        if layer % 2 == 0:
            y = ab_mixer(h, ab_w_in[i], sgu_v_g[i], sgu_w_s[i], sgu_b_s[i],
                         s5_lam_re[i], s5_lam_im[i], s5_log_dt[i], s5_b_re[i], s5_b_im[i],
                         s5_c_re[i], s5_c_im[i], s5_d[i], s5_w_glu[i], ab_w_out[i])
        else:
            y = mla_mixer(h, mla_w_in[i], mla_q_norm_g[i], mla_kv_norm_g[i],
                          mla_w_uq[i], mla_w_ukv[i], mla_w_o[i])
        x = x + g_m[:, None, :] * y

        h = modulate(rmsnorm(x, norm_ffn_g[layer]), sh_f, sc_f)
        if layer % 2 == 0:
            y = swiglu(h, ffn_w1[i], ffn_w3[i], ffn_w2[i])
        else:
            y = moe_swiglu(h, moe_w_router[i], moe_w1[i], moe_w3[i], moe_w2[i])
        x = x + g_f[:, None, :] * y
    return rmsnorm(x, final_g)
```

```cpp
#include <hip/hip_runtime.h>
#include <hip/hip_cooperative_groups.h>
#include <cstdio>
#include <cstdint>
namespace cg = cooperative_groups;

#ifndef MK_ONE_LAUNCH
#define MK_ONE_LAUNCH 0
#endif
#ifndef FAST_GEMM
#define FAST_GEMM 0
#endif
#ifndef FAST_ATTN
#define FAST_ATTN 0
#endif

#define LAS __attribute__((address_space(3)))
typedef unsigned short bf16_t;
typedef short bf16x8 __attribute__((ext_vector_type(8)));
typedef float f32x4 __attribute__((ext_vector_type(4)));
typedef float f32x2 __attribute__((ext_vector_type(2)));
typedef unsigned u32x4 __attribute__((ext_vector_type(4)));
typedef unsigned u32x2 __attribute__((ext_vector_type(2)));

constexpr int D = 1024, SEQ = 8192, NBATCH = 2, T = NBATCH * SEQ;
constexpr int A_W = 512, B_W = 512, AB_IN = 1536;
constexpr int D_FF = 2816, NEXP = 8, D_FFE = 3584;
constexpr int QL = 384, KVL = 256, CIN = 704, CINP = 768, NH = 8, DQK = 192, DV = 128;
constexpr float RMS_EPS = 1e-6f;
constexpr int NTHREADS = 512, NWAVES = 8;
constexpr int RT_MAX = 34816;
constexpr float QSCALE = 0.07216878364870323f * 1.4426950408889634f;

constexpr size_t MiB = 1u << 20;
constexpr size_t WS_CTL = 0, CTL_BYTES = 64 * 1024;
constexpr size_t WS_MOD = 1 * MiB;
constexpr size_t WS_TOKINFO = 1 * MiB + 256 * 1024;
constexpr size_t WS_LIST = 2 * MiB;
constexpr size_t WS_MW13 = 4 * MiB;
constexpr size_t WS_MW2 = 116 * MiB;
constexpr size_t WS_XG = 172 * MiB;
constexpr size_t WS_O = 172 * MiB;
constexpr size_t WS_V = 204 * MiB;
constexpr size_t WS_HM = 240 * MiB;
constexpr size_t WS_WIN = 240 * MiB, WS_WGLU = 243 * MiB, WS_WOUT = 244 * MiB, WS_W13 = 246 * MiB, WS_W2 = 257 * MiB;
constexpr size_t WS_WMIN = 263 * MiB, WS_WUQ = 265 * MiB, WS_WUKV = 267 * MiB, WS_WO = 268 * MiB;
constexpr size_t WS_GTA = 270 * MiB, WS_BTC = 274 * MiB, WS_ROPE = 282 * MiB, WS_A16 = 284 * MiB;
constexpr size_t WS_H = 285 * MiB;
constexpr size_t WS_UA = 317 * MiB, WS_VA = 333 * MiB, WS_AC = 349 * MiB, WS_SS = 381 * MiB, WS_YG = 413 * MiB, WS_CAT = 429 * MiB;
constexpr size_t WS_HF = 317 * MiB;
constexpr size_t WS_Z = 317 * MiB, WS_Q = 317 * MiB, WS_CQ = 365 * MiB, WS_CKV = 377 * MiB, WS_K = 385 * MiB;
constexpr size_t WS_END = 478 * MiB;
constexpr int CW_CNT = 0;
constexpr int CW_BAR = 1024;

__device__ __forceinline__ float bf2f(unsigned h) { return __uint_as_float(h << 16); }
__device__ __forceinline__ unsigned f2bf(float f) { unsigned u = __float_as_uint(f); return (u + 0x7fffu + ((u >> 16) & 1u)) >> 16; }
__device__ __forceinline__ unsigned pk2(float lo, float hi) { return f2bf(lo) | (f2bf(hi) << 16); }
__device__ __forceinline__ void unpack8(const u32x4 w, float (&f)[8]) {
    f[0] = __uint_as_float(w.x << 16); f[1] = __uint_as_float(w.x & 0xffff0000u);
    f[2] = __uint_as_float(w.y << 16); f[3] = __uint_as_float(w.y & 0xffff0000u);
    f[4] = __uint_as_float(w.z << 16); f[5] = __uint_as_float(w.z & 0xffff0000u);
    f[6] = __uint_as_float(w.w << 16); f[7] = __uint_as_float(w.w & 0xffff0000u);
}
__device__ __forceinline__ u32x4 pack8(const float (&f)[8]) {
    u32x4 w; w.x = pk2(f[0], f[1]); w.y = pk2(f[2], f[3]); w.z = pk2(f[4], f[5]); w.w = pk2(f[6], f[7]); return w;
}
__device__ __forceinline__ float sigmoidf_(float x) { return 1.0f / (1.0f + __expf(-x)); }
__device__ __forceinline__ float siluf_(float x) { return x / (1.0f + __expf(-x)); }
__device__ __forceinline__ float gelu_tanh(float x) { const float z = 1.5957691216057308f * (x + 0.044715f * x * x * x); return x / (1.0f + __expf(-z)); }
__device__ __forceinline__ float wave_sum(float v) {
#pragma unroll
    for (int o = 1; o < 64; o <<= 1) v += __shfl_xor(v, o);
    return v;
}
__device__ __forceinline__ float wave_max(float v) {
#pragma unroll
    for (int o = 1; o < 64; o <<= 1) v = fmaxf(v, __shfl_xor(v, o));
    return v;
}

struct Args { const float* in[34]; float* out; unsigned char* ws; int lo, hi; };
struct Frame {
    unsigned char* lds;
    int tid, lane, wave, G, bid;
    const float* in[34];
    float* out; unsigned char* ws;
};
enum { I_X = 0, I_C, I_ADAW, I_ADAB, I_NMIX, I_NFFN, I_FING, I_ABWIN, I_SGUVG, I_SGUWS, I_SGUBS, I_LAMRE, I_LAMIM, I_LOGDT,
       I_BRE, I_BIM, I_CRE, I_CIM, I_S5D, I_WGLU, I_ABWOUT, I_FW1, I_FW3, I_FW2, I_MWIN, I_QNG, I_KVNG, I_WUQ, I_WUKV, I_WO,
       I_ROUTER, I_MW1, I_MW3, I_MW2 };

__device__ __forceinline__ int rowmap(int kind, int n) {
    switch (kind) {
        case 1: return 256 * (n >> 7) + (n & 127);
        case 2: return 256 * (n >> 7) + 128 + (n & 127);
        case 3: { if (n < 640) return n; const int i = n - 640; return 640 + 2 * (i & 31) + (i >> 5); }
        case 4: { const int h = n / 192, r = n - h * 192; if (r < 128) return n; const int i = r - 128; return h * 192 + 128 + 2 * (i & 31) + (i >> 5); }
        default: return n;
    }
}
__device__ __forceinline__ void transpose_item(const float* W, int N, bf16_t* WT, int ldd, int kind, float* scr, int kb, int nb, int lane) {
    const int k0 = 64 * kb, n0 = 32 * nb;
#pragma unroll 8
    for (int i = 0; i < 32; ++i) { const int kk = 2 * i + (lane >> 5); scr[kk * 33 + (lane & 31)] = W[(size_t)(k0 + kk) * N + n0 + (lane & 31)]; }
    asm volatile("s_waitcnt lgkmcnt(0)" ::: "memory");
    const int c = lane & 7;
#pragma unroll
    for (int j = 0; j < 4; ++j) { const int n = (lane >> 3) + 8 * j; const float* s = scr + (8 * c) * 33 + n;
        u32x4 o; o.x = pk2(s[0 * 33], s[1 * 33]); o.y = pk2(s[2 * 33], s[3 * 33]); o.z = pk2(s[4 * 33], s[5 * 33]); o.w = pk2(s[6 * 33], s[7 * 33]);
        *(u32x4*)(WT + (size_t)rowmap(kind, n0 + n) * ldd + k0 + 8 * c) = o; }
    asm volatile("s_waitcnt lgkmcnt(0)" ::: "memory");
}


__device__ __forceinline__ void p0_adaln_unit(Frame& F, int unit) {
    float* silu_c = (float*)F.lds;
    float* red = (float*)(F.lds + 8192);
    const float* c = F.in[I_C];
    for (int i = F.tid; i < 2048; i += NTHREADS) silu_c[i] = siluf_(c[i]);
    __syncthreads();
    const int col = unit * 64, layer = col / 6144, j = col - layer * 6144;
    const float* w = F.in[I_ADAW] + (size_t)layer * 1024 * 6144 + j + F.lane;
    float a0 = 0.f, a1 = 0.f;
    const int kbeg = F.wave * 128;
#pragma unroll 8
    for (int k = kbeg; k < kbeg + 128; ++k) { const float wv = w[(size_t)k * 6144]; a0 += silu_c[k] * wv; a1 += silu_c[1024 + k] * wv; }
    red[(F.wave * 2 + 0) * 64 + F.lane] = a0; red[(F.wave * 2 + 1) * 64 + F.lane] = a1;
    __syncthreads();
    if (F.tid < 128) { const int b = F.tid >> 6, l = F.tid & 63; float s = 0.f;
#pragma unroll
        for (int wv = 0; wv < 8; ++wv) s += red[(wv * 2 + b) * 64 + l];
        s += F.in[I_ADAB][layer * 6144 + j + l];
        ((float*)(F.ws + WS_MOD))[(size_t)(layer * 2 + b) * 6144 + j + l] = s; }
    __syncthreads();
}

__device__ __forceinline__ void p0_s5_unit(Frame& F, int g) {
    float* Pre = (float*)F.lds;
    float* Pim = Pre + 2 * 17 * 64;
    float* BBre = Pim + 2 * 17 * 64;
    float* BBim = BBre + 2 * 64 * 16;
    float* Cre = BBim + 2 * 64 * 16;
    float* Cim = Cre + 2 * 16 * 64;
    float* Kt = Cim + 2 * 16 * 64;
    const float* lam_re = F.in[I_LAMRE]; const float* lam_im = F.in[I_LAMIM]; const float* log_dt = F.in[I_LOGDT];
    for (int idx = F.tid; idx < 2 * 17 * 64; idx += NTHREADS) {
        const int dir = idx / (17 * 64), r = idx - dir * 17 * 64, j = r >> 6, p = r & 63;
        const float dt = expf(log_dt[dir * 32 + g]);
        const float lr = lam_re[(dir * 32 + g) * 64 + p], li = lam_im[(dir * 32 + g) * 64 + p];
        const float mag = expf(lr * dt * (float)j); float sn, cs; sincosf(li * dt * (float)j, &sn, &cs);
        Pre[idx] = mag * cs; Pim[idx] = mag * sn;
    }
    for (int idx = F.tid; idx < 2 * 16 * 64; idx += NTHREADS) {
        const int dir = idx >> 10, r = idx & 1023;
        Cre[idx] = F.in[I_CRE][(size_t)(dir * 32 + g) * 1024 + r]; Cim[idx] = F.in[I_CIM][(size_t)(dir * 32 + g) * 1024 + r];
    }
    __syncthreads();
    for (int idx = F.tid; idx < 2 * 64 * 16; idx += NTHREADS) {
        const int dir = idx >> 10, r = idx & 1023, p = r >> 4;
        const float lr = lam_re[(dir * 32 + g) * 64 + p], li = lam_im[(dir * 32 + g) * 64 + p];
        const float ar = Pre[(dir * 17 + 1) * 64 + p], ai = Pim[(dir * 17 + 1) * 64 + p];
        const float den = lr * lr + li * li;
        const float fr = ((ar - 1.0f) * lr + ai * li) / den, fi = (ai * lr - (ar - 1.0f) * li) / den;
        const float br = F.in[I_BRE][(size_t)(dir * 32 + g) * 1024 + r], bi = F.in[I_BIM][(size_t)(dir * 32 + g) * 1024 + r];
        BBre[idx] = fr * br - fi * bi; BBim[idx] = fr * bi + fi * br;
    }
    __syncthreads();
    for (int idx = F.tid; idx < 2 * 16 * 16 * 16; idx += NTHREADS) {
        const int dir = idx >> 12, j = (idx >> 8) & 15, h = (idx >> 4) & 15, hp = idx & 15;
        float s = 0.f;
        for (int p = 0; p < 64; ++p) {
            const float cr = Cre[(dir * 16 + h) * 64 + p], ci = Cim[(dir * 16 + h) * 64 + p];
            const float pr = Pre[(dir * 17 + j) * 64 + p], pi = Pim[(dir * 17 + j) * 64 + p];
            const float xr = cr * pr - ci * pi, xi = cr * pi + ci * pr;
            s += xr * BBre[(dir * 64 + p) * 16 + hp] - xi * BBim[(dir * 64 + p) * 16 + hp];
        }
        Kt[idx] = s;
    }
    __syncthreads();
    bf16_t* GtA = (bf16_t*)(F.ws + WS_GTA) + (size_t)g * 256 * 256;
    for (int ch = F.tid; ch < 256 * 32; ch += NTHREADS) {
        const int np = ch >> 5, k0 = (ch & 31) * 8, dir = np >> 7, ri = (np >> 6) & 1, p = np & 63, s = k0 >> 4, h0 = k0 & 15;
        const int e = dir == 0 ? 15 - s : s;
        const float pr = Pre[(dir * 17 + e) * 64 + p], pi = Pim[(dir * 17 + e) * 64 + p];
        float v[8];
#pragma unroll
        for (int j = 0; j < 8; ++j) { const float br = BBre[(dir * 64 + p) * 16 + h0 + j], bi = BBim[(dir * 64 + p) * 16 + h0 + j];
            v[j] = ri == 0 ? (pr * br - pi * bi) : (pr * bi + pi * br); }
        *(u32x4*)(GtA + (size_t)np * 256 + k0) = pack8(v);
    }
    bf16_t* BtC = (bf16_t*)(F.ws + WS_BTC) + (size_t)g * 256 * 512;
    for (int ch = F.tid; ch < 256 * 64; ch += NTHREADS) {
        const int np = ch >> 6, k0 = (ch & 63) * 8, t = np >> 4, h = np & 15;
        float v[8];
        if (k0 < 256) {
            const int s = k0 >> 4, h0 = k0 & 15;
#pragma unroll
            for (int j = 0; j < 8; ++j) { float x = 0.f;
                if (t >= s) x += Kt[((0 * 16 + (t - s)) * 16 + h) * 16 + h0 + j];
                if (s >= t) x += Kt[((1 * 16 + (s - t)) * 16 + h) * 16 + h0 + j];
                v[j] = x; }
        } else {
            const int q = k0 - 256, dir = q >> 7, ri = (q >> 6) & 1, p0 = q & 63;
            const int e = dir == 0 ? t + 1 : 16 - t;
#pragma unroll
            for (int j = 0; j < 8; ++j) { const int p = p0 + j;
                const float cr = Cre[(dir * 16 + h) * 64 + p], ci = Cim[(dir * 16 + h) * 64 + p];
                const float pr = Pre[(dir * 17 + e) * 64 + p], pi = Pim[(dir * 17 + e) * 64 + p];
                v[j] = ri == 0 ? (cr * pr - ci * pi) : -(cr * pi + ci * pr); }
        }
        *(u32x4*)(BtC + (size_t)np * 512 + k0) = pack8(v);
    }
    if (F.tid < 128) { const int dir = F.tid >> 6, p = F.tid & 63;
        f32x2 a; a.x = Pre[(dir * 17 + 16) * 64 + p]; a.y = Pim[(dir * 17 + 16) * 64 + p];
        ((f32x2*)(F.ws + WS_A16))[(g * 2 + dir) * 64 + p] = a; }
    __syncthreads();
}

__device__ __forceinline__ void p0_tmat(Frame& F, float* scr, int& base, const float* src, bf16_t* dst, int K, int N, int ldd, int kind, int nrep, size_t src_rep, size_t dst_rep) {
    const int gw = F.bid * NWAVES + F.wave, NGW = F.G * NWAVES;
    const int nblk = N / 32, per = (K / 64) * nblk, tot = per * nrep;
    int first = gw - (base % NGW); if (first < 0) first += NGW;
    for (int it = first; it < tot; it += NGW) {
        const int rep = it / per, r = it - rep * per;
        transpose_item(src + (size_t)rep * src_rep, N, dst + (size_t)rep * dst_rep, ldd, kind, scr, r / nblk, r % nblk, F.lane);
    }
    base += tot;
}
__device__ __forceinline__ void p0_prologue(Frame& F) {
    for (int u = F.bid; u < 225; u += F.G) {
        if (u < 192) p0_adaln_unit(F, u);
        else if (u < 224) p0_s5_unit(F, u - 192);
        else { u32x4 z = {0u, 0u, 0u, 0u}; u32x4* dst = (u32x4*)((bf16_t*)(F.ws + WS_WMIN) + (size_t)704 * 1024);
            for (int i = F.tid; i < 64 * 1024 / 8; i += NTHREADS) dst[i] = z; }
    }
    __syncthreads();
    { f32x2* rope = (f32x2*)(F.ws + WS_ROPE);
      for (int idx = F.bid * NTHREADS + F.tid; idx < SEQ * 32; idx += F.G * NTHREADS) {
          const int l = idx >> 5, i = idx & 31;
          const float inv = powf(10000.0f, -(float)(2 * i) / 64.0f);
          const float ang = (float)l * inv; float sn, cs; sincosf(ang, &sn, &cs);
          f32x2 v; v.x = cs; v.y = sn; rope[idx] = v; } }
    float* scr = (float*)(F.lds + F.wave * 16384);
    unsigned char* ws = F.ws; int base = 0;
    p0_tmat(F, scr, base, F.in[I_ABWIN], (bf16_t*)(ws + WS_WIN), 1024, 1536, 1024, 0, 1, 0, 0);
    p0_tmat(F, scr, base, F.in[I_WGLU], (bf16_t*)(ws + WS_WGLU), 512, 512, 512, 0, 1, 0, 0);
    p0_tmat(F, scr, base, F.in[I_ABWOUT], (bf16_t*)(ws + WS_WOUT), 1024, 1024, 1024, 0, 1, 0, 0);
    p0_tmat(F, scr, base, F.in[I_FW1], (bf16_t*)(ws + WS_W13), 1024, 2816, 1024, 1, 1, 0, 0);
    p0_tmat(F, scr, base, F.in[I_FW3], (bf16_t*)(ws + WS_W13), 1024, 2816, 1024, 2, 1, 0, 0);
    p0_tmat(F, scr, base, F.in[I_FW2], (bf16_t*)(ws + WS_W2), 2816, 1024, 2816, 0, 1, 0, 0);
    p0_tmat(F, scr, base, F.in[I_MWIN], (bf16_t*)(ws + WS_WMIN), 1024, 704, 1024, 3, 1, 0, 0);
    p0_tmat(F, scr, base, F.in[I_WUQ], (bf16_t*)(ws + WS_WUQ), 384, 1536, 384, 4, 1, 0, 0);
    p0_tmat(F, scr, base, F.in[I_WUKV], (bf16_t*)(ws + WS_WUKV), 256, 2048, 256, 0, 1, 0, 0);
    p0_tmat(F, scr, base, F.in[I_WO], (bf16_t*)(ws + WS_WO), 1024, 1024, 1024, 0, 1, 0, 0);
    p0_tmat(F, scr, base, F.in[I_MW1], (bf16_t*)(ws + WS_MW13), 1024, 3584, 1024, 1, 8, (size_t)1024 * 3584, (size_t)7168 * 1024);
    p0_tmat(F, scr, base, F.in[I_MW3], (bf16_t*)(ws + WS_MW13), 1024, 3584, 1024, 2, 8, (size_t)1024 * 3584, (size_t)7168 * 1024);
    p0_tmat(F, scr, base, F.in[I_MW2], (bf16_t*)(ws + WS_MW2), 3584, 1024, 3584, 0, 8, (size_t)3584 * 1024, (size_t)1024 * 3584);
}

__device__ __forceinline__ void norm_row(const float* xrow, const float* gn, const float* sh, const float* sc, bf16_t* orow, int lane, f32x4 (&hv)[4]) {
    const f32x4* xr = (const f32x4*)xrow + lane;
    f32x4 v[4]; float s = 0.f;
#pragma unroll
    for (int j = 0; j < 4; ++j) { v[j] = xr[64 * j]; s += (v[j].x * v[j].x + v[j].y * v[j].y) + (v[j].z * v[j].z + v[j].w * v[j].w); }
    const float rstd = rsqrtf(wave_sum(s) * (1.0f / D) + RMS_EPS);
    u32x2* o8 = (u32x2*)orow + lane;
#pragma unroll
    for (int j = 0; j < 4; ++j) {
        const f32x4 g4 = ((const f32x4*)gn)[lane + 64 * j], s4 = ((const f32x4*)sh)[lane + 64 * j], c4 = ((const f32x4*)sc)[lane + 64 * j];
        f32x4 h; h.x = v[j].x * rstd * g4.x * (1.0f + c4.x) + s4.x; h.y = v[j].y * rstd * g4.y * (1.0f + c4.y) + s4.y;
        h.z = v[j].z * rstd * g4.z * (1.0f + c4.z) + s4.z; h.w = v[j].w * rstd * g4.w * (1.0f + c4.w) + s4.w;
        hv[j] = h; u32x2 w; w.x = pk2(h.x, h.y); w.y = pk2(h.z, h.w); o8[64 * j] = w; }
}
__device__ __forceinline__ void norm_phase(Frame& F, const float* X, const float* gn, int layer, int which_shift) {
    const float* mod = (const float*)(F.ws + WS_MOD) + (size_t)layer * 2 * 6144;
    bf16_t* H = (bf16_t*)(F.ws + WS_H);
    const int gw = F.bid * NWAVES + F.wave, NGW = F.G * NWAVES;
    for (int m = gw; m < T; m += NGW) { const int b = m >> 13; f32x4 hv[4];
        norm_row(X + (size_t)m * D, gn, mod + b * 6144 + which_shift * 1024, mod + b * 6144 + (which_shift + 1) * 1024, H + (size_t)m * D, F.lane, hv); }
}

__device__ __forceinline__ void zsplit_phase(Frame& F) {
    const float* Z = (const float*)(F.ws + WS_Z); bf16_t* CQ = (bf16_t*)(F.ws + WS_CQ); bf16_t* CKV = (bf16_t*)(F.ws + WS_CKV); bf16_t* Kf = (bf16_t*)(F.ws + WS_K);
    const f32x2* rope = (const f32x2*)(F.ws + WS_ROPE);
    const float* gq = F.in[I_QNG]; const float* gkv = F.in[I_KVNG];
    const int gw = F.bid * NWAVES + F.wave, NGW = F.G * NWAVES, lane = F.lane;
    for (int m = gw; m < T; m += NGW) {
        const float* z = Z + (size_t)m * CINP; const int b = m >> 13, l = m & (SEQ - 1);
        float q[6], kv[4]; float s = 0.f, s2 = 0.f;
#pragma unroll
        for (int j = 0; j < 6; ++j) { q[j] = z[lane + 64 * j]; s += q[j] * q[j]; }
#pragma unroll
        for (int j = 0; j < 4; ++j) { kv[j] = z[QL + lane + 64 * j]; s2 += kv[j] * kv[j]; }
        const float kr = z[QL + KVL + lane];
        const float r1 = rsqrtf(wave_sum(s) * (1.0f / QL) + RMS_EPS), r2 = rsqrtf(wave_sum(s2) * (1.0f / KVL) + RMS_EPS);
#pragma unroll
        for (int j = 0; j < 6; ++j) CQ[(size_t)m * QL + lane + 64 * j] = (bf16_t)f2bf(q[j] * r1 * gq[lane + 64 * j]);
#pragma unroll
        for (int j = 0; j < 4; ++j) CKV[(size_t)m * KVL + lane + 64 * j] = (bf16_t)f2bf(kv[j] * r2 * gkv[lane + 64 * j]);
        const float other = __shfl_xor(kr, 1); const int i = lane >> 1; const f32x2 cs = rope[l * 32 + i];
        const float x1 = (lane & 1) ? other : kr, x2 = (lane & 1) ? kr : other;
        const float o = (lane & 1) ? (x1 * cs.y + x2 * cs.x) : (x1 * cs.x - x2 * cs.y);
        const bf16_t ob = (bf16_t)f2bf(o);
#pragma unroll
        for (int hh = 0; hh < NH; ++hh) Kf[((size_t)(b * NH + hh) * SEQ + l) * DQK + 128 + lane] = ob;
    }
}

__device__ __forceinline__ void sgu_unit(Frame& F, int unit) {
    constexpr int PIT = 136;
    bf16_t* Ws = (bf16_t*)F.lds;
    bf16_t* Vt = Ws + 128 * PIT;
    const int g = unit & 3, n = (unit >> 2) & 63, b = unit >> 8;
    const int tok0 = b * SEQ + n * 128;
    const bf16_t* VA = (const bf16_t*)(F.ws + WS_VA); const bf16_t* UA = (const bf16_t*)(F.ws + WS_UA); bf16_t* CAT = (bf16_t*)(F.ws + WS_CAT);
    const int tid = F.tid, lane = F.lane;
    {
        const int tk = tid >> 2, c0 = (tid & 3) * 32;
        const u32x4* src = (const u32x4*)(VA + (size_t)(tok0 + tk) * A_W + g * 128 + c0);
        float v[32]; float s = 0.f;
#pragma unroll
        for (int j = 0; j < 4; ++j) { float f[8]; unpack8(src[j], f);
#pragma unroll
            for (int e = 0; e < 8; ++e) { v[j * 8 + e] = f[e]; s += f[e] * f[e]; } }
        s += __shfl_xor(s, 1); s += __shfl_xor(s, 2);
        const float rstd = rsqrtf(s * (1.0f / 128.0f) + RMS_EPS);
        const float* vg = F.in[I_SGUVG] + g * 128 + c0;
#pragma unroll
        for (int e = 0; e < 32; ++e) Vt[(c0 + e) * PIT + tk] = (bf16_t)f2bf(v[e] * rstd * vg[e]);
        const f32x4* wsrc = (const f32x4*)(F.in[I_SGUWS] + (size_t)g * 128 * 128 + (size_t)tk * 128 + c0);
#pragma unroll
        for (int j = 0; j < 4; ++j) { const f32x4 a = wsrc[2 * j], bq = wsrc[2 * j + 1];
            u32x4 w; w.x = pk2(a.x, a.y); w.y = pk2(a.z, a.w); w.z = pk2(bq.x, bq.y); w.w = pk2(bq.z, bq.w);
            *(u32x4*)(Ws + tk * PIT + c0 + 8 * j) = w; }
    }
    __syncthreads();
    f32x4 acc[8];
#pragma unroll
    for (int nn = 0; nn < 8; ++nn) acc[nn] = (f32x4){0.f, 0.f, 0.f, 0.f};
    const int fr = lane & 15, fq = lane >> 4, w = F.wave;
#pragma unroll
    for (int kk = 0; kk < 4; ++kk) {
        const bf16x8 a = *(const bf16x8*)(Ws + (16 * w + fr) * PIT + 32 * kk + 8 * fq);
#pragma unroll
        for (int nn = 0; nn < 8; ++nn) { const bf16x8 bv = *(const bf16x8*)(Vt + (16 * nn + fr) * PIT + 32 * kk + 8 * fq);
            acc[nn] = __builtin_amdgcn_mfma_f32_16x16x32_bf16(a, bv, acc[nn], 0, 0, 0); }
    }
    const float* bs = F.in[I_SGUBS] + g * 128;
#pragma unroll
    for (int nn = 0; nn < 8; ++nn)
#pragma unroll
        for (int i = 0; i < 4; ++i) { const int q = 16 * w + 4 * fq + i, c = 16 * nn + fr;
            const float sv = acc[nn][i] + bs[q];
            const size_t tok = (size_t)(tok0 + q);
            const float u = bf2f(UA[tok * A_W + g * 128 + c]);
            CAT[tok * D + g * 128 + c] = (bf16_t)f2bf(u * sv); }
    __syncthreads();
}

__device__ __forceinline__ void scan_wave(Frame& F, int id) {
    const int b = id >> 6, g = (id >> 1) & 31, dir = id & 1, p = F.lane;
    const float* SS = (const float*)(F.ws + WS_SS); bf16_t* AC = (bf16_t*)(F.ws + WS_AC);
    const f32x2 a16 = ((const f32x2*)(F.ws + WS_A16))[(g * 2 + dir) * 64 + p];
    float xr = 0.f, xi = 0.f;
    const size_t row0 = (size_t)g * 1024 + b * 512;
#pragma unroll 8
    for (int i = 0; i < 512; ++i) {
        const int blk = dir == 0 ? i : 511 - i; const size_t row = row0 + blk;
        const float sr = SS[row * 256 + dir * 128 + p], si = SS[row * 256 + dir * 128 + 64 + p];
        AC[row * 512 + 256 + dir * 128 + p] = (bf16_t)f2bf(xr); AC[row * 512 + 256 + dir * 128 + 64 + p] = (bf16_t)f2bf(xi);
        const float nr = a16.x * xr - a16.y * xi + sr, ni = a16.x * xi + a16.y * xr + si;
        xr = nr; xi = ni;
    }
}

struct EpiIn {
    bf16_t *UA, *VA, *AC;
    __device__ __forceinline__ void operator()(int row, int col, const float (&v)[8]) const {
        if (col < 1024) { float o[8];
#pragma unroll
            for (int j = 0; j < 8; ++j) o[j] = gelu_tanh(v[j]);
            bf16_t* dst = col < 512 ? UA + (size_t)row * A_W + col : VA + (size_t)row * A_W + (col - 512);
            *(u32x4*)dst = pack8(o);
        } else { const int cp = col - 1024, g = cp >> 4, h0 = cp & 15;
            *(u32x4*)(AC + ((size_t)g * 1024 + (row >> 4)) * 512 + (row & 15) * 16 + h0) = pack8(v); }
    }
};
struct EpiS5A {
    float* SS;
    __device__ __forceinline__ void operator()(int row, int col, const float (&v)[8]) const {
        float* d = SS + (size_t)row * 256 + (col & 255);
        *(f32x4*)d = (f32x4){v[0], v[1], v[2], v[3]}; *(f32x4*)(d + 4) = (f32x4){v[4], v[5], v[6], v[7]};
    }
};
struct EpiS5C {
    const bf16_t* AC; const float* dsk; bf16_t* YG;
    __device__ __forceinline__ void operator()(int row, int col, const float (&v)[8]) const {
        const int g = row >> 10, blk = row & 1023, cl = col & 255, t = cl >> 4, h0 = cl & 15;
        float u[8]; unpack8(*(const u32x4*)(AC + (size_t)row * 512 + cl), u);
        float o[8];
#pragma unroll
        for (int j = 0; j < 8; ++j) o[j] = gelu_tanh(v[j] + dsk[g * 16 + h0 + j] * u[j]);
        *(u32x4*)(YG + (size_t)(blk * 16 + t) * B_W + g * 16 + h0) = pack8(o);
    }
};
struct EpiGlu {
    const bf16_t* YG; bf16_t* CAT;
    __device__ __forceinline__ void operator()(int row, int col, const float (&v)[8]) const {
        float y[8]; unpack8(*(const u32x4*)(YG + (size_t)row * B_W + col), y); float o[8];
#pragma unroll
        for (int j = 0; j < 8; ++j) o[j] = y[j] * sigmoidf_(v[j]);
        *(u32x4*)(CAT + (size_t)row * D + 512 + col) = pack8(o);
    }
};
struct EpiRes {
    const float* Xin; float* X; const float* gate;
    __device__ __forceinline__ void operator()(int row, int col, const float (&v)[8]) const {
        const int b = row >> 13; const float* gt = gate + b * 6144 + col; const float* xi = Xin + (size_t)row * D + col; float* xo = X + (size_t)row * D + col;
        const f32x4 x0 = *(const f32x4*)xi, x1 = *(const f32x4*)(xi + 4), g0 = *(const f32x4*)gt, g1 = *(const f32x4*)(gt + 4);
        *(f32x4*)xo = (f32x4){x0.x + g0.x * v[0], x0.y + g0.y * v[1], x0.z + g0.z * v[2], x0.w + g0.w * v[3]};
        *(f32x4*)(xo + 4) = (f32x4){x1.x + g1.x * v[4], x1.y + g1.y * v[5], x1.z + g1.z * v[6], x1.w + g1.w * v[7]};
    }
};
struct EpiSwiglu {
    bf16_t* O; int ldo;
    __device__ __forceinline__ void operator()(int row, int col, const float (&a)[8], const float (&b)[8]) const {
        float o[8];
#pragma unroll
        for (int j = 0; j < 8; ++j) o[j] = siluf_(a[j]) * b[j];
        *(u32x4*)(O + (size_t)row * ldo + (col % ldo)) = pack8(o);
    }
};
struct EpiZ {
    float* Z;
    __device__ __forceinline__ void operator()(int row, int col, const float (&v)[8]) const {
        float* d = Z + (size_t)row * CINP + col;
        *(f32x4*)d = (f32x4){v[0], v[1], v[2], v[3]}; *(f32x4*)(d + 4) = (f32x4){v[4], v[5], v[6], v[7]};
    }
};
struct EpiQ {
    bf16_t* Q; const f32x2* rope;
    __device__ __forceinline__ void operator()(int row, int col, const float (&v)[8]) const {
        const int b = row >> 13, l = row & (SEQ - 1), h = col / 192, r = col - h * 192;
        float o[8];
        if (r < 128) {
#pragma unroll
            for (int j = 0; j < 8; ++j) o[j] = v[j] * QSCALE;
        } else { const int i0 = (r - 128) >> 1;
#pragma unroll
            for (int j = 0; j < 4; ++j) { const f32x2 cs = rope[l * 32 + i0 + j]; const float x1 = v[2 * j], x2 = v[2 * j + 1];
                o[2 * j] = (x1 * cs.x - x2 * cs.y) * QSCALE; o[2 * j + 1] = (x1 * cs.y + x2 * cs.x) * QSCALE; } }
        *(u32x4*)(Q + ((size_t)(b * NH + h) * SEQ + l) * DQK + r) = pack8(o);
    }
};
struct EpiKV {
    bf16_t *Kf, *V;
    __device__ __forceinline__ void operator()(int row, int col, const float (&v)[8]) const {
        const int b = row >> 13, l = row & (SEQ - 1), h = col >> 8, r = col & 255;
        bf16_t* d = r < 128 ? Kf + ((size_t)(b * NH + h) * SEQ + l) * DQK + r : V + ((size_t)(b * NH + h) * SEQ + l) * DV + (r - 128);
        *(u32x4*)d = pack8(v);
    }
};
struct EpiYS {
    bf16_t* YS;
    __device__ __forceinline__ void operator()(int row, int col, const float (&v)[8]) const { *(u32x4*)(YS + (size_t)row * D + (col & 1023)) = pack8(v); }
};

struct BOffNone { __device__ __forceinline__ int operator()(int) const { return 0; } };
struct BOffDiag { __device__ __forceinline__ int operator()(int row) const { return (row >> 10) * 256; } };
struct BOffMoE { int rb[9]; int nper;
    __device__ __forceinline__ int operator()(int row) const { int e = 0;
#pragma unroll
        for (int j = 1; j < 8; ++j) if (row >= rb[j]) e = j;
        return e * nper; } };

template <bool DUAL, class Epi, class BOff>
__device__ __forceinline__ void naive_gemm(Frame& F, const bf16_t* A, int lda, const bf16_t* Bt, int K, int M, int Ncols, const Epi& E, const BOff& boff) {
    const int ncg = Ncols / 8; const long total = (long)M * ncg;
    for (long it = (long)F.bid * NTHREADS + F.tid; it < total; it += (long)F.G * NTHREADS) {
        const int cgp = (int)(it / M), row = (int)(it - (long)cgp * M), col = cgp * 8;
        const int bo = boff(row);
        const bf16_t* a = A + (size_t)row * lda;
        if constexpr (!DUAL) {
            const bf16_t* bp = Bt + (size_t)(bo + col) * K;
            float acc[8];
#pragma unroll
            for (int j = 0; j < 8; ++j) acc[j] = 0.f;
            for (int k = 0; k < K; k += 8) { float av[8]; unpack8(*(const u32x4*)(a + k), av);
#pragma unroll
                for (int j = 0; j < 8; ++j) { float bv[8]; unpack8(*(const u32x4*)(bp + (size_t)j * K + k), bv);
#pragma unroll
                    for (int e = 0; e < 8; ++e) acc[j] += av[e] * bv[e]; } }
            E(row, bo + col, acc);
        } else {
            const int brow = 256 * (col >> 7) + (col & 127);
            const bf16_t* bp = Bt + (size_t)(bo + brow) * K;
            float acc[8], acc2[8];
#pragma unroll
            for (int j = 0; j < 8; ++j) { acc[j] = 0.f; acc2[j] = 0.f; }
            for (int k = 0; k < K; k += 8) { float av[8]; unpack8(*(const u32x4*)(a + k), av);
#pragma unroll
                for (int j = 0; j < 8; ++j) { float bv[8]; unpack8(*(const u32x4*)(bp + (size_t)j * K + k), bv); float cv[8]; unpack8(*(const u32x4*)(bp + (size_t)(128 + j) * K + k), cv);
#pragma unroll
                    for (int e = 0; e < 8; ++e) { acc[j] += av[e] * bv[e]; acc2[j] += av[e] * cv[e]; } } }
            E(row, bo / 2 + col, acc, acc2);
        }
    }
}

__device__ __forceinline__ void naive_attn_phase(Frame& F) {
    const bf16_t* Q = (const bf16_t*)(F.ws + WS_Q); const bf16_t* Kf = (const bf16_t*)(F.ws + WS_K); const bf16_t* V = (const bf16_t*)(F.ws + WS_V); bf16_t* O = (bf16_t*)(F.ws + WS_O);
    float* qs = (float*)(F.lds) + F.wave * 192;
    const int gw = F.bid * NWAVES + F.wave, NGW = F.G * NWAVES, lane = F.lane;
    for (int r = gw; r < NBATCH * NH * SEQ; r += NGW) {
        const int bh = r >> 13, l = r & (SEQ - 1), b = bh >> 3, h = bh & 7;
        const bf16_t* qrow = Q + (size_t)r * DQK;
        for (int i = lane; i < 192; i += 64) qs[i] = bf2f(qrow[i]);
        asm volatile("s_waitcnt lgkmcnt(0)" ::: "memory");
        float m = -1e30f, lsum = 0.f, o0 = 0.f, o1 = 0.f;
        const bf16_t* Kb = Kf + (size_t)bh * SEQ * DQK; const bf16_t* Vb = V + (size_t)bh * SEQ * DV;
        for (int j0 = 0; j0 < SEQ; j0 += 64) {
            const u32x4* kr = (const u32x4*)(Kb + (size_t)(j0 + lane) * DQK); float s = 0.f;
#pragma unroll 4
            for (int c = 0; c < 24; ++c) { float kv[8]; unpack8(kr[c], kv); const f32x4 q0 = *(const f32x4*)(qs + c * 8), q1 = *(const f32x4*)(qs + c * 8 + 4);
                s += q0.x * kv[0] + q0.y * kv[1] + q0.z * kv[2] + q0.w * kv[3] + q1.x * kv[4] + q1.y * kv[5] + q1.z * kv[6] + q1.w * kv[7]; }
            const float mn = fmaxf(m, wave_max(s)), alpha = exp2f(m - mn), pw = exp2f(s - mn);
            lsum = lsum * alpha + wave_sum(pw); m = mn; o0 *= alpha; o1 *= alpha;
            const unsigned* vp = (const unsigned*)(Vb + (size_t)j0 * DV) + lane;
#pragma unroll 8
            for (int j = 0; j < 64; ++j) { const float pj = __shfl(pw, j); const unsigned vv = vp[(size_t)j * (DV / 2)];
                o0 += pj * __uint_as_float(vv << 16); o1 += pj * __uint_as_float(vv & 0xffff0000u); }
        }
        const float inv = 1.0f / lsum;
        unsigned* orow = (unsigned*)(O + (size_t)(b * SEQ + l) * D + h * 128) + lane;
        *orow = pk2(o0 * inv, o1 * inv);
    }
}

__device__ __forceinline__ void route_phase(Frame& F) {
    const float* X = F.out; const float* gn = F.in[I_NFFN] + 1024; const float* mod = (const float*)(F.ws + WS_MOD) + (size_t)1 * 2 * 6144;
    bf16_t* H = (bf16_t*)(F.ws + WS_H); const float* wr = F.in[I_ROUTER];
    unsigned* cnt = (unsigned*)(F.ws + WS_CTL) + CW_CNT; int* list = (int*)(F.ws + WS_LIST); int* tokinfo = (int*)(F.ws + WS_TOKINFO);
    int* le0 = (int*)F.lds; int* le1 = le0 + 64; float* lg0 = (float*)(le1 + 64); float* lg1 = lg0 + 64; int* lp0 = (int*)(lg1 + 64); int* lp1 = lp0 + 64;
    const int lane = F.lane;
    for (int chunk = F.bid; chunk < T / 64; chunk += F.G) {
        const int row0 = chunk * 64;
        for (int rr = 0; rr < 8; ++rr) {
            const int lr = F.wave * 8 + rr, m = row0 + lr, b = m >> 13; f32x4 hv[4];
            norm_row(X + (size_t)m * D, gn, mod + b * 6144 + 3 * 1024, mod + b * 6144 + 4 * 1024, H + (size_t)m * D, lane, hv);
            float lg[8];
#pragma unroll
            for (int e = 0; e < 8; ++e) lg[e] = 0.f;
#pragma unroll
            for (int j = 0; j < 4; ++j) { const float hx[4] = {hv[j].x, hv[j].y, hv[j].z, hv[j].w};
#pragma unroll
                for (int q = 0; q < 4; ++q) { const int k = 4 * lane + 256 * j + q; const f32x4 w0 = *(const f32x4*)(wr + (size_t)k * 8), w1 = *(const f32x4*)(wr + (size_t)k * 8 + 4);
                    lg[0] += hx[q] * w0.x; lg[1] += hx[q] * w0.y; lg[2] += hx[q] * w0.z; lg[3] += hx[q] * w0.w;
                    lg[4] += hx[q] * w1.x; lg[5] += hx[q] * w1.y; lg[6] += hx[q] * w1.z; lg[7] += hx[q] * w1.w; } }
#pragma unroll
            for (int e = 0; e < 8; ++e) lg[e] = wave_sum(lg[e]);
            int e0 = 0; float v0 = lg[0];
#pragma unroll
            for (int e = 1; e < 8; ++e) if (lg[e] > v0) { v0 = lg[e]; e0 = e; }
            int e1 = -1; float v1 = -3.0e38f;
#pragma unroll
            for (int e = 0; e < 8; ++e) if (e != e0 && lg[e] > v1) { v1 = lg[e]; e1 = e; }
            const float ex = __expf(v1 - v0), g0 = 1.0f / (1.0f + ex), g1 = ex / (1.0f + ex);
            if (lane == 0) { le0[lr] = e0; le1[lr] = e1; lg0[lr] = g0; lg1[lr] = g1; }
        }
        __syncthreads();
        if (F.tid < 8) { const int e = F.tid; int c = 0;
            for (int r = 0; r < 64; ++r) c += (le0[r] == e) + (le1[r] == e);
            const unsigned base = c ? atomicAdd(cnt + e, (unsigned)c) : 0u; int p = (int)base;
            for (int r = 0; r < 64; ++r) { if (le0[r] == e) { lp0[r] = p; list[e * T + p] = row0 + r; ++p; } if (le1[r] == e) { lp1[r] = p; list[e * T + p] = row0 + r; ++p; } }
        }
        __syncthreads();
        if (F.tid < 64) { const int r = F.tid; int* ti = tokinfo + (size_t)(row0 + r) * 8;
            ti[0] = le0[r]; ti[1] = lp0[r]; ti[2] = le1[r]; ti[3] = lp1[r]; ((float*)ti)[4] = lg0[r]; ((float*)ti)[5] = lg1[r]; }
        __syncthreads();
    }
}
struct MoEMeta { int rb[9]; int tiles[8]; };
__device__ __forceinline__ void moe_meta(Frame& F, MoEMeta& mm) {
    const unsigned* cnt = (const unsigned*)(F.ws + WS_CTL) + CW_CNT; int acc = 0;
#pragma unroll
    for (int e = 0; e < 8; ++e) { const int c = (int)__builtin_amdgcn_readfirstlane(__hip_atomic_load(cnt + e, __ATOMIC_RELAXED, __HIP_MEMORY_SCOPE_AGENT)); mm.rb[e] = acc; mm.tiles[e] = (c + 255) >> 8; acc += mm.tiles[e] * 256; }
    mm.rb[8] = acc;
}
__device__ __forceinline__ void gather_phase(Frame& F) {
    MoEMeta mm; moe_meta(F, mm);
    const unsigned* cnt = (const unsigned*)(F.ws + WS_CTL) + CW_CNT; const int* list = (const int*)(F.ws + WS_LIST);
    const bf16_t* H = (const bf16_t*)(F.ws + WS_H); bf16_t* XG = (bf16_t*)(F.ws + WS_XG);
    const int gw = F.bid * NWAVES + F.wave, NGW = F.G * NWAVES, lane = F.lane;
#pragma unroll
    for (int e = 0; e < 8; ++e) { const int c = (int)__hip_atomic_load(cnt + e, __ATOMIC_RELAXED, __HIP_MEMORY_SCOPE_AGENT);
        for (int p = gw; p < c; p += NGW) { const int tok = list[e * T + p];
            const u32x4* s = (const u32x4*)(H + (size_t)tok * D) + lane; u32x4* d = (u32x4*)(XG + (size_t)(mm.rb[e] + p) * D) + lane;
            d[0] = s[0]; d[64] = s[64]; } }
}
__device__ __forceinline__ void final_phase(Frame& F) {
    MoEMeta mm; moe_meta(F, mm);
    const int* tokinfo = (const int*)(F.ws + WS_TOKINFO); const bf16_t* YS = (const bf16_t*)(F.ws + WS_XG);
    const float* mod = (const float*)(F.ws + WS_MOD) + (size_t)1 * 2 * 6144; const float* fg = F.in[I_FING];
    const int gw = F.bid * NWAVES + F.wave, NGW = F.G * NWAVES, lane = F.lane;
    for (int m = gw; m < T; m += NGW) {
        const int* ti = tokinfo + (size_t)m * 8; const int e0 = ti[0], p0 = ti[1], e1 = ti[2], p1 = ti[3]; const float g0 = ((const float*)ti)[4], g1 = ((const float*)ti)[5];
        int r0 = 0, r1 = 0;
#pragma unroll
        for (int e = 0; e < 8; ++e) { if (e == e0) r0 = mm.rb[e] + p0; if (e == e1) r1 = mm.rb[e] + p1; }
        const int b = m >> 13; const float* gf = mod + b * 6144 + 5 * 1024;
        float* xr = F.out + (size_t)m * D; f32x4 v[4]; float s = 0.f;
#pragma unroll
        for (int j = 0; j < 4; ++j) { const int c = 4 * lane + 256 * j;
            const f32x4 x = *(const f32x4*)(xr + c), gg = *(const f32x4*)(gf + c);
            const u32x2 y0 = *(const u32x2*)(YS + (size_t)r0 * D + c), y1 = *(const u32x2*)(YS + (size_t)r1 * D + c);
            f32x4 y; y.x = g0 * __uint_as_float(y0.x << 16) + g1 * __uint_as_float(y1.x << 16); y.y = g0 * __uint_as_float(y0.x & 0xffff0000u) + g1 * __uint_as_float(y1.x & 0xffff0000u);
            y.z = g0 * __uint_as_float(y0.y << 16) + g1 * __uint_as_float(y1.y << 16); y.w = g0 * __uint_as_float(y0.y & 0xffff0000u) + g1 * __uint_as_float(y1.y & 0xffff0000u);
            v[j] = (f32x4){x.x + gg.x * y.x, x.y + gg.y * y.y, x.z + gg.z * y.z, x.w + gg.w * y.w};
            s += (v[j].x * v[j].x + v[j].y * v[j].y) + (v[j].z * v[j].z + v[j].w * v[j].w); }
        const float rstd = rsqrtf(wave_sum(s) * (1.0f / D) + RMS_EPS);
#pragma unroll
        for (int j = 0; j < 4; ++j) { const int c = 4 * lane + 256 * j; const f32x4 g4 = *(const f32x4*)(fg + c);
            *(f32x4*)(xr + c) = (f32x4){v[j].x * rstd * g4.x, v[j].y * rstd * g4.y, v[j].z * rstd * g4.z, v[j].w * rstd * g4.w}; }
    }
}

constexpr int NPH = 22;
constexpr int LDS_BYTES = 147456;

__global__ void __launch_bounds__(NTHREADS, 2) mega(Args args) {
    extern __shared__ __attribute__((aligned(16))) unsigned char lds[];
    Frame F; F.lds = lds; F.tid = threadIdx.x; F.lane = F.tid & 63; F.wave = __builtin_amdgcn_readfirstlane(F.tid >> 6);
    F.G = gridDim.x; F.bid = blockIdx.x; F.out = args.out; F.ws = args.ws;
#pragma unroll
    for (int i = 0; i < 34; ++i) F.in[i] = args.in[i];
    unsigned char* ws = args.ws;
    const int lo = args.lo, hi = args.hi;
#if MK_ONE_LAUNCH
    cg::grid_group grid = cg::this_grid();
#define GRID_BAR() grid.sync()
#else
#define GRID_BAR() do {} while (0)
#endif
#define IN(k) (lo <= (k) && (k) < hi)
#define SEAM(k) do { if (IN(k) && IN((k) + 1)) GRID_BAR(); } while (0)
    const float* mod = (const float*)(ws + WS_MOD);
    bf16_t* H = (bf16_t*)(ws + WS_H);

    if (IN(0)) { p0_prologue(F); } SEAM(0);
    if (IN(1)) { norm_phase(F, F.in[I_X], F.in[I_NMIX], 0, 0); } SEAM(1);
    if (IN(2)) { EpiIn E{(bf16_t*)(ws + WS_UA), (bf16_t*)(ws + WS_VA), (bf16_t*)(ws + WS_AC)};
        naive_gemm<false>(F, H, D, (const bf16_t*)(ws + WS_WIN), D, T, AB_IN, E, BOffNone{}); } SEAM(2);
    if (IN(3)) { EpiS5A E{(float*)(ws + WS_SS)};
        naive_gemm<false>(F, (const bf16_t*)(ws + WS_AC), 512, (const bf16_t*)(ws + WS_GTA), 256, 32768, 256, E, BOffDiag{});
        for (int u = F.bid; u < 512; u += F.G) sgu_unit(F, u); } SEAM(3);
    if (IN(4)) { const int gw = F.bid * NWAVES + F.wave; if (F.wave == 0) { for (int id = F.bid; id < 128; id += F.G) scan_wave(F, id); } (void)gw; } SEAM(4);
    if (IN(5)) { EpiS5C E{(const bf16_t*)(ws + WS_AC), F.in[I_S5D], (bf16_t*)(ws + WS_YG)};
        naive_gemm<false>(F, (const bf16_t*)(ws + WS_AC), 512, (const bf16_t*)(ws + WS_BTC), 512, 32768, 256, E, BOffDiag{}); } SEAM(5);
    if (IN(6)) { EpiGlu E{(const bf16_t*)(ws + WS_YG), (bf16_t*)(ws + WS_CAT)};
        naive_gemm<false>(F, (const bf16_t*)(ws + WS_YG), 512, (const bf16_t*)(ws + WS_WGLU), 512, T, 512, E, BOffNone{}); } SEAM(6);
    if (IN(7)) { EpiRes E{F.in[I_X], F.out, mod + 2 * 1024};
        naive_gemm<false>(F, (const bf16_t*)(ws + WS_CAT), D, (const bf16_t*)(ws + WS_WOUT), D, T, D, E, BOffNone{}); } SEAM(7);
    if (IN(8)) { norm_phase(F, F.out, F.in[I_NFFN], 0, 3); } SEAM(8);
    if (IN(9)) { EpiSwiglu E{(bf16_t*)(ws + WS_HF), D_FF};
        naive_gemm<true>(F, H, D, (const bf16_t*)(ws + WS_W13), D, T, D_FF, E, BOffNone{}); } SEAM(9);
    if (IN(10)) { EpiRes E{F.out, F.out, mod + 5 * 1024};
        naive_gemm<false>(F, (const bf16_t*)(ws + WS_HF), D_FF, (const bf16_t*)(ws + WS_W2), D_FF, T, D, E, BOffNone{}); } SEAM(10);
    if (IN(11)) { norm_phase(F, F.out, F.in[I_NMIX] + 1024, 1, 0); } SEAM(11);
    if (IN(12)) { EpiZ E{(float*)(ws + WS_Z)};
        naive_gemm<false>(F, H, D, (const bf16_t*)(ws + WS_WMIN), D, T, CINP, E, BOffNone{}); } SEAM(12);
    if (IN(13)) { zsplit_phase(F); } SEAM(13);
    if (IN(14)) { EpiQ Eq{(bf16_t*)(ws + WS_Q), (const f32x2*)(ws + WS_ROPE)};
        naive_gemm<false>(F, (const bf16_t*)(ws + WS_CQ), QL, (const bf16_t*)(ws + WS_WUQ), QL, T, NH * DQK, Eq, BOffNone{});
        EpiKV Ek{(bf16_t*)(ws + WS_K), (bf16_t*)(ws + WS_V)};
        naive_gemm<false>(F, (const bf16_t*)(ws + WS_CKV), KVL, (const bf16_t*)(ws + WS_WUKV), KVL, T, NH * 256, Ek, BOffNone{}); } SEAM(14);
    if (IN(15)) { naive_attn_phase(F); } SEAM(15);
    if (IN(16)) { EpiRes E{F.out, F.out, mod + 2 * 6144 + 2 * 1024};
        naive_gemm<false>(F, (const bf16_t*)(ws + WS_O), D, (const bf16_t*)(ws + WS_WO), D, T, D, E, BOffNone{}); } SEAM(16);
    if (IN(17)) { route_phase(F); } SEAM(17);
    if (IN(18)) { gather_phase(F); } SEAM(18);
    if (IN(19)) { MoEMeta mm; moe_meta(F, mm); BOffMoE bo;
#pragma unroll
        for (int e = 0; e < 9; ++e) bo.rb[e] = mm.rb[e]; bo.nper = 7168;
        EpiSwiglu E{(bf16_t*)(ws + WS_HM), D_FFE};
        naive_gemm<true>(F, (const bf16_t*)(ws + WS_XG), D, (const bf16_t*)(ws + WS_MW13), D, mm.rb[8], D_FFE, E, bo); } SEAM(19);
    if (IN(20)) { MoEMeta mm; moe_meta(F, mm); BOffMoE bo;
#pragma unroll
        for (int e = 0; e < 9; ++e) bo.rb[e] = mm.rb[e]; bo.nper = 1024;
        EpiYS E{(bf16_t*)(ws + WS_XG)};
        naive_gemm<false>(F, (const bf16_t*)(ws + WS_HM), D_FFE, (const bf16_t*)(ws + WS_MW2), D_FFE, mm.rb[8], D, E, bo); } SEAM(20);
    if (IN(21)) { final_phase(F); }
}

extern "C" void kernel_launch(void* const* d_in, const int* in_sizes, int n_in, void* d_out, int out_size, void* d_ws, size_t ws_size, hipStream_t stream) {
    static int grid = 0;
    if (grid == 0) {
        if (n_in != 34 || out_size != T * D || ws_size < WS_END) { fprintf(stderr, "kernel_launch: unexpected shapes n_in %d out %d ws %zu (need %zu)\n", n_in, out_size, ws_size, (size_t)WS_END); grid = -1; return; }
        int dev = 0, cus = 0, per_cu = 0;
        hipGetDevice(&dev); hipDeviceGetAttribute(&cus, hipDeviceAttributeMultiprocessorCount, dev);
        if (hipFuncSetAttribute((const void*)mega, hipFuncAttributeMaxDynamicSharedMemorySize, LDS_BYTES) != hipSuccess) { fprintf(stderr, "hipFuncSetAttribute failed\n"); grid = -1; return; }
        if (hipOccupancyMaxActiveBlocksPerMultiprocessor(&per_cu, (const void*)mega, NTHREADS, LDS_BYTES) != hipSuccess || per_cu < 1) { fprintf(stderr, "occupancy query failed (%d)\n", per_cu); per_cu = 1; }
        (void)hipGetLastError();
        grid = cus * per_cu;
    }
    if (grid < 0) return;
    hipMemsetAsync((char*)d_ws + WS_CTL, 0, CTL_BYTES, stream);
    Args a{};
    for (int i = 0; i < 34; ++i) a.in[i] = (const float*)d_in[i];
    a.out = (float*)d_out; a.ws = (unsigned char*)d_ws;
#if MK_ONE_LAUNCH
    a.lo = 0; a.hi = NPH;
    void* kargs[] = {&a};
    hipError_t e = hipLaunchCooperativeKernel((const void*)mega, dim3(grid), dim3(NTHREADS), kargs, LDS_BYTES, stream);
    if (e != hipSuccess) fprintf(stderr, "cooperative launch failed: %s (grid %d)\n", hipGetErrorString(e), grid);
#else
    for (int ph = 0; ph < NPH; ++ph) { a.lo = ph; a.hi = ph + 1; hipLaunchKernelGGL(mega, dim3(grid), dim3(NTHREADS), LDS_BYTES, stream, a); }
#endif
}
```

```cpp
#include <hip/hip_runtime.h>
#include <hip/hip_cooperative_groups.h>
#include <cstdio>
#include <cstdint>
namespace cg = cooperative_groups;

#ifndef MK_ONE_LAUNCH
#define MK_ONE_LAUNCH 1
#endif
#ifndef FAST_GEMM
#define FAST_GEMM 0
#endif
#ifndef FAST_ATTN
#define FAST_ATTN 0
#endif

#define LAS __attribute__((address_space(3)))
typedef unsigned short bf16_t;
typedef short bf16x8 __attribute__((ext_vector_type(8)));
typedef float f32x4 __attribute__((ext_vector_type(4)));
typedef float f32x2 __attribute__((ext_vector_type(2)));
typedef unsigned u32x4 __attribute__((ext_vector_type(4)));
typedef unsigned u32x2 __attribute__((ext_vector_type(2)));

constexpr int D = 1024, SEQ = 8192, NBATCH = 2, T = NBATCH * SEQ;
constexpr int A_W = 512, B_W = 512, AB_IN = 1536;
constexpr int D_FF = 2816, NEXP = 8, D_FFE = 3584;
constexpr int QL = 384, KVL = 256, CIN = 704, CINP = 768, NH = 8, DQK = 192, DV = 128;
constexpr float RMS_EPS = 1e-6f;
constexpr int NTHREADS = 512, NWAVES = 8;
constexpr int RT_MAX = 34816;
constexpr float QSCALE = 0.07216878364870323f * 1.4426950408889634f;

constexpr size_t MiB = 1u << 20;
constexpr size_t WS_CTL = 0, CTL_BYTES = 64 * 1024;
constexpr size_t WS_MOD = 1 * MiB;
constexpr size_t WS_TOKINFO = 1 * MiB + 256 * 1024;
constexpr size_t WS_LIST = 2 * MiB;
constexpr size_t WS_MW13 = 4 * MiB;
constexpr size_t WS_MW2 = 116 * MiB;
constexpr size_t WS_XG = 172 * MiB;
constexpr size_t WS_O = 172 * MiB;
constexpr size_t WS_V = 204 * MiB;
constexpr size_t WS_HM = 240 * MiB;
constexpr size_t WS_WIN = 240 * MiB, WS_WGLU = 243 * MiB, WS_WOUT = 244 * MiB, WS_W13 = 246 * MiB, WS_W2 = 257 * MiB;
constexpr size_t WS_WMIN = 263 * MiB, WS_WUQ = 265 * MiB, WS_WUKV = 267 * MiB, WS_WO = 268 * MiB;
constexpr size_t WS_GTA = 270 * MiB, WS_BTC = 274 * MiB, WS_ROPE = 282 * MiB, WS_A16 = 284 * MiB;
constexpr size_t WS_H = 285 * MiB;
constexpr size_t WS_UA = 317 * MiB, WS_VA = 333 * MiB, WS_AC = 349 * MiB, WS_SS = 381 * MiB, WS_YG = 413 * MiB, WS_CAT = 429 * MiB;
constexpr size_t WS_HF = 317 * MiB;
constexpr size_t WS_Z = 317 * MiB, WS_Q = 317 * MiB, WS_CQ = 365 * MiB, WS_CKV = 377 * MiB, WS_K = 385 * MiB;
constexpr size_t WS_END = 478 * MiB;
constexpr int CW_CNT = 0;
constexpr int CW_BAR = 1024;

__device__ __forceinline__ float bf2f(unsigned h) { return __uint_as_float(h << 16); }
__device__ __forceinline__ unsigned f2bf(float f) { unsigned u = __float_as_uint(f); return (u + 0x7fffu + ((u >> 16) & 1u)) >> 16; }
__device__ __forceinline__ unsigned pk2(float lo, float hi) { return f2bf(lo) | (f2bf(hi) << 16); }
__device__ __forceinline__ void unpack8(const u32x4 w, float (&f)[8]) {
    f[0] = __uint_as_float(w.x << 16); f[1] = __uint_as_float(w.x & 0xffff0000u);
    f[2] = __uint_as_float(w.y << 16); f[3] = __uint_as_float(w.y & 0xffff0000u);
    f[4] = __uint_as_float(w.z << 16); f[5] = __uint_as_float(w.z & 0xffff0000u);
    f[6] = __uint_as_float(w.w << 16); f[7] = __uint_as_float(w.w & 0xffff0000u);
}
__device__ __forceinline__ u32x4 pack8(const float (&f)[8]) {
    u32x4 w; w.x = pk2(f[0], f[1]); w.y = pk2(f[2], f[3]); w.z = pk2(f[4], f[5]); w.w = pk2(f[6], f[7]); return w;
}
__device__ __forceinline__ float sigmoidf_(float x) { return 1.0f / (1.0f + __expf(-x)); }
__device__ __forceinline__ float siluf_(float x) { return x / (1.0f + __expf(-x)); }
__device__ __forceinline__ float gelu_tanh(float x) { const float z = 1.5957691216057308f * (x + 0.044715f * x * x * x); return x / (1.0f + __expf(-z)); }
__device__ __forceinline__ float wave_sum(float v) {
#pragma unroll
    for (int o = 1; o < 64; o <<= 1) v += __shfl_xor(v, o);
    return v;
}
__device__ __forceinline__ float wave_max(float v) {
#pragma unroll
    for (int o = 1; o < 64; o <<= 1) v = fmaxf(v, __shfl_xor(v, o));
    return v;
}

struct Args { const float* in[34]; float* out; unsigned char* ws; int lo, hi; };
struct Frame {
    unsigned char* lds;
    int tid, lane, wave, G, bid;
    const float* in[34];
    float* out; unsigned char* ws;
};
enum { I_X = 0, I_C, I_ADAW, I_ADAB, I_NMIX, I_NFFN, I_FING, I_ABWIN, I_SGUVG, I_SGUWS, I_SGUBS, I_LAMRE, I_LAMIM, I_LOGDT,
       I_BRE, I_BIM, I_CRE, I_CIM, I_S5D, I_WGLU, I_ABWOUT, I_FW1, I_FW3, I_FW2, I_MWIN, I_QNG, I_KVNG, I_WUQ, I_WUKV, I_WO,
       I_ROUTER, I_MW1, I_MW3, I_MW2 };

__device__ __forceinline__ int rowmap(int kind, int n) {
    switch (kind) {
        case 1: return 256 * (n >> 7) + (n & 127);
        case 2: return 256 * (n >> 7) + 128 + (n & 127);
        case 3: { if (n < 640) return n; const int i = n - 640; return 640 + 2 * (i & 31) + (i >> 5); }
        case 4: { const int h = n / 192, r = n - h * 192; if (r < 128) return n; const int i = r - 128; return h * 192 + 128 + 2 * (i & 31) + (i >> 5); }
        default: return n;
    }
}
__device__ __forceinline__ void transpose_item(const float* W, int N, bf16_t* WT, int ldd, int kind, float* scr, int kb, int nb, int lane) {
    const int k0 = 64 * kb, n0 = 32 * nb;
#pragma unroll 8
    for (int i = 0; i < 32; ++i) { const int kk = 2 * i + (lane >> 5); scr[kk * 33 + (lane & 31)] = W[(size_t)(k0 + kk) * N + n0 + (lane & 31)]; }
    asm volatile("s_waitcnt lgkmcnt(0)" ::: "memory");
    const int c = lane & 7;
#pragma unroll
    for (int j = 0; j < 4; ++j) { const int n = (lane >> 3) + 8 * j; const float* s = scr + (8 * c) * 33 + n;
        u32x4 o; o.x = pk2(s[0 * 33], s[1 * 33]); o.y = pk2(s[2 * 33], s[3 * 33]); o.z = pk2(s[4 * 33], s[5 * 33]); o.w = pk2(s[6 * 33], s[7 * 33]);
        *(u32x4*)(WT + (size_t)rowmap(kind, n0 + n) * ldd + k0 + 8 * c) = o; }
    asm volatile("s_waitcnt lgkmcnt(0)" ::: "memory");
}


__device__ __forceinline__ void p0_adaln_unit(Frame& F, int unit) {
    float* silu_c = (float*)F.lds;
    float* red = (float*)(F.lds + 8192);
    const float* c = F.in[I_C];
    for (int i = F.tid; i < 2048; i += NTHREADS) silu_c[i] = siluf_(c[i]);
    __syncthreads();
    const int col = unit * 64, layer = col / 6144, j = col - layer * 6144;
    const float* w = F.in[I_ADAW] + (size_t)layer * 1024 * 6144 + j + F.lane;
    float a0 = 0.f, a1 = 0.f;
    const int kbeg = F.wave * 128;
#pragma unroll 8
    for (int k = kbeg; k < kbeg + 128; ++k) { const float wv = w[(size_t)k * 6144]; a0 += silu_c[k] * wv; a1 += silu_c[1024 + k] * wv; }
    red[(F.wave * 2 + 0) * 64 + F.lane] = a0; red[(F.wave * 2 + 1) * 64 + F.lane] = a1;
    __syncthreads();
    if (F.tid < 128) { const int b = F.tid >> 6, l = F.tid & 63; float s = 0.f;
#pragma unroll
        for (int wv = 0; wv < 8; ++wv) s += red[(wv * 2 + b) * 64 + l];
        s += F.in[I_ADAB][layer * 6144 + j + l];
        ((float*)(F.ws + WS_MOD))[(size_t)(layer * 2 + b) * 6144 + j + l] = s; }
    __syncthreads();
}

__device__ __forceinline__ void p0_s5_unit(Frame& F, int g) {
    float* Pre = (float*)F.lds;
    float* Pim = Pre + 2 * 17 * 64;
    float* BBre = Pim + 2 * 17 * 64;
    float* BBim = BBre + 2 * 64 * 16;
    float* Cre = BBim + 2 * 64 * 16;
    float* Cim = Cre + 2 * 16 * 64;
    float* Kt = Cim + 2 * 16 * 64;
    const float* lam_re = F.in[I_LAMRE]; const float* lam_im = F.in[I_LAMIM]; const float* log_dt = F.in[I_LOGDT];
    for (int idx = F.tid; idx < 2 * 17 * 64; idx += NTHREADS) {
        const int dir = idx / (17 * 64), r = idx - dir * 17 * 64, j = r >> 6, p = r & 63;
        const float dt = expf(log_dt[dir * 32 + g]);
        const float lr = lam_re[(dir * 32 + g) * 64 + p], li = lam_im[(dir * 32 + g) * 64 + p];
        const float mag = expf(lr * dt * (float)j); float sn, cs; sincosf(li * dt * (float)j, &sn, &cs);
        Pre[idx] = mag * cs; Pim[idx] = mag * sn;
    }
    for (int idx = F.tid; idx < 2 * 16 * 64; idx += NTHREADS) {
        const int dir = idx >> 10, r = idx & 1023;
        Cre[idx] = F.in[I_CRE][(size_t)(dir * 32 + g) * 1024 + r]; Cim[idx] = F.in[I_CIM][(size_t)(dir * 32 + g) * 1024 + r];
    }
    __syncthreads();
    for (int idx = F.tid; idx < 2 * 64 * 16; idx += NTHREADS) {
        const int dir = idx >> 10, r = idx & 1023, p = r >> 4;
        const float lr = lam_re[(dir * 32 + g) * 64 + p], li = lam_im[(dir * 32 + g) * 64 + p];
        const float ar = Pre[(dir * 17 + 1) * 64 + p], ai = Pim[(dir * 17 + 1) * 64 + p];
        const float den = lr * lr + li * li;
        const float fr = ((ar - 1.0f) * lr + ai * li) / den, fi = (ai * lr - (ar - 1.0f) * li) / den;
        const float br = F.in[I_BRE][(size_t)(dir * 32 + g) * 1024 + r], bi = F.in[I_BIM][(size_t)(dir * 32 + g) * 1024 + r];
        BBre[idx] = fr * br - fi * bi; BBim[idx] = fr * bi + fi * br;
    }
    __syncthreads();
    for (int idx = F.tid; idx < 2 * 16 * 16 * 16; idx += NTHREADS) {
        const int dir = idx >> 12, j = (idx >> 8) & 15, h = (idx >> 4) & 15, hp = idx & 15;
        float s = 0.f;
        for (int p = 0; p < 64; ++p) {
            const float cr = Cre[(dir * 16 + h) * 64 + p], ci = Cim[(dir * 16 + h) * 64 + p];
            const float pr = Pre[(dir * 17 + j) * 64 + p], pi = Pim[(dir * 17 + j) * 64 + p];
            const float xr = cr * pr - ci * pi, xi = cr * pi + ci * pr;
            s += xr * BBre[(dir * 64 + p) * 16 + hp] - xi * BBim[(dir * 64 + p) * 16 + hp];
        }
        Kt[idx] = s;
    }
    __syncthreads();
    bf16_t* GtA = (bf16_t*)(F.ws + WS_GTA) + (size_t)g * 256 * 256;
    for (int ch = F.tid; ch < 256 * 32; ch += NTHREADS) {
        const int np = ch >> 5, k0 = (ch & 31) * 8, dir = np >> 7, ri = (np >> 6) & 1, p = np & 63, s = k0 >> 4, h0 = k0 & 15;
        const int e = dir == 0 ? 15 - s : s;
        const float pr = Pre[(dir * 17 + e) * 64 + p], pi = Pim[(dir * 17 + e) * 64 + p];
        float v[8];
#pragma unroll
        for (int j = 0; j < 8; ++j) { const float br = BBre[(dir * 64 + p) * 16 + h0 + j], bi = BBim[(dir * 64 + p) * 16 + h0 + j];
            v[j] = ri == 0 ? (pr * br - pi * bi) : (pr * bi + pi * br); }
        *(u32x4*)(GtA + (size_t)np * 256 + k0) = pack8(v);
    }
    bf16_t* BtC = (bf16_t*)(F.ws + WS_BTC) + (size_t)g * 256 * 512;
    for (int ch = F.tid; ch < 256 * 64; ch += NTHREADS) {
        const int np = ch >> 6, k0 = (ch & 63) * 8, t = np >> 4, h = np & 15;
        float v[8];
        if (k0 < 256) {
            const int s = k0 >> 4, h0 = k0 & 15;
#pragma unroll
            for (int j = 0; j < 8; ++j) { float x = 0.f;
                if (t >= s) x += Kt[((0 * 16 + (t - s)) * 16 + h) * 16 + h0 + j];
                if (s >= t) x += Kt[((1 * 16 + (s - t)) * 16 + h) * 16 + h0 + j];
                v[j] = x; }
        } else {
            const int q = k0 - 256, dir = q >> 7, ri = (q >> 6) & 1, p0 = q & 63;
            const int e = dir == 0 ? t + 1 : 16 - t;
#pragma unroll
            for (int j = 0; j < 8; ++j) { const int p = p0 + j;
                const float cr = Cre[(dir * 16 + h) * 64 + p], ci = Cim[(dir * 16 + h) * 64 + p];
                const float pr = Pre[(dir * 17 + e) * 64 + p], pi = Pim[(dir * 17 + e) * 64 + p];
                v[j] = ri == 0 ? (cr * pr - ci * pi) : -(cr * pi + ci * pr); }
        }
        *(u32x4*)(BtC + (size_t)np * 512 + k0) = pack8(v);
    }
    if (F.tid < 128) { const int dir = F.tid >> 6, p = F.tid & 63;
        f32x2 a; a.x = Pre[(dir * 17 + 16) * 64 + p]; a.y = Pim[(dir * 17 + 16) * 64 + p];
        ((f32x2*)(F.ws + WS_A16))[(g * 2 + dir) * 64 + p] = a; }
    __syncthreads();
}

__device__ __forceinline__ void p0_tmat(Frame& F, float* scr, int& base, const float* src, bf16_t* dst, int K, int N, int ldd, int kind, int nrep, size_t src_rep, size_t dst_rep) {
    const int gw = F.bid * NWAVES + F.wave, NGW = F.G * NWAVES;
    const int nblk = N / 32, per = (K / 64) * nblk, tot = per * nrep;
    int first = gw - (base % NGW); if (first < 0) first += NGW;
    for (int it = first; it < tot; it += NGW) {
        const int rep = it / per, r = it - rep * per;
        transpose_item(src + (size_t)rep * src_rep, N, dst + (size_t)rep * dst_rep, ldd, kind, scr, r / nblk, r % nblk, F.lane);
    }
    base += tot;
}
__device__ __forceinline__ void p0_prologue(Frame& F) {
    for (int u = F.bid; u < 225; u += F.G) {
        if (u < 192) p0_adaln_unit(F, u);
        else if (u < 224) p0_s5_unit(F, u - 192);
        else { u32x4 z = {0u, 0u, 0u, 0u}; u32x4* dst = (u32x4*)((bf16_t*)(F.ws + WS_WMIN) + (size_t)704 * 1024);
            for (int i = F.tid; i < 64 * 1024 / 8; i += NTHREADS) dst[i] = z; }
    }
    __syncthreads();
    { f32x2* rope = (f32x2*)(F.ws + WS_ROPE);
      for (int idx = F.bid * NTHREADS + F.tid; idx < SEQ * 32; idx += F.G * NTHREADS) {
          const int l = idx >> 5, i = idx & 31;
          const float inv = powf(10000.0f, -(float)(2 * i) / 64.0f);
          const float ang = (float)l * inv; float sn, cs; sincosf(ang, &sn, &cs);
          f32x2 v; v.x = cs; v.y = sn; rope[idx] = v; } }
    float* scr = (float*)(F.lds + F.wave * 16384);
    unsigned char* ws = F.ws; int base = 0;
    p0_tmat(F, scr, base, F.in[I_ABWIN], (bf16_t*)(ws + WS_WIN), 1024, 1536, 1024, 0, 1, 0, 0);
    p0_tmat(F, scr, base, F.in[I_WGLU], (bf16_t*)(ws + WS_WGLU), 512, 512, 512, 0, 1, 0, 0);
    p0_tmat(F, scr, base, F.in[I_ABWOUT], (bf16_t*)(ws + WS_WOUT), 1024, 1024, 1024, 0, 1, 0, 0);
    p0_tmat(F, scr, base, F.in[I_FW1], (bf16_t*)(ws + WS_W13), 1024, 2816, 1024, 1, 1, 0, 0);
    p0_tmat(F, scr, base, F.in[I_FW3], (bf16_t*)(ws + WS_W13), 1024, 2816, 1024, 2, 1, 0, 0);
    p0_tmat(F, scr, base, F.in[I_FW2], (bf16_t*)(ws + WS_W2), 2816, 1024, 2816, 0, 1, 0, 0);
    p0_tmat(F, scr, base, F.in[I_MWIN], (bf16_t*)(ws + WS_WMIN), 1024, 704, 1024, 3, 1, 0, 0);
    p0_tmat(F, scr, base, F.in[I_WUQ], (bf16_t*)(ws + WS_WUQ), 384, 1536, 384, 4, 1, 0, 0);
    p0_tmat(F, scr, base, F.in[I_WUKV], (bf16_t*)(ws + WS_WUKV), 256, 2048, 256, 0, 1, 0, 0);
    p0_tmat(F, scr, base, F.in[I_WO], (bf16_t*)(ws + WS_WO), 1024, 1024, 1024, 0, 1, 0, 0);
    p0_tmat(F, scr, base, F.in[I_MW1], (bf16_t*)(ws + WS_MW13), 1024, 3584, 1024, 1, 8, (size_t)1024 * 3584, (size_t)7168 * 1024);
    p0_tmat(F, scr, base, F.in[I_MW3], (bf16_t*)(ws + WS_MW13), 1024, 3584, 1024, 2, 8, (size_t)1024 * 3584, (size_t)7168 * 1024);
    p0_tmat(F, scr, base, F.in[I_MW2], (bf16_t*)(ws + WS_MW2), 3584, 1024, 3584, 0, 8, (size_t)3584 * 1024, (size_t)1024 * 3584);
}

__device__ __forceinline__ void norm_row(const float* xrow, const float* gn, const float* sh, const float* sc, bf16_t* orow, int lane, f32x4 (&hv)[4]) {
    const f32x4* xr = (const f32x4*)xrow + lane;
    f32x4 v[4]; float s = 0.f;
#pragma unroll
    for (int j = 0; j < 4; ++j) { v[j] = xr[64 * j]; s += (v[j].x * v[j].x + v[j].y * v[j].y) + (v[j].z * v[j].z + v[j].w * v[j].w); }
    const float rstd = rsqrtf(wave_sum(s) * (1.0f / D) + RMS_EPS);
    u32x2* o8 = (u32x2*)orow + lane;
#pragma unroll
    for (int j = 0; j < 4; ++j) {
        const f32x4 g4 = ((const f32x4*)gn)[lane + 64 * j], s4 = ((const f32x4*)sh)[lane + 64 * j], c4 = ((const f32x4*)sc)[lane + 64 * j];
        f32x4 h; h.x = v[j].x * rstd * g4.x * (1.0f + c4.x) + s4.x; h.y = v[j].y * rstd * g4.y * (1.0f + c4.y) + s4.y;
        h.z = v[j].z * rstd * g4.z * (1.0f + c4.z) + s4.z; h.w = v[j].w * rstd * g4.w * (1.0f + c4.w) + s4.w;
        hv[j] = h; u32x2 w; w.x = pk2(h.x, h.y); w.y = pk2(h.z, h.w); o8[64 * j] = w; }
}
__device__ __forceinline__ void norm_phase(Frame& F, const float* X, const float* gn, int layer, int which_shift) {
    const float* mod = (const float*)(F.ws + WS_MOD) + (size_t)layer * 2 * 6144;
    bf16_t* H = (bf16_t*)(F.ws + WS_H);
    const int gw = F.bid * NWAVES + F.wave, NGW = F.G * NWAVES;
    for (int m = gw; m < T; m += NGW) { const int b = m >> 13; f32x4 hv[4];
        norm_row(X + (size_t)m * D, gn, mod + b * 6144 + which_shift * 1024, mod + b * 6144 + (which_shift + 1) * 1024, H + (size_t)m * D, F.lane, hv); }
}

__device__ __forceinline__ void zsplit_phase(Frame& F) {
    const float* Z = (const float*)(F.ws + WS_Z); bf16_t* CQ = (bf16_t*)(F.ws + WS_CQ); bf16_t* CKV = (bf16_t*)(F.ws + WS_CKV); bf16_t* Kf = (bf16_t*)(F.ws + WS_K);
    const f32x2* rope = (const f32x2*)(F.ws + WS_ROPE);
    const float* gq = F.in[I_QNG]; const float* gkv = F.in[I_KVNG];
    const int gw = F.bid * NWAVES + F.wave, NGW = F.G * NWAVES, lane = F.lane;
    for (int m = gw; m < T; m += NGW) {
        const float* z = Z + (size_t)m * CINP; const int b = m >> 13, l = m & (SEQ - 1);
        float q[6], kv[4]; float s = 0.f, s2 = 0.f;
#pragma unroll
        for (int j = 0; j < 6; ++j) { q[j] = z[lane + 64 * j]; s += q[j] * q[j]; }
#pragma unroll
        for (int j = 0; j < 4; ++j) { kv[j] = z[QL + lane + 64 * j]; s2 += kv[j] * kv[j]; }
        const float kr = z[QL + KVL + lane];
        const float r1 = rsqrtf(wave_sum(s) * (1.0f / QL) + RMS_EPS), r2 = rsqrtf(wave_sum(s2) * (1.0f / KVL) + RMS_EPS);
#pragma unroll
        for (int j = 0; j < 6; ++j) CQ[(size_t)m * QL + lane + 64 * j] = (bf16_t)f2bf(q[j] * r1 * gq[lane + 64 * j]);
#pragma unroll
        for (int j = 0; j < 4; ++j) CKV[(size_t)m * KVL + lane + 64 * j] = (bf16_t)f2bf(kv[j] * r2 * gkv[lane + 64 * j]);
        const float other = __shfl_xor(kr, 1); const int i = lane >> 1; const f32x2 cs = rope[l * 32 + i];
        const float x1 = (lane & 1) ? other : kr, x2 = (lane & 1) ? kr : other;
        const float o = (lane & 1) ? (x1 * cs.y + x2 * cs.x) : (x1 * cs.x - x2 * cs.y);
        const bf16_t ob = (bf16_t)f2bf(o);
#pragma unroll
        for (int hh = 0; hh < NH; ++hh) Kf[((size_t)(b * NH + hh) * SEQ + l) * DQK + 128 + lane] = ob;
    }
}

__device__ __forceinline__ void sgu_unit(Frame& F, int unit) {
    constexpr int PIT = 136;
    bf16_t* Ws = (bf16_t*)F.lds;
    bf16_t* Vt = Ws + 128 * PIT;
    const int g = unit & 3, n = (unit >> 2) & 63, b = unit >> 8;
    const int tok0 = b * SEQ + n * 128;
    const bf16_t* VA = (const bf16_t*)(F.ws + WS_VA); const bf16_t* UA = (const bf16_t*)(F.ws + WS_UA); bf16_t* CAT = (bf16_t*)(F.ws + WS_CAT);
    const int tid = F.tid, lane = F.lane;
    {
        const int tk = tid >> 2, c0 = (tid & 3) * 32;
        const u32x4* src = (const u32x4*)(VA + (size_t)(tok0 + tk) * A_W + g * 128 + c0);
        float v[32]; float s = 0.f;
#pragma unroll
        for (int j = 0; j < 4; ++j) { float f[8]; unpack8(src[j], f);
#pragma unroll
            for (int e = 0; e < 8; ++e) { v[j * 8 + e] = f[e]; s += f[e] * f[e]; } }
        s += __shfl_xor(s, 1); s += __shfl_xor(s, 2);
        const float rstd = rsqrtf(s * (1.0f / 128.0f) + RMS_EPS);
        const float* vg = F.in[I_SGUVG] + g * 128 + c0;
#pragma unroll
        for (int e = 0; e < 32; ++e) Vt[(c0 + e) * PIT + tk] = (bf16_t)f2bf(v[e] * rstd * vg[e]);
        const f32x4* wsrc = (const f32x4*)(F.in[I_SGUWS] + (size_t)g * 128 * 128 + (size_t)tk * 128 + c0);
#pragma unroll
        for (int j = 0; j < 4; ++j) { const f32x4 a = wsrc[2 * j], bq = wsrc[2 * j + 1];
            u32x4 w; w.x = pk2(a.x, a.y); w.y = pk2(a.z, a.w); w.z = pk2(bq.x, bq.y); w.w = pk2(bq.z, bq.w);
            *(u32x4*)(Ws + tk * PIT + c0 + 8 * j) = w; }
    }
    __syncthreads();
    f32x4 acc[8];
#pragma unroll
    for (int nn = 0; nn < 8; ++nn) acc[nn] = (f32x4){0.f, 0.f, 0.f, 0.f};
    const int fr = lane & 15, fq = lane >> 4, w = F.wave;
#pragma unroll
    for (int kk = 0; kk < 4; ++kk) {
        const bf16x8 a = *(const bf16x8*)(Ws + (16 * w + fr) * PIT + 32 * kk + 8 * fq);
#pragma unroll
        for (int nn = 0; nn < 8; ++nn) { const bf16x8 bv = *(const bf16x8*)(Vt + (16 * nn + fr) * PIT + 32 * kk + 8 * fq);
            acc[nn] = __builtin_amdgcn_mfma_f32_16x16x32_bf16(a, bv, acc[nn], 0, 0, 0); }
    }
    const float* bs = F.in[I_SGUBS] + g * 128;
#pragma unroll
    for (int nn = 0; nn < 8; ++nn)
#pragma unroll
        for (int i = 0; i < 4; ++i) { const int q = 16 * w + 4 * fq + i, c = 16 * nn + fr;
            const float sv = acc[nn][i] + bs[q];
            const size_t tok = (size_t)(tok0 + q);
            const float u = bf2f(UA[tok * A_W + g * 128 + c]);
            CAT[tok * D + g * 128 + c] = (bf16_t)f2bf(u * sv); }
    __syncthreads();
}

__device__ __forceinline__ void scan_wave(Frame& F, int id) {
    const int b = id >> 6, g = (id >> 1) & 31, dir = id & 1, p = F.lane;
    const float* SS = (const float*)(F.ws + WS_SS); bf16_t* AC = (bf16_t*)(F.ws + WS_AC);
    const f32x2 a16 = ((const f32x2*)(F.ws + WS_A16))[(g * 2 + dir) * 64 + p];
    float xr = 0.f, xi = 0.f;
    const size_t row0 = (size_t)g * 1024 + b * 512;
#pragma unroll 8
    for (int i = 0; i < 512; ++i) {
        const int blk = dir == 0 ? i : 511 - i; const size_t row = row0 + blk;
        const float sr = SS[row * 256 + dir * 128 + p], si = SS[row * 256 + dir * 128 + 64 + p];
        AC[row * 512 + 256 + dir * 128 + p] = (bf16_t)f2bf(xr); AC[row * 512 + 256 + dir * 128 + 64 + p] = (bf16_t)f2bf(xi);
        const float nr = a16.x * xr - a16.y * xi + sr, ni = a16.x * xi + a16.y * xr + si;
        xr = nr; xi = ni;
    }
}

struct EpiIn {
    bf16_t *UA, *VA, *AC;
    __device__ __forceinline__ void operator()(int row, int col, const float (&v)[8]) const {
        if (col < 1024) { float o[8];
#pragma unroll
            for (int j = 0; j < 8; ++j) o[j] = gelu_tanh(v[j]);
            bf16_t* dst = col < 512 ? UA + (size_t)row * A_W + col : VA + (size_t)row * A_W + (col - 512);
            *(u32x4*)dst = pack8(o);
        } else { const int cp = col - 1024, g = cp >> 4, h0 = cp & 15;
            *(u32x4*)(AC + ((size_t)g * 1024 + (row >> 4)) * 512 + (row & 15) * 16 + h0) = pack8(v); }
    }
};
struct EpiS5A {
    float* SS;
    __device__ __forceinline__ void operator()(int row, int col, const float (&v)[8]) const {
        float* d = SS + (size_t)row * 256 + (col & 255);
        *(f32x4*)d = (f32x4){v[0], v[1], v[2], v[3]}; *(f32x4*)(d + 4) = (f32x4){v[4], v[5], v[6], v[7]};
    }
};
struct EpiS5C {
    const bf16_t* AC; const float* dsk; bf16_t* YG;
    __device__ __forceinline__ void operator()(int row, int col, const float (&v)[8]) const {
        const int g = row >> 10, blk = row & 1023, cl = col & 255, t = cl >> 4, h0 = cl & 15;
        float u[8]; unpack8(*(const u32x4*)(AC + (size_t)row * 512 + cl), u);
        float o[8];
#pragma unroll
        for (int j = 0; j < 8; ++j) o[j] = gelu_tanh(v[j] + dsk[g * 16 + h0 + j] * u[j]);
        *(u32x4*)(YG + (size_t)(blk * 16 + t) * B_W + g * 16 + h0) = pack8(o);
    }
};
struct EpiGlu {
    const bf16_t* YG; bf16_t* CAT;
    __device__ __forceinline__ void operator()(int row, int col, const float (&v)[8]) const {
        float y[8]; unpack8(*(const u32x4*)(YG + (size_t)row * B_W + col), y); float o[8];
#pragma unroll
        for (int j = 0; j < 8; ++j) o[j] = y[j] * sigmoidf_(v[j]);
        *(u32x4*)(CAT + (size_t)row * D + 512 + col) = pack8(o);
    }
};
struct EpiRes {
    const float* Xin; float* X; const float* gate;
    __device__ __forceinline__ void operator()(int row, int col, const float (&v)[8]) const {
        const int b = row >> 13; const float* gt = gate + b * 6144 + col; const float* xi = Xin + (size_t)row * D + col; float* xo = X + (size_t)row * D + col;
        const f32x4 x0 = *(const f32x4*)xi, x1 = *(const f32x4*)(xi + 4), g0 = *(const f32x4*)gt, g1 = *(const f32x4*)(gt + 4);
        *(f32x4*)xo = (f32x4){x0.x + g0.x * v[0], x0.y + g0.y * v[1], x0.z + g0.z * v[2], x0.w + g0.w * v[3]};
        *(f32x4*)(xo + 4) = (f32x4){x1.x + g1.x * v[4], x1.y + g1.y * v[5], x1.z + g1.z * v[6], x1.w + g1.w * v[7]};
    }
};
struct EpiSwiglu {
    bf16_t* O; int ldo;
    __device__ __forceinline__ void operator()(int row, int col, const float (&a)[8], const float (&b)[8]) const {
        float o[8];
#pragma unroll
        for (int j = 0; j < 8; ++j) o[j] = siluf_(a[j]) * b[j];
        *(u32x4*)(O + (size_t)row * ldo + (col % ldo)) = pack8(o);
    }
};
struct EpiZ {
    float* Z;
    __device__ __forceinline__ void operator()(int row, int col, const float (&v)[8]) const {
        float* d = Z + (size_t)row * CINP + col;
        *(f32x4*)d = (f32x4){v[0], v[1], v[2], v[3]}; *(f32x4*)(d + 4) = (f32x4){v[4], v[5], v[6], v[7]};
    }
};
struct EpiQ {
    bf16_t* Q; const f32x2* rope;
    __device__ __forceinline__ void operator()(int row, int col, const float (&v)[8]) const {
        const int b = row >> 13, l = row & (SEQ - 1), h = col / 192, r = col - h * 192;
        float o[8];
        if (r < 128) {
#pragma unroll
            for (int j = 0; j < 8; ++j) o[j] = v[j] * QSCALE;
        } else { const int i0 = (r - 128) >> 1;
#pragma unroll
            for (int j = 0; j < 4; ++j) { const f32x2 cs = rope[l * 32 + i0 + j]; const float x1 = v[2 * j], x2 = v[2 * j + 1];
                o[2 * j] = (x1 * cs.x - x2 * cs.y) * QSCALE; o[2 * j + 1] = (x1 * cs.y + x2 * cs.x) * QSCALE; } }
        *(u32x4*)(Q + ((size_t)(b * NH + h) * SEQ + l) * DQK + r) = pack8(o);
    }
};
struct EpiKV {
    bf16_t *Kf, *V;
    __device__ __forceinline__ void operator()(int row, int col, const float (&v)[8]) const {
        const int b = row >> 13, l = row & (SEQ - 1), h = col >> 8, r = col & 255;
        bf16_t* d = r < 128 ? Kf + ((size_t)(b * NH + h) * SEQ + l) * DQK + r : V + ((size_t)(b * NH + h) * SEQ + l) * DV + (r - 128);
        *(u32x4*)d = pack8(v);
    }
};
struct EpiYS {
    bf16_t* YS;
    __device__ __forceinline__ void operator()(int row, int col, const float (&v)[8]) const { *(u32x4*)(YS + (size_t)row * D + (col & 1023)) = pack8(v); }
};

struct BOffNone { __device__ __forceinline__ int operator()(int) const { return 0; } };
struct BOffDiag { __device__ __forceinline__ int operator()(int row) const { return (row >> 10) * 256; } };
struct BOffMoE { int rb[9]; int nper;
    __device__ __forceinline__ int operator()(int row) const { int e = 0;
#pragma unroll
        for (int j = 1; j < 8; ++j) if (row >= rb[j]) e = j;
        return e * nper; } };

template <bool DUAL, class Epi, class BOff>
__device__ __forceinline__ void naive_gemm(Frame& F, const bf16_t* A, int lda, const bf16_t* Bt, int K, int M, int Ncols, const Epi& E, const BOff& boff) {
    const int ncg = Ncols / 8; const long total = (long)M * ncg;
    for (long it = (long)F.bid * NTHREADS + F.tid; it < total; it += (long)F.G * NTHREADS) {
        const int cgp = (int)(it / M), row = (int)(it - (long)cgp * M), col = cgp * 8;
        const int bo = boff(row);
        const bf16_t* a = A + (size_t)row * lda;
        if constexpr (!DUAL) {
            const bf16_t* bp = Bt + (size_t)(bo + col) * K;
            float acc[8];
#pragma unroll
            for (int j = 0; j < 8; ++j) acc[j] = 0.f;
            for (int k = 0; k < K; k += 8) { float av[8]; unpack8(*(const u32x4*)(a + k), av);
#pragma unroll
                for (int j = 0; j < 8; ++j) { float bv[8]; unpack8(*(const u32x4*)(bp + (size_t)j * K + k), bv);
#pragma unroll
                    for (int e = 0; e < 8; ++e) acc[j] += av[e] * bv[e]; } }
            E(row, bo + col, acc);
        } else {
            const int brow = 256 * (col >> 7) + (col & 127);
            const bf16_t* bp = Bt + (size_t)(bo + brow) * K;
            float acc[8], acc2[8];
#pragma unroll
            for (int j = 0; j < 8; ++j) { acc[j] = 0.f; acc2[j] = 0.f; }
            for (int k = 0; k < K; k += 8) { float av[8]; unpack8(*(const u32x4*)(a + k), av);
#pragma unroll
                for (int j = 0; j < 8; ++j) { float bv[8]; unpack8(*(const u32x4*)(bp + (size_t)j * K + k), bv); float cv[8]; unpack8(*(const u32x4*)(bp + (size_t)(128 + j) * K + k), cv);
#pragma unroll
                    for (int e = 0; e < 8; ++e) { acc[j] += av[e] * bv[e]; acc2[j] += av[e] * cv[e]; } } }
            E(row, bo / 2 + col, acc, acc2);
        }
    }
}

__device__ __forceinline__ void naive_attn_phase(Frame& F) {
    const bf16_t* Q = (const bf16_t*)(F.ws + WS_Q); const bf16_t* Kf = (const bf16_t*)(F.ws + WS_K); const bf16_t* V = (const bf16_t*)(F.ws + WS_V); bf16_t* O = (bf16_t*)(F.ws + WS_O);
    float* qs = (float*)(F.lds) + F.wave * 192;
    const int gw = F.bid * NWAVES + F.wave, NGW = F.G * NWAVES, lane = F.lane;
    for (int r = gw; r < NBATCH * NH * SEQ; r += NGW) {
        const int bh = r >> 13, l = r & (SEQ - 1), b = bh >> 3, h = bh & 7;
        const bf16_t* qrow = Q + (size_t)r * DQK;
        for (int i = lane; i < 192; i += 64) qs[i] = bf2f(qrow[i]);
        asm volatile("s_waitcnt lgkmcnt(0)" ::: "memory");
        float m = -1e30f, lsum = 0.f, o0 = 0.f, o1 = 0.f;
        const bf16_t* Kb = Kf + (size_t)bh * SEQ * DQK; const bf16_t* Vb = V + (size_t)bh * SEQ * DV;
        for (int j0 = 0; j0 < SEQ; j0 += 64) {
            const u32x4* kr = (const u32x4*)(Kb + (size_t)(j0 + lane) * DQK); float s = 0.f;
#pragma unroll 4
            for (int c = 0; c < 24; ++c) { float kv[8]; unpack8(kr[c], kv); const f32x4 q0 = *(const f32x4*)(qs + c * 8), q1 = *(const f32x4*)(qs + c * 8 + 4);
                s += q0.x * kv[0] + q0.y * kv[1] + q0.z * kv[2] + q0.w * kv[3] + q1.x * kv[4] + q1.y * kv[5] + q1.z * kv[6] + q1.w * kv[7]; }
            const float mn = fmaxf(m, wave_max(s)), alpha = exp2f(m - mn), pw = exp2f(s - mn);
            lsum = lsum * alpha + wave_sum(pw); m = mn; o0 *= alpha; o1 *= alpha;
            const unsigned* vp = (const unsigned*)(Vb + (size_t)j0 * DV) + lane;
#pragma unroll 8
            for (int j = 0; j < 64; ++j) { const float pj = __shfl(pw, j); const unsigned vv = vp[(size_t)j * (DV / 2)];
                o0 += pj * __uint_as_float(vv << 16); o1 += pj * __uint_as_float(vv & 0xffff0000u); }
        }
        const float inv = 1.0f / lsum;
        unsigned* orow = (unsigned*)(O + (size_t)(b * SEQ + l) * D + h * 128) + lane;
        *orow = pk2(o0 * inv, o1 * inv);
    }
}

__device__ __forceinline__ void route_phase(Frame& F) {
    const float* X = F.out; const float* gn = F.in[I_NFFN] + 1024; const float* mod = (const float*)(F.ws + WS_MOD) + (size_t)1 * 2 * 6144;
    bf16_t* H = (bf16_t*)(F.ws + WS_H); const float* wr = F.in[I_ROUTER];
    unsigned* cnt = (unsigned*)(F.ws + WS_CTL) + CW_CNT; int* list = (int*)(F.ws + WS_LIST); int* tokinfo = (int*)(F.ws + WS_TOKINFO);
    int* le0 = (int*)F.lds; int* le1 = le0 + 64; float* lg0 = (float*)(le1 + 64); float* lg1 = lg0 + 64; int* lp0 = (int*)(lg1 + 64); int* lp1 = lp0 + 64;
    const int lane = F.lane;
    for (int chunk = F.bid; chunk < T / 64; chunk += F.G) {
        const int row0 = chunk * 64;
        for (int rr = 0; rr < 8; ++rr) {
            const int lr = F.wave * 8 + rr, m = row0 + lr, b = m >> 13; f32x4 hv[4];
            norm_row(X + (size_t)m * D, gn, mod + b * 6144 + 3 * 1024, mod + b * 6144 + 4 * 1024, H + (size_t)m * D, lane, hv);
            float lg[8];
#pragma unroll
            for (int e = 0; e < 8; ++e) lg[e] = 0.f;
#pragma unroll
            for (int j = 0; j < 4; ++j) { const float hx[4] = {hv[j].x, hv[j].y, hv[j].z, hv[j].w};
#pragma unroll
                for (int q = 0; q < 4; ++q) { const int k = 4 * lane + 256 * j + q; const f32x4 w0 = *(const f32x4*)(wr + (size_t)k * 8), w1 = *(const f32x4*)(wr + (size_t)k * 8 + 4);
                    lg[0] += hx[q] * w0.x; lg[1] += hx[q] * w0.y; lg[2] += hx[q] * w0.z; lg[3] += hx[q] * w0.w;
                    lg[4] += hx[q] * w1.x; lg[5] += hx[q] * w1.y; lg[6] += hx[q] * w1.z; lg[7] += hx[q] * w1.w; } }
#pragma unroll
            for (int e = 0; e < 8; ++e) lg[e] = wave_sum(lg[e]);
            int e0 = 0; float v0 = lg[0];
#pragma unroll
            for (int e = 1; e < 8; ++e) if (lg[e] > v0) { v0 = lg[e]; e0 = e; }
            int e1 = -1; float v1 = -3.0e38f;
#pragma unroll
            for (int e = 0; e < 8; ++e) if (e != e0 && lg[e] > v1) { v1 = lg[e]; e1 = e; }
            const float ex = __expf(v1 - v0), g0 = 1.0f / (1.0f + ex), g1 = ex / (1.0f + ex);
            if (lane == 0) { le0[lr] = e0; le1[lr] = e1; lg0[lr] = g0; lg1[lr] = g1; }
        }
        __syncthreads();
        if (F.tid < 8) { const int e = F.tid; int c = 0;
            for (int r = 0; r < 64; ++r) c += (le0[r] == e) + (le1[r] == e);
            const unsigned base = c ? atomicAdd(cnt + e, (unsigned)c) : 0u; int p = (int)base;
            for (int r = 0; r < 64; ++r) { if (le0[r] == e) { lp0[r] = p; list[e * T + p] = row0 + r; ++p; } if (le1[r] == e) { lp1[r] = p; list[e * T + p] = row0 + r; ++p; } }
        }
        __syncthreads();
        if (F.tid < 64) { const int r = F.tid; int* ti = tokinfo + (size_t)(row0 + r) * 8;
            ti[0] = le0[r]; ti[1] = lp0[r]; ti[2] = le1[r]; ti[3] = lp1[r]; ((float*)ti)[4] = lg0[r]; ((float*)ti)[5] = lg1[r]; }
        __syncthreads();
    }
}
struct MoEMeta { int rb[9]; int tiles[8]; };
__device__ __forceinline__ void moe_meta(Frame& F, MoEMeta& mm) {
    const unsigned* cnt = (const unsigned*)(F.ws + WS_CTL) + CW_CNT; int acc = 0;
#pragma unroll
    for (int e = 0; e < 8; ++e) { const int c = (int)__builtin_amdgcn_readfirstlane(__hip_atomic_load(cnt + e, __ATOMIC_RELAXED, __HIP_MEMORY_SCOPE_AGENT)); mm.rb[e] = acc; mm.tiles[e] = (c + 255) >> 8; acc += mm.tiles[e] * 256; }
    mm.rb[8] = acc;
}
__device__ __forceinline__ void gather_phase(Frame& F) {
    MoEMeta mm; moe_meta(F, mm);
    const unsigned* cnt = (const unsigned*)(F.ws + WS_CTL) + CW_CNT; const int* list = (const int*)(F.ws + WS_LIST);
    const bf16_t* H = (const bf16_t*)(F.ws + WS_H); bf16_t* XG = (bf16_t*)(F.ws + WS_XG);
    const int gw = F.bid * NWAVES + F.wave, NGW = F.G * NWAVES, lane = F.lane;
#pragma unroll
    for (int e = 0; e < 8; ++e) { const int c = (int)__hip_atomic_load(cnt + e, __ATOMIC_RELAXED, __HIP_MEMORY_SCOPE_AGENT);
        for (int p = gw; p < c; p += NGW) { const int tok = list[e * T + p];
            const u32x4* s = (const u32x4*)(H + (size_t)tok * D) + lane; u32x4* d = (u32x4*)(XG + (size_t)(mm.rb[e] + p) * D) + lane;
            d[0] = s[0]; d[64] = s[64]; } }
}
__device__ __forceinline__ void final_phase(Frame& F) {
    MoEMeta mm; moe_meta(F, mm);
    const int* tokinfo = (const int*)(F.ws + WS_TOKINFO); const bf16_t* YS = (const bf16_t*)(F.ws + WS_XG);
    const float* mod = (const float*)(F.ws + WS_MOD) + (size_t)1 * 2 * 6144; const float* fg = F.in[I_FING];
    const int gw = F.bid * NWAVES + F.wave, NGW = F.G * NWAVES, lane = F.lane;
    for (int m = gw; m < T; m += NGW) {
        const int* ti = tokinfo + (size_t)m * 8; const int e0 = ti[0], p0 = ti[1], e1 = ti[2], p1 = ti[3]; const float g0 = ((const float*)ti)[4], g1 = ((const float*)ti)[5];
        int r0 = 0, r1 = 0;
#pragma unroll
        for (int e = 0; e < 8; ++e) { if (e == e0) r0 = mm.rb[e] + p0; if (e == e1) r1 = mm.rb[e] + p1; }
        const int b = m >> 13; const float* gf = mod + b * 6144 + 5 * 1024;
        float* xr = F.out + (size_t)m * D; f32x4 v[4]; float s = 0.f;
#pragma unroll
        for (int j = 0; j < 4; ++j) { const int c = 4 * lane + 256 * j;
            const f32x4 x = *(const f32x4*)(xr + c), gg = *(const f32x4*)(gf + c);
            const u32x2 y0 = *(const u32x2*)(YS + (size_t)r0 * D + c), y1 = *(const u32x2*)(YS + (size_t)r1 * D + c);
            f32x4 y; y.x = g0 * __uint_as_float(y0.x << 16) + g1 * __uint_as_float(y1.x << 16); y.y = g0 * __uint_as_float(y0.x & 0xffff0000u) + g1 * __uint_as_float(y1.x & 0xffff0000u);
            y.z = g0 * __uint_as_float(y0.y << 16) + g1 * __uint_as_float(y1.y << 16); y.w = g0 * __uint_as_float(y0.y & 0xffff0000u) + g1 * __uint_as_float(y1.y & 0xffff0000u);
            v[j] = (f32x4){x.x + gg.x * y.x, x.y + gg.y * y.y, x.z + gg.z * y.z, x.w + gg.w * y.w};
            s += (v[j].x * v[j].x + v[j].y * v[j].y) + (v[j].z * v[j].z + v[j].w * v[j].w); }
        const float rstd = rsqrtf(wave_sum(s) * (1.0f / D) + RMS_EPS);
#pragma unroll
        for (int j = 0; j < 4; ++j) { const int c = 4 * lane + 256 * j; const f32x4 g4 = *(const f32x4*)(fg + c);
            *(f32x4*)(xr + c) = (f32x4){v[j].x * rstd * g4.x, v[j].y * rstd * g4.y, v[j].z * rstd * g4.z, v[j].w * rstd * g4.w}; }
    }
}

constexpr int NPH = 22;
constexpr int LDS_BYTES = 147456;

__global__ void __launch_bounds__(NTHREADS, 2) mega(Args args) {
    extern __shared__ __attribute__((aligned(16))) unsigned char lds[];
    Frame F; F.lds = lds; F.tid = threadIdx.x; F.lane = F.tid & 63; F.wave = __builtin_amdgcn_readfirstlane(F.tid >> 6);
    F.G = gridDim.x; F.bid = blockIdx.x; F.out = args.out; F.ws = args.ws;
#pragma unroll
    for (int i = 0; i < 34; ++i) F.in[i] = args.in[i];
    unsigned char* ws = args.ws;
    const int lo = args.lo, hi = args.hi;
#if MK_ONE_LAUNCH
    cg::grid_group grid = cg::this_grid();
#define GRID_BAR() grid.sync()
#else
#define GRID_BAR() do {} while (0)
#endif
#define IN(k) (lo <= (k) && (k) < hi)
#define SEAM(k) do { if (IN(k) && IN((k) + 1)) GRID_BAR(); } while (0)
    const float* mod = (const float*)(ws + WS_MOD);
    bf16_t* H = (bf16_t*)(ws + WS_H);

    if (IN(0)) { p0_prologue(F); } SEAM(0);
    if (IN(1)) { norm_phase(F, F.in[I_X], F.in[I_NMIX], 0, 0); } SEAM(1);
    if (IN(2)) { EpiIn E{(bf16_t*)(ws + WS_UA), (bf16_t*)(ws + WS_VA), (bf16_t*)(ws + WS_AC)};
        naive_gemm<false>(F, H, D, (const bf16_t*)(ws + WS_WIN), D, T, AB_IN, E, BOffNone{}); } SEAM(2);
    if (IN(3)) { EpiS5A E{(float*)(ws + WS_SS)};
        naive_gemm<false>(F, (const bf16_t*)(ws + WS_AC), 512, (const bf16_t*)(ws + WS_GTA), 256, 32768, 256, E, BOffDiag{});
        for (int u = F.bid; u < 512; u += F.G) sgu_unit(F, u); } SEAM(3);
    if (IN(4)) { const int gw = F.bid * NWAVES + F.wave; if (F.wave == 0) { for (int id = F.bid; id < 128; id += F.G) scan_wave(F, id); } (void)gw; } SEAM(4);
    if (IN(5)) { EpiS5C E{(const bf16_t*)(ws + WS_AC), F.in[I_S5D], (bf16_t*)(ws + WS_YG)};
        naive_gemm<false>(F, (const bf16_t*)(ws + WS_AC), 512, (const bf16_t*)(ws + WS_BTC), 512, 32768, 256, E, BOffDiag{}); } SEAM(5);
    if (IN(6)) { EpiGlu E{(const bf16_t*)(ws + WS_YG), (bf16_t*)(ws + WS_CAT)};
        naive_gemm<false>(F, (const bf16_t*)(ws + WS_YG), 512, (const bf16_t*)(ws + WS_WGLU), 512, T, 512, E, BOffNone{}); } SEAM(6);
    if (IN(7)) { EpiRes E{F.in[I_X], F.out, mod + 2 * 1024};
        naive_gemm<false>(F, (const bf16_t*)(ws + WS_CAT), D, (const bf16_t*)(ws + WS_WOUT), D, T, D, E, BOffNone{}); } SEAM(7);
    if (IN(8)) { norm_phase(F, F.out, F.in[I_NFFN], 0, 3); } SEAM(8);
    if (IN(9)) { EpiSwiglu E{(bf16_t*)(ws + WS_HF), D_FF};
        naive_gemm<true>(F, H, D, (const bf16_t*)(ws + WS_W13), D, T, D_FF, E, BOffNone{}); } SEAM(9);
    if (IN(10)) { EpiRes E{F.out, F.out, mod + 5 * 1024};
        naive_gemm<false>(F, (const bf16_t*)(ws + WS_HF), D_FF, (const bf16_t*)(ws + WS_W2), D_FF, T, D, E, BOffNone{}); } SEAM(10);
    if (IN(11)) { norm_phase(F, F.out, F.in[I_NMIX] + 1024, 1, 0); } SEAM(11);
    if (IN(12)) { EpiZ E{(float*)(ws + WS_Z)};
        naive_gemm<false>(F, H, D, (const bf16_t*)(ws + WS_WMIN), D, T, CINP, E, BOffNone{}); } SEAM(12);
    if (IN(13)) { zsplit_phase(F); } SEAM(13);
    if (IN(14)) { EpiQ Eq{(bf16_t*)(ws + WS_Q), (const f32x2*)(ws + WS_ROPE)};
        naive_gemm<false>(F, (const bf16_t*)(ws + WS_CQ), QL, (const bf16_t*)(ws + WS_WUQ), QL, T, NH * DQK, Eq, BOffNone{});
        EpiKV Ek{(bf16_t*)(ws + WS_K), (bf16_t*)(ws + WS_V)};
        naive_gemm<false>(F, (const bf16_t*)(ws + WS_CKV), KVL, (const bf16_t*)(ws + WS_WUKV), KVL, T, NH * 256, Ek, BOffNone{}); } SEAM(14);
    if (IN(15)) { naive_attn_phase(F); } SEAM(15);
    if (IN(16)) { EpiRes E{F.out, F.out, mod + 2 * 6144 + 2 * 1024};
        naive_gemm<false>(F, (const bf16_t*)(ws + WS_O), D, (const bf16_t*)(ws + WS_WO), D, T, D, E, BOffNone{}); } SEAM(16);
    if (IN(17)) { route_phase(F); } SEAM(17);
    if (IN(18)) { gather_phase(F); } SEAM(18);
    if (IN(19)) { MoEMeta mm; moe_meta(F, mm); BOffMoE bo;
#pragma unroll
        for (int e = 0; e < 9; ++e) bo.rb[e] = mm.rb[e]; bo.nper = 7168;
        EpiSwiglu E{(bf16_t*)(ws + WS_HM), D_FFE};
        naive_gemm<true>(F, (const bf16_t*)(ws + WS_XG), D, (const bf16_t*)(ws + WS_MW13), D, mm.rb[8], D_FFE, E, bo); } SEAM(19);
    if (IN(20)) { MoEMeta mm; moe_meta(F, mm); BOffMoE bo;
#pragma unroll
        for (int e = 0; e < 9; ++e) bo.rb[e] = mm.rb[e]; bo.nper = 1024;
        EpiYS E{(bf16_t*)(ws + WS_XG)};
        naive_gemm<false>(F, (const bf16_t*)(ws + WS_HM), D_FFE, (const bf16_t*)(ws + WS_MW2), D_FFE, mm.rb[8], D, E, bo); } SEAM(20);
    if (IN(21)) { final_phase(F); }
}

extern "C" void kernel_launch(void* const* d_in, const int* in_sizes, int n_in, void* d_out, int out_size, void* d_ws, size_t ws_size, hipStream_t stream) {
    static int grid = 0;
    if (grid == 0) {
        if (n_in != 34 || out_size != T * D || ws_size < WS_END) { fprintf(stderr, "kernel_launch: unexpected shapes n_in %d out %d ws %zu (need %zu)\n", n_in, out_size, ws_size, (size_t)WS_END); grid = -1; return; }
        int dev = 0, cus = 0, per_cu = 0;
        hipGetDevice(&dev); hipDeviceGetAttribute(&cus, hipDeviceAttributeMultiprocessorCount, dev);
        if (hipFuncSetAttribute((const void*)mega, hipFuncAttributeMaxDynamicSharedMemorySize, LDS_BYTES) != hipSuccess) { fprintf(stderr, "hipFuncSetAttribute failed\n"); grid = -1; return; }
        if (hipOccupancyMaxActiveBlocksPerMultiprocessor(&per_cu, (const void*)mega, NTHREADS, LDS_BYTES) != hipSuccess || per_cu < 1) { fprintf(stderr, "occupancy query failed (%d)\n", per_cu); per_cu = 1; }
        (void)hipGetLastError();
        grid = cus * per_cu;
    }
    if (grid < 0) return;
    hipMemsetAsync((char*)d_ws + WS_CTL, 0, CTL_BYTES, stream);
    Args a{};
    for (int i = 0; i < 34; ++i) a.in[i] = (const float*)d_in[i];
    a.out = (float*)d_out; a.ws = (unsigned char*)d_ws;
#if MK_ONE_LAUNCH
    a.lo = 0; a.hi = NPH;
    void* kargs[] = {&a};
    hipError_t e = hipLaunchCooperativeKernel((const void*)mega, dim3(grid), dim3(NTHREADS), kargs, LDS_BYTES, stream);
    if (e != hipSuccess) fprintf(stderr, "cooperative launch failed: %s (grid %d)\n", hipGetErrorString(e), grid);
#else
    for (int ph = 0; ph < NPH; ++ph) { a.lo = ph; a.hi = ph + 1; hipLaunchKernelGGL(mega, dim3(grid), dim3(NTHREADS), LDS_BYTES, stream, a); }
#endif
}
```

```cpp
#include <hip/hip_runtime.h>
#include <hip/hip_cooperative_groups.h>
#include <cstdio>
#include <cstdint>
namespace cg = cooperative_groups;

#ifndef MK_ONE_LAUNCH
#define MK_ONE_LAUNCH 1
#endif
#ifndef FAST_GEMM
#define FAST_GEMM 1
#endif
#ifndef FAST_ATTN
#define FAST_ATTN 1
#endif

#define LAS __attribute__((address_space(3)))
typedef unsigned short bf16_t;
typedef short bf16x8 __attribute__((ext_vector_type(8)));
typedef float f32x4 __attribute__((ext_vector_type(4)));
typedef float f32x2 __attribute__((ext_vector_type(2)));
typedef unsigned u32x4 __attribute__((ext_vector_type(4)));
typedef unsigned u32x2 __attribute__((ext_vector_type(2)));

constexpr int D = 1024, SEQ = 8192, NBATCH = 2, T = NBATCH * SEQ;
constexpr int A_W = 512, B_W = 512, AB_IN = 1536;
constexpr int D_FF = 2816, NEXP = 8, D_FFE = 3584;
constexpr int QL = 384, KVL = 256, CIN = 704, CINP = 768, NH = 8, DQK = 192, DV = 128;
constexpr float RMS_EPS = 1e-6f;
constexpr int NTHREADS = 512, NWAVES = 8;
constexpr int RT_MAX = 34816;
constexpr float QSCALE = 0.07216878364870323f * 1.4426950408889634f;

constexpr size_t MiB = 1u << 20;
constexpr size_t WS_CTL = 0, CTL_BYTES = 64 * 1024;
constexpr size_t WS_MOD = 1 * MiB;
constexpr size_t WS_TOKINFO = 1 * MiB + 256 * 1024;
constexpr size_t WS_LIST = 2 * MiB;
constexpr size_t WS_MW13 = 4 * MiB;
constexpr size_t WS_MW2 = 116 * MiB;
constexpr size_t WS_XG = 172 * MiB;
constexpr size_t WS_O = 172 * MiB;
constexpr size_t WS_V = 204 * MiB;
constexpr size_t WS_HM = 240 * MiB;
constexpr size_t WS_WIN = 240 * MiB, WS_WGLU = 243 * MiB, WS_WOUT = 244 * MiB, WS_W13 = 246 * MiB, WS_W2 = 257 * MiB;
constexpr size_t WS_WMIN = 263 * MiB, WS_WUQ = 265 * MiB, WS_WUKV = 267 * MiB, WS_WO = 268 * MiB;
constexpr size_t WS_GTA = 270 * MiB, WS_BTC = 274 * MiB, WS_ROPE = 282 * MiB, WS_A16 = 284 * MiB;
constexpr size_t WS_H = 285 * MiB;
constexpr size_t WS_UA = 317 * MiB, WS_VA = 333 * MiB, WS_AC = 349 * MiB, WS_SS = 381 * MiB, WS_YG = 413 * MiB, WS_CAT = 429 * MiB;
constexpr size_t WS_HF = 317 * MiB;
constexpr size_t WS_Z = 317 * MiB, WS_Q = 317 * MiB, WS_CQ = 365 * MiB, WS_CKV = 377 * MiB, WS_K = 385 * MiB;
constexpr size_t WS_END = 478 * MiB;
constexpr int CW_CNT = 0;
constexpr int CW_BAR = 1024;

__device__ __forceinline__ float bf2f(unsigned h) { return __uint_as_float(h << 16); }
__device__ __forceinline__ unsigned f2bf(float f) { unsigned u = __float_as_uint(f); return (u + 0x7fffu + ((u >> 16) & 1u)) >> 16; }
__device__ __forceinline__ unsigned pk2(float lo, float hi) { return f2bf(lo) | (f2bf(hi) << 16); }
__device__ __forceinline__ void unpack8(const u32x4 w, float (&f)[8]) {
    f[0] = __uint_as_float(w.x << 16); f[1] = __uint_as_float(w.x & 0xffff0000u);
    f[2] = __uint_as_float(w.y << 16); f[3] = __uint_as_float(w.y & 0xffff0000u);
    f[4] = __uint_as_float(w.z << 16); f[5] = __uint_as_float(w.z & 0xffff0000u);
    f[6] = __uint_as_float(w.w << 16); f[7] = __uint_as_float(w.w & 0xffff0000u);
}
__device__ __forceinline__ u32x4 pack8(const float (&f)[8]) {
    u32x4 w; w.x = pk2(f[0], f[1]); w.y = pk2(f[2], f[3]); w.z = pk2(f[4], f[5]); w.w = pk2(f[6], f[7]); return w;
}
__device__ __forceinline__ float sigmoidf_(float x) { return 1.0f / (1.0f + __expf(-x)); }
__device__ __forceinline__ float siluf_(float x) { return x / (1.0f + __expf(-x)); }
__device__ __forceinline__ float gelu_tanh(float x) { const float z = 1.5957691216057308f * (x + 0.044715f * x * x * x); return x / (1.0f + __expf(-z)); }
__device__ __forceinline__ float wave_sum(float v) {
#pragma unroll
    for (int o = 1; o < 64; o <<= 1) v += __shfl_xor(v, o);
    return v;
}
__device__ __forceinline__ float wave_max(float v) {
#pragma unroll
    for (int o = 1; o < 64; o <<= 1) v = fmaxf(v, __shfl_xor(v, o));
    return v;
}

struct Args { const float* in[34]; float* out; unsigned char* ws; int lo, hi; };
struct Frame {
    unsigned char* lds;
    int tid, lane, wave, G, bid;
    const float* const* in;
    float* out; unsigned char* ws;
};
enum { I_X = 0, I_C, I_ADAW, I_ADAB, I_NMIX, I_NFFN, I_FING, I_ABWIN, I_SGUVG, I_SGUWS, I_SGUBS, I_LAMRE, I_LAMIM, I_LOGDT,
       I_BRE, I_BIM, I_CRE, I_CIM, I_S5D, I_WGLU, I_ABWOUT, I_FW1, I_FW3, I_FW2, I_MWIN, I_QNG, I_KVNG, I_WUQ, I_WUKV, I_WO,
       I_ROUTER, I_MW1, I_MW3, I_MW2 };

__device__ __forceinline__ int rowmap(int kind, int n) {
    switch (kind) {
        case 1: return 256 * (n >> 7) + (n & 127);
        case 2: return 256 * (n >> 7) + 128 + (n & 127);
        case 3: { if (n < 640) return n; const int i = n - 640; return 640 + 2 * (i & 31) + (i >> 5); }
        case 4: { const int h = n / 192, r = n - h * 192; if (r < 128) return n; const int i = r - 128; return h * 192 + 128 + 2 * (i & 31) + (i >> 5); }
        default: return n;
    }
}
__device__ __forceinline__ void transpose_item(const float* W, int N, bf16_t* WT, int ldd, int kind, float* scr, int kb, int nb, int lane) {
    const int k0 = 64 * kb, n0 = 32 * nb;
#pragma unroll 8
    for (int i = 0; i < 32; ++i) { const int kk = 2 * i + (lane >> 5); scr[kk * 33 + (lane & 31)] = W[(size_t)(k0 + kk) * N + n0 + (lane & 31)]; }
    asm volatile("s_waitcnt lgkmcnt(0)" ::: "memory");
    const int c = lane & 7;
#pragma unroll
    for (int j = 0; j < 4; ++j) { const int n = (lane >> 3) + 8 * j; const float* s = scr + (8 * c) * 33 + n;
        u32x4 o; o.x = pk2(s[0 * 33], s[1 * 33]); o.y = pk2(s[2 * 33], s[3 * 33]); o.z = pk2(s[4 * 33], s[5 * 33]); o.w = pk2(s[6 * 33], s[7 * 33]);
        *(u32x4*)(WT + (size_t)rowmap(kind, n0 + n) * ldd + k0 + 8 * c) = o; }
    asm volatile("s_waitcnt lgkmcnt(0)" ::: "memory");
}


__device__ __forceinline__ void p0_adaln_unit(Frame& F, int unit) {
    float* silu_c = (float*)F.lds;
    float* red = (float*)(F.lds + 8192);
    const float* c = F.in[I_C];
    for (int i = F.tid; i < 2048; i += NTHREADS) silu_c[i] = siluf_(c[i]);
    __syncthreads();
    const int col = unit * 64, layer = col / 6144, j = col - layer * 6144;
    const float* w = F.in[I_ADAW] + (size_t)layer * 1024 * 6144 + j + F.lane;
    float a0 = 0.f, a1 = 0.f;
    const int kbeg = F.wave * 128;
#pragma unroll 8
    for (int k = kbeg; k < kbeg + 128; ++k) { const float wv = w[(size_t)k * 6144]; a0 += silu_c[k] * wv; a1 += silu_c[1024 + k] * wv; }
    red[(F.wave * 2 + 0) * 64 + F.lane] = a0; red[(F.wave * 2 + 1) * 64 + F.lane] = a1;
    __syncthreads();
    if (F.tid < 128) { const int b = F.tid >> 6, l = F.tid & 63; float s = 0.f;
#pragma unroll
        for (int wv = 0; wv < 8; ++wv) s += red[(wv * 2 + b) * 64 + l];
        s += F.in[I_ADAB][layer * 6144 + j + l];
        ((float*)(F.ws + WS_MOD))[(size_t)(layer * 2 + b) * 6144 + j + l] = s; }
    __syncthreads();
}

__device__ __forceinline__ void p0_s5_unit(Frame& F, int g) {
    float* Pre = (float*)F.lds;
    float* Pim = Pre + 2 * 17 * 64;
    float* BBre = Pim + 2 * 17 * 64;
    float* BBim = BBre + 2 * 64 * 16;
    float* Cre = BBim + 2 * 64 * 16;
    float* Cim = Cre + 2 * 16 * 64;
    float* Kt = Cim + 2 * 16 * 64;
    const float* lam_re = F.in[I_LAMRE]; const float* lam_im = F.in[I_LAMIM]; const float* log_dt = F.in[I_LOGDT];
    for (int idx = F.tid; idx < 2 * 17 * 64; idx += NTHREADS) {
        const int dir = idx / (17 * 64), r = idx - dir * 17 * 64, j = r >> 6, p = r & 63;
        const float dt = expf(log_dt[dir * 32 + g]);
        const float lr = lam_re[(dir * 32 + g) * 64 + p], li = lam_im[(dir * 32 + g) * 64 + p];
        const float mag = expf(lr * dt * (float)j); float sn, cs; sincosf(li * dt * (float)j, &sn, &cs);
        Pre[idx] = mag * cs; Pim[idx] = mag * sn;
    }
    for (int idx = F.tid; idx < 2 * 16 * 64; idx += NTHREADS) {
        const int dir = idx >> 10, r = idx & 1023;
        Cre[idx] = F.in[I_CRE][(size_t)(dir * 32 + g) * 1024 + r]; Cim[idx] = F.in[I_CIM][(size_t)(dir * 32 + g) * 1024 + r];
    }
    __syncthreads();
    for (int idx = F.tid; idx < 2 * 64 * 16; idx += NTHREADS) {
        const int dir = idx >> 10, r = idx & 1023, p = r >> 4;
        const float lr = lam_re[(dir * 32 + g) * 64 + p], li = lam_im[(dir * 32 + g) * 64 + p];
        const float ar = Pre[(dir * 17 + 1) * 64 + p], ai = Pim[(dir * 17 + 1) * 64 + p];
        const float den = lr * lr + li * li;
        const float fr = ((ar - 1.0f) * lr + ai * li) / den, fi = (ai * lr - (ar - 1.0f) * li) / den;
        const float br = F.in[I_BRE][(size_t)(dir * 32 + g) * 1024 + r], bi = F.in[I_BIM][(size_t)(dir * 32 + g) * 1024 + r];
        BBre[idx] = fr * br - fi * bi; BBim[idx] = fr * bi + fi * br;
    }
    __syncthreads();
    for (int idx = F.tid; idx < 2 * 16 * 16 * 16; idx += NTHREADS) {
        const int dir = idx >> 12, j = (idx >> 8) & 15, h = (idx >> 4) & 15, hp = idx & 15;
        float s = 0.f;
        for (int p = 0; p < 64; ++p) {
            const float cr = Cre[(dir * 16 + h) * 64 + p], ci = Cim[(dir * 16 + h) * 64 + p];
            const float pr = Pre[(dir * 17 + j) * 64 + p], pi = Pim[(dir * 17 + j) * 64 + p];
            const float xr = cr * pr - ci * pi, xi = cr * pi + ci * pr;
            s += xr * BBre[(dir * 64 + p) * 16 + hp] - xi * BBim[(dir * 64 + p) * 16 + hp];
        }
        Kt[idx] = s;
    }
    __syncthreads();
    bf16_t* GtA = (bf16_t*)(F.ws + WS_GTA) + (size_t)g * 256 * 256;
    for (int ch = F.tid; ch < 256 * 32; ch += NTHREADS) {
        const int np = ch >> 5, k0 = (ch & 31) * 8, dir = np >> 7, ri = (np >> 6) & 1, p = np & 63, s = k0 >> 4, h0 = k0 & 15;
        const int e = dir == 0 ? 15 - s : s;
        const float pr = Pre[(dir * 17 + e) * 64 + p], pi = Pim[(dir * 17 + e) * 64 + p];
        float v[8];
#pragma unroll
        for (int j = 0; j < 8; ++j) { const float br = BBre[(dir * 64 + p) * 16 + h0 + j], bi = BBim[(dir * 64 + p) * 16 + h0 + j];
            v[j] = ri == 0 ? (pr * br - pi * bi) : (pr * bi + pi * br); }
        *(u32x4*)(GtA + (size_t)np * 256 + k0) = pack8(v);
    }
    bf16_t* BtC = (bf16_t*)(F.ws + WS_BTC) + (size_t)g * 256 * 512;
    for (int ch = F.tid; ch < 256 * 64; ch += NTHREADS) {
        const int np = ch >> 6, k0 = (ch & 63) * 8, t = np >> 4, h = np & 15;
        float v[8];
        if (k0 < 256) {
            const int s = k0 >> 4, h0 = k0 & 15;
#pragma unroll
            for (int j = 0; j < 8; ++j) { float x = 0.f;
                if (t >= s) x += Kt[((0 * 16 + (t - s)) * 16 + h) * 16 + h0 + j];
                if (s >= t) x += Kt[((1 * 16 + (s - t)) * 16 + h) * 16 + h0 + j];
                v[j] = x; }
        } else {
            const int q = k0 - 256, dir = q >> 7, ri = (q >> 6) & 1, p0 = q & 63;
            const int e = dir == 0 ? t + 1 : 16 - t;
#pragma unroll
            for (int j = 0; j < 8; ++j) { const int p = p0 + j;
                const float cr = Cre[(dir * 16 + h) * 64 + p], ci = Cim[(dir * 16 + h) * 64 + p];
                const float pr = Pre[(dir * 17 + e) * 64 + p], pi = Pim[(dir * 17 + e) * 64 + p];
                v[j] = ri == 0 ? (cr * pr - ci * pi) : -(cr * pi + ci * pr); }
        }
        *(u32x4*)(BtC + (size_t)np * 512 + k0) = pack8(v);
    }
    if (F.tid < 128) { const int dir = F.tid >> 6, p = F.tid & 63;
        f32x2 a; a.x = Pre[(dir * 17 + 16) * 64 + p]; a.y = Pim[(dir * 17 + 16) * 64 + p];
        ((f32x2*)(F.ws + WS_A16))[(g * 2 + dir) * 64 + p] = a; }
    __syncthreads();
}

__device__ __forceinline__ void p0_tmat(Frame& F, float* scr, int& base, const float* src, bf16_t* dst, int K, int N, int ldd, int kind, int nrep, size_t src_rep, size_t dst_rep) {
    const int gw = F.bid * NWAVES + F.wave, NGW = F.G * NWAVES;
    const int nblk = N / 32, per = (K / 64) * nblk, tot = per * nrep;
    int first = gw - (base % NGW); if (first < 0) first += NGW;
    for (int it = first; it < tot; it += NGW) {
        const int rep = it / per, r = it - rep * per;
        transpose_item(src + (size_t)rep * src_rep, N, dst + (size_t)rep * dst_rep, ldd, kind, scr, r / nblk, r % nblk, F.lane);
    }
    base += tot;
}
__device__ __forceinline__ void p0_prologue(Frame& F) {
    for (int u = F.bid; u < 225; u += F.G) {
        if (u < 192) p0_adaln_unit(F, u);
        else if (u < 224) p0_s5_unit(F, u - 192);
        else { u32x4 z = {0u, 0u, 0u, 0u}; u32x4* dst = (u32x4*)((bf16_t*)(F.ws + WS_WMIN) + (size_t)704 * 1024);
            for (int i = F.tid; i < 64 * 1024 / 8; i += NTHREADS) dst[i] = z; }
    }
    __syncthreads();
    { f32x2* rope = (f32x2*)(F.ws + WS_ROPE);
      for (int idx = F.bid * NTHREADS + F.tid; idx < SEQ * 32; idx += F.G * NTHREADS) {
          const int l = idx >> 5, i = idx & 31;
          const float inv = powf(10000.0f, -(float)(2 * i) / 64.0f);
          const float ang = (float)l * inv; float sn, cs; sincosf(ang, &sn, &cs);
          f32x2 v; v.x = cs; v.y = sn; rope[idx] = v; } }
    float* scr = (float*)(F.lds + F.wave * 16384);
    unsigned char* ws = F.ws; int base = 0;
    p0_tmat(F, scr, base, F.in[I_ABWIN], (bf16_t*)(ws + WS_WIN), 1024, 1536, 1024, 0, 1, 0, 0);
    p0_tmat(F, scr, base, F.in[I_WGLU], (bf16_t*)(ws + WS_WGLU), 512, 512, 512, 0, 1, 0, 0);
    p0_tmat(F, scr, base, F.in[I_ABWOUT], (bf16_t*)(ws + WS_WOUT), 1024, 1024, 1024, 0, 1, 0, 0);
    p0_tmat(F, scr, base, F.in[I_FW1], (bf16_t*)(ws + WS_W13), 1024, 2816, 1024, 1, 1, 0, 0);
    p0_tmat(F, scr, base, F.in[I_FW3], (bf16_t*)(ws + WS_W13), 1024, 2816, 1024, 2, 1, 0, 0);
    p0_tmat(F, scr, base, F.in[I_FW2], (bf16_t*)(ws + WS_W2), 2816, 1024, 2816, 0, 1, 0, 0);
    p0_tmat(F, scr, base, F.in[I_MWIN], (bf16_t*)(ws + WS_WMIN), 1024, 704, 1024, 3, 1, 0, 0);
    p0_tmat(F, scr, base, F.in[I_WUQ], (bf16_t*)(ws + WS_WUQ), 384, 1536, 384, 4, 1, 0, 0);
    p0_tmat(F, scr, base, F.in[I_WUKV], (bf16_t*)(ws + WS_WUKV), 256, 2048, 256, 0, 1, 0, 0);
    p0_tmat(F, scr, base, F.in[I_WO], (bf16_t*)(ws + WS_WO), 1024, 1024, 1024, 0, 1, 0, 0);
    p0_tmat(F, scr, base, F.in[I_MW1], (bf16_t*)(ws + WS_MW13), 1024, 3584, 1024, 1, 8, (size_t)1024 * 3584, (size_t)7168 * 1024);
    p0_tmat(F, scr, base, F.in[I_MW3], (bf16_t*)(ws + WS_MW13), 1024, 3584, 1024, 2, 8, (size_t)1024 * 3584, (size_t)7168 * 1024);
    p0_tmat(F, scr, base, F.in[I_MW2], (bf16_t*)(ws + WS_MW2), 3584, 1024, 3584, 0, 8, (size_t)3584 * 1024, (size_t)1024 * 3584);
}

__device__ __forceinline__ void norm_row(const float* xrow, const float* gn, const float* sh, const float* sc, bf16_t* orow, int lane, f32x4 (&hv)[4]) {
    const f32x4* xr = (const f32x4*)xrow + lane;
    f32x4 v[4]; float s = 0.f;
#pragma unroll
    for (int j = 0; j < 4; ++j) { v[j] = xr[64 * j]; s += (v[j].x * v[j].x + v[j].y * v[j].y) + (v[j].z * v[j].z + v[j].w * v[j].w); }
    const float rstd = rsqrtf(wave_sum(s) * (1.0f / D) + RMS_EPS);
    u32x2* o8 = (u32x2*)orow + lane;
#pragma unroll
    for (int j = 0; j < 4; ++j) {
        const f32x4 g4 = ((const f32x4*)gn)[lane + 64 * j], s4 = ((const f32x4*)sh)[lane + 64 * j], c4 = ((const f32x4*)sc)[lane + 64 * j];
        f32x4 h; h.x = v[j].x * rstd * g4.x * (1.0f + c4.x) + s4.x; h.y = v[j].y * rstd * g4.y * (1.0f + c4.y) + s4.y;
        h.z = v[j].z * rstd * g4.z * (1.0f + c4.z) + s4.z; h.w = v[j].w * rstd * g4.w * (1.0f + c4.w) + s4.w;
        hv[j] = h; u32x2 w; w.x = pk2(h.x, h.y); w.y = pk2(h.z, h.w); o8[64 * j] = w; }
}
__device__ __forceinline__ void norm_phase(Frame& F, const float* X, const float* gn, int layer, int which_shift) {
    const float* mod = (const float*)(F.ws + WS_MOD) + (size_t)layer * 2 * 6144;
    bf16_t* H = (bf16_t*)(F.ws + WS_H);
    const int gw = F.bid * NWAVES + F.wave, NGW = F.G * NWAVES;
    for (int m = gw; m < T; m += NGW) { const int b = m >> 13; f32x4 hv[4];
        norm_row(X + (size_t)m * D, gn, mod + b * 6144 + which_shift * 1024, mod + b * 6144 + (which_shift + 1) * 1024, H + (size_t)m * D, F.lane, hv); }
}

__device__ __forceinline__ void zsplit_phase(Frame& F) {
    const float* Z = (const float*)(F.ws + WS_Z); bf16_t* CQ = (bf16_t*)(F.ws + WS_CQ); bf16_t* CKV = (bf16_t*)(F.ws + WS_CKV); bf16_t* Kf = (bf16_t*)(F.ws + WS_K);
    const f32x2* rope = (const f32x2*)(F.ws + WS_ROPE);
    const float* gq = F.in[I_QNG]; const float* gkv = F.in[I_KVNG];
    const int gw = F.bid * NWAVES + F.wave, NGW = F.G * NWAVES, lane = F.lane;
    for (int m = gw; m < T; m += NGW) {
        const float* z = Z + (size_t)m * CINP; const int b = m >> 13, l = m & (SEQ - 1);
        float q[6], kv[4]; float s = 0.f, s2 = 0.f;
#pragma unroll
        for (int j = 0; j < 6; ++j) { q[j] = z[lane + 64 * j]; s += q[j] * q[j]; }
#pragma unroll
        for (int j = 0; j < 4; ++j) { kv[j] = z[QL + lane + 64 * j]; s2 += kv[j] * kv[j]; }
        const float kr = z[QL + KVL + lane];
        const float r1 = rsqrtf(wave_sum(s) * (1.0f / QL) + RMS_EPS), r2 = rsqrtf(wave_sum(s2) * (1.0f / KVL) + RMS_EPS);
#pragma unroll
        for (int j = 0; j < 6; ++j) CQ[(size_t)m * QL + lane + 64 * j] = (bf16_t)f2bf(q[j] * r1 * gq[lane + 64 * j]);
#pragma unroll
        for (int j = 0; j < 4; ++j) CKV[(size_t)m * KVL + lane + 64 * j] = (bf16_t)f2bf(kv[j] * r2 * gkv[lane + 64 * j]);
        const float other = __shfl_xor(kr, 1); const int i = lane >> 1; const f32x2 cs = rope[l * 32 + i];
        const float x1 = (lane & 1) ? other : kr, x2 = (lane & 1) ? kr : other;
        const float o = (lane & 1) ? (x1 * cs.y + x2 * cs.x) : (x1 * cs.x - x2 * cs.y);
        const bf16_t ob = (bf16_t)f2bf(o);
#pragma unroll
        for (int hh = 0; hh < NH; ++hh) Kf[((size_t)(b * NH + hh) * SEQ + l) * DQK + 128 + lane] = ob;
    }
}

__device__ __forceinline__ void sgu_unit(Frame& F, int unit) {
    constexpr int PIT = 136;
    bf16_t* Ws = (bf16_t*)F.lds;
    bf16_t* Vt = Ws + 128 * PIT;
    const int g = unit & 3, n = (unit >> 2) & 63, b = unit >> 8;
    const int tok0 = b * SEQ + n * 128;
    const bf16_t* VA = (const bf16_t*)(F.ws + WS_VA); const bf16_t* UA = (const bf16_t*)(F.ws + WS_UA); bf16_t* CAT = (bf16_t*)(F.ws + WS_CAT);
    const int tid = F.tid, lane = F.lane;
    {
        const int tk = tid >> 2, c0 = (tid & 3) * 32;
        const u32x4* src = (const u32x4*)(VA + (size_t)(tok0 + tk) * A_W + g * 128 + c0);
        float v[32]; float s = 0.f;
#pragma unroll
        for (int j = 0; j < 4; ++j) { float f[8]; unpack8(src[j], f);
#pragma unroll
            for (int e = 0; e < 8; ++e) { v[j * 8 + e] = f[e]; s += f[e] * f[e]; } }
        s += __shfl_xor(s, 1); s += __shfl_xor(s, 2);
        const float rstd = rsqrtf(s * (1.0f / 128.0f) + RMS_EPS);
        const float* vg = F.in[I_SGUVG] + g * 128 + c0;
#pragma unroll
        for (int e = 0; e < 32; ++e) Vt[(c0 + e) * PIT + tk] = (bf16_t)f2bf(v[e] * rstd * vg[e]);
        const f32x4* wsrc = (const f32x4*)(F.in[I_SGUWS] + (size_t)g * 128 * 128 + (size_t)tk * 128 + c0);
#pragma unroll
        for (int j = 0; j < 4; ++j) { const f32x4 a = wsrc[2 * j], bq = wsrc[2 * j + 1];
            u32x4 w; w.x = pk2(a.x, a.y); w.y = pk2(a.z, a.w); w.z = pk2(bq.x, bq.y); w.w = pk2(bq.z, bq.w);
            *(u32x4*)(Ws + tk * PIT + c0 + 8 * j) = w; }
    }
    __syncthreads();
    f32x4 acc[8];
#pragma unroll
    for (int nn = 0; nn < 8; ++nn) acc[nn] = (f32x4){0.f, 0.f, 0.f, 0.f};
    const int fr = lane & 15, fq = lane >> 4, w = F.wave;
#pragma unroll
    for (int kk = 0; kk < 4; ++kk) {
        const bf16x8 a = *(const bf16x8*)(Ws + (16 * w + fr) * PIT + 32 * kk + 8 * fq);
#pragma unroll
        for (int nn = 0; nn < 8; ++nn) { const bf16x8 bv = *(const bf16x8*)(Vt + (16 * nn + fr) * PIT + 32 * kk + 8 * fq);
            acc[nn] = __builtin_amdgcn_mfma_f32_16x16x32_bf16(a, bv, acc[nn], 0, 0, 0); }
    }
    const float* bs = F.in[I_SGUBS] + g * 128;
#pragma unroll
    for (int nn = 0; nn < 8; ++nn)
#pragma unroll
        for (int i = 0; i < 4; ++i) { const int q = 16 * w + 4 * fq + i, c = 16 * nn + fr;
            const float sv = acc[nn][i] + bs[q];
            const size_t tok = (size_t)(tok0 + q);
            const float u = bf2f(UA[tok * A_W + g * 128 + c]);
            CAT[tok * D + g * 128 + c] = (bf16_t)f2bf(u * sv); if (i == 3) asm volatile("" ::: "memory"); }
    __syncthreads();
}

__device__ __forceinline__ void scan_wave(Frame& F, int id) {
    const int b = id >> 6, g = (id >> 1) & 31, dir = id & 1, p = F.lane;
    const float* SS = (const float*)(F.ws + WS_SS); bf16_t* AC = (bf16_t*)(F.ws + WS_AC);
    const f32x2 a16 = ((const f32x2*)(F.ws + WS_A16))[(g * 2 + dir) * 64 + p];
    float xr = 0.f, xi = 0.f;
    const size_t row0 = (size_t)g * 1024 + b * 512;
#pragma unroll 8
    for (int i = 0; i < 512; ++i) {
        const int blk = dir == 0 ? i : 511 - i; const size_t row = row0 + blk;
        const float sr = SS[row * 256 + dir * 128 + p], si = SS[row * 256 + dir * 128 + 64 + p];
        AC[row * 512 + 256 + dir * 128 + p] = (bf16_t)f2bf(xr); AC[row * 512 + 256 + dir * 128 + 64 + p] = (bf16_t)f2bf(xi);
        const float nr = a16.x * xr - a16.y * xi + sr, ni = a16.x * xi + a16.y * xr + si;
        xr = nr; xi = ni;
    }
}

struct EpiIn {
    bf16_t *UA, *VA, *AC;
    __device__ __forceinline__ void operator()(int row, int col, const float (&v)[8]) const {
        if (col < 1024) { float o[8];
#pragma unroll
            for (int j = 0; j < 8; ++j) o[j] = gelu_tanh(v[j]);
            bf16_t* dst = col < 512 ? UA + (size_t)row * A_W + col : VA + (size_t)row * A_W + (col - 512);
            *(u32x4*)dst = pack8(o);
        } else { const int cp = col - 1024, g = cp >> 4, h0 = cp & 15;
            *(u32x4*)(AC + ((size_t)g * 1024 + (row >> 4)) * 512 + (row & 15) * 16 + h0) = pack8(v); }
    }
};
struct EpiS5A {
    float* SS;
    __device__ __forceinline__ void operator()(int row, int col, const float (&v)[8]) const {
        float* d = SS + (size_t)row * 256 + (col & 255);
        *(f32x4*)d = (f32x4){v[0], v[1], v[2], v[3]}; *(f32x4*)(d + 4) = (f32x4){v[4], v[5], v[6], v[7]};
    }
};
struct EpiS5C {
    const bf16_t* AC; const float* dsk; bf16_t* YG;
    __device__ __forceinline__ void operator()(int row, int col, const float (&v)[8]) const {
        const int g = row >> 10, blk = row & 1023, cl = col & 255, t = cl >> 4, h0 = cl & 15;
        float u[8]; unpack8(*(const u32x4*)(AC + (size_t)row * 512 + cl), u);
        float o[8];
#pragma unroll
        for (int j = 0; j < 8; ++j) o[j] = gelu_tanh(v[j] + dsk[g * 16 + h0 + j] * u[j]);
        *(u32x4*)(YG + (size_t)(blk * 16 + t) * B_W + g * 16 + h0) = pack8(o);
    }
};
struct EpiGlu {
    const bf16_t* YG; bf16_t* CAT;
    __device__ __forceinline__ void operator()(int row, int col, const float (&v)[8]) const {
        float y[8]; unpack8(*(const u32x4*)(YG + (size_t)row * B_W + col), y); float o[8];
#pragma unroll
        for (int j = 0; j < 8; ++j) o[j] = y[j] * sigmoidf_(v[j]);
        *(u32x4*)(CAT + (size_t)row * D + 512 + col) = pack8(o);
    }
};
struct EpiRes {
    const float* Xin; float* X; const float* gate;
    __device__ __forceinline__ void operator()(int row, int col, const float (&v)[8]) const {
        const int b = row >> 13; const float* gt = gate + b * 6144 + col; const float* xi = Xin + (size_t)row * D + col; float* xo = X + (size_t)row * D + col;
        const f32x4 x0 = *(const f32x4*)xi, x1 = *(const f32x4*)(xi + 4), g0 = *(const f32x4*)gt, g1 = *(const f32x4*)(gt + 4);
        *(f32x4*)xo = (f32x4){x0.x + g0.x * v[0], x0.y + g0.y * v[1], x0.z + g0.z * v[2], x0.w + g0.w * v[3]};
        *(f32x4*)(xo + 4) = (f32x4){x1.x + g1.x * v[4], x1.y + g1.y * v[5], x1.z + g1.z * v[6], x1.w + g1.w * v[7]};
    }
};
struct EpiSwiglu {
    bf16_t* O; int ldo;
    __device__ __forceinline__ void operator()(int row, int col, const float (&a)[8], const float (&b)[8]) const {
        float o[8];
#pragma unroll
        for (int j = 0; j < 8; ++j) o[j] = siluf_(a[j]) * b[j];
        *(u32x4*)(O + (size_t)row * ldo + (col % ldo)) = pack8(o);
    }
};
struct EpiZ {
    float* Z;
    __device__ __forceinline__ void operator()(int row, int col, const float (&v)[8]) const {
        float* d = Z + (size_t)row * CINP + col;
        *(f32x4*)d = (f32x4){v[0], v[1], v[2], v[3]}; *(f32x4*)(d + 4) = (f32x4){v[4], v[5], v[6], v[7]};
    }
};
struct EpiQ {
    bf16_t* Q;
    __device__ __forceinline__ void operator()(int row, int col, const float (&v)[8]) const {
        const int b = row >> 13, l = row & (SEQ - 1), h = col / 192, r = col - h * 192;
        float o[8];
#pragma unroll
        for (int j = 0; j < 8; ++j) o[j] = v[j] * QSCALE;
        *(u32x4*)(Q + ((size_t)(b * NH + h) * SEQ + l) * DQK + r) = pack8(o);
    }
};
struct EpiKV {
    bf16_t *Kf, *V;
    __device__ __forceinline__ void operator()(int row, int col, const float (&v)[8]) const {
        const int b = row >> 13, l = row & (SEQ - 1), h = col >> 8, r = col & 255;
        bf16_t* d = r < 128 ? Kf + ((size_t)(b * NH + h) * SEQ + l) * DQK + r : V + ((size_t)(b * NH + h) * SEQ + l) * DV + (r - 128);
        *(u32x4*)d = pack8(v);
    }
};
struct EpiYS {
    bf16_t* YS;
    __device__ __forceinline__ void operator()(int row, int col, const float (&v)[8]) const { *(u32x4*)(YS + (size_t)row * D + (col & 1023)) = pack8(v); }
};

struct BOffNone { __device__ __forceinline__ int operator()(int) const { return 0; } };
struct BOffDiag { __device__ __forceinline__ int operator()(int row) const { return (row >> 10) * 256; } };
struct BOffMoE { int rb[9]; int nper;
    __device__ __forceinline__ int operator()(int row) const { int e = 0;
#pragma unroll
        for (int j = 1; j < 8; ++j) if (row >= rb[j]) e = j;
        return e * nper; } };

template <bool DUAL, class Epi, class BOff>
__device__ __forceinline__ void naive_gemm(Frame& F, const bf16_t* A, int lda, const bf16_t* Bt, int K, int M, int Ncols, const Epi& E, const BOff& boff) {
    const int ncg = Ncols / 8; const long total = (long)M * ncg;
    for (long it = (long)F.bid * NTHREADS + F.tid; it < total; it += (long)F.G * NTHREADS) {
        const int cgp = (int)(it / M), row = (int)(it - (long)cgp * M), col = cgp * 8;
        const int bo = boff(row);
        const bf16_t* a = A + (size_t)row * lda;
        if constexpr (!DUAL) {
            const bf16_t* bp = Bt + (size_t)(bo + col) * K;
            float acc[8];
#pragma unroll
            for (int j = 0; j < 8; ++j) acc[j] = 0.f;
            for (int k = 0; k < K; k += 8) { float av[8]; unpack8(*(const u32x4*)(a + k), av);
#pragma unroll
                for (int j = 0; j < 8; ++j) { float bv[8]; unpack8(*(const u32x4*)(bp + (size_t)j * K + k), bv);
#pragma unroll
                    for (int e = 0; e < 8; ++e) acc[j] += av[e] * bv[e]; } }
            E(row, bo + col, acc);
        } else {
            const int brow = 256 * (col >> 7) + (col & 127);
            const bf16_t* bp = Bt + (size_t)(bo + brow) * K;
            float acc[8], acc2[8];
#pragma unroll
            for (int j = 0; j < 8; ++j) { acc[j] = 0.f; acc2[j] = 0.f; }
            for (int k = 0; k < K; k += 8) { float av[8]; unpack8(*(const u32x4*)(a + k), av);
#pragma unroll
                for (int j = 0; j < 8; ++j) { float bv[8]; unpack8(*(const u32x4*)(bp + (size_t)j * K + k), bv); float cv[8]; unpack8(*(const u32x4*)(bp + (size_t)(128 + j) * K + k), cv);
#pragma unroll
                    for (int e = 0; e < 8; ++e) { acc[j] += av[e] * bv[e]; acc2[j] += av[e] * cv[e]; } } }
            E(row, bo / 2 + col, acc, acc2);
        }
    }
}


namespace pg8 {
constexpr int BM = 256, BK = 64, HALF = 128, HTB = HALF * BK * 2, STAGE_BYTES = 8 * HTB, NXCD = 8, WGM = 8;
__host__ __device__ __forceinline__ int lds_byte(int r, int c) { const int st = (r >> 4) * 2 + (c >> 5), rr = r & 15, cc = c & 31, ob = rr * 64 + cc * 2; return st * 1024 + (ob ^ (((ob >> 9) & 1) << 5)); }
__host__ __device__ __forceinline__ void stage_rc(int b, int& R, int& C) { const int st = b / 1024, sb = b % 1024, swz = sb ^ (((sb >> 9) & 1) << 5); R = (st >> 1) * 16 + swz / 64; C = (st & 1) * 32 + (swz % 64) / 2; }
__host__ __device__ __forceinline__ int perm32(int rho) { const int n = rho >> 4, i = rho & 15; return 8 * (i >> 2) + 4 * n + (i & 3); }
struct Unit { int pm, pn; };
struct Gemm { const bf16_t* A; const bf16_t* Bt; int lda, K; };

struct StaticOrder {
    int nM, nN, nwg, G, c;
    __device__ void init(int M, int N, int G_, int c_) { nM = M / BM; nN = N / BM; nwg = nM * nN; G = G_; c = c_; }
    __device__ bool next(int i, Unit& u) const {
        const long L = (long)i * G + c; if (L >= nwg) return false;
        int wgid = (int)L; { const int q = nwg / NXCD, r = nwg % NXCD, xcd = wgid % NXCD, off = wgid / NXCD; wgid = (xcd < r ? xcd * (q + 1) : r * (q + 1) + (xcd - r) * q) + off; }
        const int nig = WGM * nN, gid = wgid / nig, fm = gid * WGM, gsz = (nM - fm) < WGM ? (nM - fm) : WGM;
        u.pm = fm + ((wgid % nig) % gsz); u.pn = (wgid % nig) / gsz; return true;
    }
};
struct DiagOrder {
    int n, G, c;
    __device__ bool next(int i, Unit& u) const { const int L = i * G + c; if (L >= n) return false; u.pm = L; u.pn = L >> 2; return true; }
};
struct MoEOrder {
    int ub[9], tb[8], tl[8]; int nN, G, c, nwg;
    __device__ bool next(int i, Unit& u) const {
        const int L = i * G + c; if (L >= nwg) return false;
        int wgid = L; { const int q = nwg / NXCD, r = nwg % NXCD, xcd = wgid % NXCD, off = wgid / NXCD; wgid = (xcd < r ? xcd * (q + 1) : r * (q + 1) + (xcd - r) * q) + off; }
        int e = 0, ube = 0, tbe = 0, tle = 1;
#pragma unroll
        for (int j = 0; j < 8; ++j) if (wgid >= ub[j] && wgid < ub[j + 1]) { e = j; ube = ub[j]; tbe = tb[j]; tle = tl[j]; }
        const int local = wgid - ube, nig = WGM * nN, gid = local / nig, fm = gid * WGM, gsz = (tle - fm) < WGM ? (tle - fm) : WGM;
        u.pm = tbe + fm + ((local % nig) % gsz); u.pn = e * nN + (local % nig) / gsz; return true;
    }
};

template <class Fn> struct Epi8 {
    static constexpr bool PERM = true; Fn f;
    __device__ __forceinline__ void operator()(const f32x4 (&acc)[2][2][4][2], const Unit& u, int wr, int wc, int fr, int fq) const {
#pragma unroll
        for (int ai = 0; ai < 2; ++ai)
#pragma unroll
            for (int m = 0; m < 4; ++m) { const int row = u.pm * BM + ai * HALF + wr * 64 + m * 16 + fr;
#pragma unroll
                for (int bj = 0; bj < 2; ++bj) { const int col = u.pn * BM + bj * HALF + wc * 32 + 8 * fq;
                    const f32x4 a = acc[ai][bj][m][0], b = acc[ai][bj][m][1];
                    const float v[8] = {a[0], a[1], a[2], a[3], b[0], b[1], b[2], b[3]}; f(row, col, v); }
                asm volatile("" ::: "memory"); }
    }
};
template <class Fn> struct Epi8Dual {
    static constexpr bool PERM = true; Fn f;
    __device__ __forceinline__ void operator()(const f32x4 (&acc)[2][2][4][2], const Unit& u, int wr, int wc, int fr, int fq) const {
#pragma unroll
        for (int ai = 0; ai < 2; ++ai)
#pragma unroll
            for (int m = 0; m < 4; ++m) { const int row = u.pm * BM + ai * HALF + wr * 64 + m * 16 + fr, col = u.pn * HALF + wc * 32 + 8 * fq;
                const f32x4 a0 = acc[ai][0][m][0], a1 = acc[ai][0][m][1], b0 = acc[ai][1][m][0], b1 = acc[ai][1][m][1];
                const float a[8] = {a0[0], a0[1], a0[2], a0[3], a1[0], a1[1], a1[2], a1[3]}; const float b[8] = {b0[0], b0[1], b0[2], b0[3], b1[0], b1[1], b1[2], b1[3]};
                f(row, col, a, b); }
    }
};

template <class Epi, class Sched, bool ALIGN_EPI>
__device__ __forceinline__ void gemm_phase(LAS unsigned char* lds, const Gemm g, const Sched& S, const Epi& E) {
    int tid_ = threadIdx.x; asm volatile("" : "+v"(tid_));
    const int tid = tid_, wid = __builtin_amdgcn_readfirstlane(tid >> 6), lane = tid & 63, wr = wid >> 2, wc = wid & 3, fr = lane & 15, fq = lane >> 4;
    const int K = g.K, nt = K / BK, lda = g.lda;
    unsigned voffA[2], voffB[2];
#pragma unroll
    for (int i = 0; i < 2; ++i) { int R, C; stage_rc(tid * 16 + i * 8192, R, C); const int Rb = Epi::PERM ? ((R & ~31) + perm32(R & 31)) : R;
        voffA[i] = (unsigned)(R * lda + C) * 2u; voffB[i] = (unsigned)(Rb * K + C) * 2u; }
    const size_t kstep = (size_t)(BK * 2);
    const size_t hstepA = (size_t)HALF * lda * 2, hstepB = (size_t)HALF * K * 2;
    const size_t tstepA = 2 * hstepA, tstepB = 2 * hstepB;
    const unsigned ldsw = (unsigned)wid * 1024u;
    const int aoff = lds_byte(wr * 64 + fr, fq * 8), boff = lds_byte(wc * 32 + fr, fq * 8);
#define PG8_SA(b, h) (((b) * 2 + (h)) * HTB)
#define PG8_SB(b, h) ((4 + (b) * 2 + (h)) * HTB)
#define PG8_STAGE(bufoff, gbase, voff) do { _Pragma("unroll") for (int _i = 0; _i < 2; ++_i) \
        __builtin_amdgcn_global_load_lds((const unsigned*)((const char*)(gbase) + (voff)[_i]), (LAS unsigned*)(lds + (bufoff) + ldsw + _i * 8192), 16, 0, 0); } while (0)
#define PG8_LDA(dst, b, h) do { _Pragma("unroll") for (int m = 0; m < 4; ++m) _Pragma("unroll") for (int k = 0; k < 2; ++k) dst[m][k] = *(const LAS bf16x8*)(lds + PG8_SA(b, h) + aoff + m * 2048 + k * 1024); } while (0)
#define PG8_LDB(dst, b, h) do { _Pragma("unroll") for (int n = 0; n < 2; ++n) _Pragma("unroll") for (int k = 0; k < 2; ++k) dst[n][k] = *(const LAS bf16x8*)(lds + PG8_SB(b, h) + boff + n * 2048 + k * 1024); } while (0)
#define PG8_MMA(ai, bj, At, Bt) do { __builtin_amdgcn_s_setprio(1); _Pragma("unroll") for (int m = 0; m < 4; ++m) _Pragma("unroll") for (int n = 0; n < 2; ++n) _Pragma("unroll") for (int k = 0; k < 2; ++k) \
        acc[ai][bj][m][n] = __builtin_amdgcn_mfma_f32_16x16x32_bf16(Bt[n][k], At[m][k], acc[ai][bj][m][n], 0, 0, 0); __builtin_amdgcn_s_setprio(0); } while (0)
#define PG8_WAIT_V(n) asm volatile("s_waitcnt vmcnt(" #n ")" ::: "memory")
#define PG8_WAIT_L(n) asm volatile("s_waitcnt lgkmcnt(" #n ")" ::: "memory")
#define PG8_BAR __builtin_amdgcn_s_barrier()
#define PG8_SCHED __builtin_amdgcn_sched_barrier(0)
    Unit cur, nxt; int ui = 0;
    if (!S.next(0, cur)) return;
    f32x4 acc[2][2][4][2];
#pragma unroll
    for (int a = 0; a < 2; ++a)
#pragma unroll
        for (int b = 0; b < 2; ++b)
#pragma unroll
            for (int m = 0; m < 4; ++m)
#pragma unroll
                for (int n = 0; n < 2; ++n) acc[a][b][m][n] = (f32x4){0.f, 0.f, 0.f, 0.f};
    bf16x8 At[4][2], B0[2][2], B1[2][2];
    const char* cA = (const char*)g.A + (size_t)cur.pm * tstepA; const char* cB = (const char*)g.Bt + (size_t)cur.pn * tstepB;
    PG8_STAGE(PG8_SB(0, 0), cB, voffB); PG8_STAGE(PG8_SB(0, 1), cB + hstepB, voffB); PG8_STAGE(PG8_SA(0, 0), cA, voffA); PG8_STAGE(PG8_SA(0, 1), cA + hstepA, voffA);
    if (wr == 1) PG8_BAR;
    PG8_WAIT_V(2); PG8_BAR;
    PG8_STAGE(PG8_SB(1, 0), cB + kstep, voffB); PG8_STAGE(PG8_SA(1, 0), cA + kstep, voffA); PG8_STAGE(PG8_SB(1, 1), cB + hstepB + kstep, voffB);
    PG8_WAIT_V(6); PG8_BAR;
    for (;;) {
        const bool has_next = S.next(ui + 1, nxt);
        const char* nA = has_next ? (const char*)g.A + (size_t)nxt.pm * tstepA : cA; const char* nB = has_next ? (const char*)g.Bt + (size_t)nxt.pn * tstepB : cB;
#pragma unroll 1
        for (int t = 0; t < nt; t += 2) {
            const bool last = (t == nt - 2);
            const char* a1 = cA + (size_t)(t + 1) * kstep;
            const char* a2 = last ? nA : cA + (size_t)(t + 2) * kstep; const char* b2 = last ? nB : cB + (size_t)(t + 2) * kstep;
            const char* a3 = a2 + kstep; const char* b3 = b2 + kstep;
            PG8_LDB(B0, 0, 0); PG8_LDB(B1, 0, 1); PG8_SCHED; PG8_LDA(At, 0, 0); PG8_STAGE(PG8_SA(1, 1), a1 + hstepA, voffA);
            PG8_WAIT_V(8); PG8_WAIT_L(0); PG8_BAR; PG8_MMA(0, 0, At, B0); PG8_MMA(0, 1, At, B1); PG8_BAR; PG8_SCHED;
            PG8_LDA(At, 0, 1); PG8_STAGE(PG8_SB(0, 0), b2, voffB); PG8_STAGE(PG8_SB(0, 1), b2 + hstepB, voffB); PG8_STAGE(PG8_SA(0, 0), a2, voffA);
            PG8_WAIT_V(8); PG8_WAIT_L(0); PG8_BAR; PG8_MMA(1, 0, At, B0); PG8_MMA(1, 1, At, B1); PG8_BAR; PG8_SCHED;
            PG8_LDB(B0, 1, 0); PG8_LDB(B1, 1, 1); PG8_SCHED; PG8_LDA(At, 1, 0); PG8_STAGE(PG8_SA(0, 1), a2 + hstepA, voffA);
            PG8_WAIT_V(8); PG8_WAIT_L(0); PG8_BAR; PG8_MMA(0, 0, At, B0); PG8_MMA(0, 1, At, B1); PG8_BAR; PG8_SCHED;
            PG8_LDA(At, 1, 1); PG8_STAGE(PG8_SB(1, 0), b3, voffB); PG8_STAGE(PG8_SB(1, 1), b3 + hstepB, voffB); PG8_STAGE(PG8_SA(1, 0), a3, voffA);
            PG8_WAIT_V(8); PG8_WAIT_L(0); PG8_BAR; PG8_MMA(1, 0, At, B0); PG8_MMA(1, 1, At, B1); PG8_BAR; PG8_SCHED;
        }
        if constexpr (ALIGN_EPI) { if (wr == 0) PG8_BAR; }
        E(acc, cur, wr, wc, fr, fq);
        if (!has_next) break;
#pragma unroll
        for (int a = 0; a < 2; ++a)
#pragma unroll
            for (int b = 0; b < 2; ++b)
#pragma unroll
                for (int m = 0; m < 4; ++m)
#pragma unroll
                    for (int n = 0; n < 2; ++n) acc[a][b][m][n] = (f32x4){0.f, 0.f, 0.f, 0.f};
        cur = nxt; cA = nA; cB = nB; ++ui;
        if constexpr (ALIGN_EPI) { if (wr == 1) PG8_BAR; }
    }
    PG8_WAIT_V(0);
    if constexpr (!ALIGN_EPI) { if (wr == 0) PG8_BAR; }
    PG8_BAR;
#undef PG8_SA
#undef PG8_SB
#undef PG8_STAGE
#undef PG8_LDA
#undef PG8_LDB
#undef PG8_MMA
#undef PG8_WAIT_V
#undef PG8_WAIT_L
#undef PG8_BAR
#undef PG8_SCHED
}
}

__device__ __forceinline__ void naive_attn_phase(Frame& F) {
    const bf16_t* Q = (const bf16_t*)(F.ws + WS_Q); const bf16_t* Kf = (const bf16_t*)(F.ws + WS_K); const bf16_t* V = (const bf16_t*)(F.ws + WS_V); bf16_t* O = (bf16_t*)(F.ws + WS_O);
    float* qs = (float*)(F.lds) + F.wave * 192;
    const int gw = F.bid * NWAVES + F.wave, NGW = F.G * NWAVES, lane = F.lane;
    for (int r = gw; r < NBATCH * NH * SEQ; r += NGW) {
        const int bh = r >> 13, l = r & (SEQ - 1), b = bh >> 3, h = bh & 7;
        const bf16_t* qrow = Q + (size_t)r * DQK;
        qs[lane] = bf2f(qrow[lane]); qs[64 + lane] = bf2f(qrow[64 + lane]);
        { const float qv = bf2f(qrow[128 + lane]), other = __shfl_xor(qv, 1); const f32x2 cs = ((const f32x2*)(F.ws + WS_ROPE))[l * 32 + (lane >> 1)];
          const float x1 = (lane & 1) ? other : qv, x2 = (lane & 1) ? qv : other;
          qs[128 + lane] = (lane & 1) ? (x1 * cs.y + x2 * cs.x) : (x1 * cs.x - x2 * cs.y); }
        asm volatile("s_waitcnt lgkmcnt(0)" ::: "memory");
        float m = -1e30f, lsum = 0.f, o0 = 0.f, o1 = 0.f;
        const bf16_t* Kb = Kf + (size_t)bh * SEQ * DQK; const bf16_t* Vb = V + (size_t)bh * SEQ * DV;
        for (int j0 = 0; j0 < SEQ; j0 += 64) {
            const u32x4* kr = (const u32x4*)(Kb + (size_t)(j0 + lane) * DQK); float s = 0.f;
#pragma unroll 4
            for (int c = 0; c < 24; ++c) { float kv[8]; unpack8(kr[c], kv); const f32x4 q0 = *(const f32x4*)(qs + c * 8), q1 = *(const f32x4*)(qs + c * 8 + 4);
                s += q0.x * kv[0] + q0.y * kv[1] + q0.z * kv[2] + q0.w * kv[3] + q1.x * kv[4] + q1.y * kv[5] + q1.z * kv[6] + q1.w * kv[7]; }
            const float mn = fmaxf(m, wave_max(s)), alpha = exp2f(m - mn), pw = exp2f(s - mn);
            lsum = lsum * alpha + wave_sum(pw); m = mn; o0 *= alpha; o1 *= alpha;
            const unsigned* vp = (const unsigned*)(Vb + (size_t)j0 * DV) + lane;
#pragma unroll 8
            for (int j = 0; j < 64; ++j) { const float pj = __shfl(pw, j); const unsigned vv = vp[(size_t)j * (DV / 2)];
                o0 += pj * __uint_as_float(vv << 16); o1 += pj * __uint_as_float(vv & 0xffff0000u); }
        }
        const float inv = 1.0f / lsum;
        unsigned* orow = (unsigned*)(O + (size_t)(b * SEQ + l) * D + h * 128) + lane;
        *orow = pk2(o0 * inv, o1 * inv);
    }
}


namespace fa {
using s16x4 = __attribute__((ext_vector_type(4))) short;
using f32x16 = __attribute__((ext_vector_type(16))) float;
constexpr int KVBLK = 64, QBLK = 32;
constexpr int SHM_V = KVBLK * DV * 2, SHM_K = KVBLK * DQK * 2;
constexpr int OFF_V = 0, OFF_K = 3 * SHM_V, OFF_WS = OFF_K + 2 * SHM_K, LDS_USED = OFF_WS + NWAVES * 64 * 4;
constexpr float THR = 8.0f;
#define FA_KSWZ(row, colB) ((row) * 384 + ((colB) ^ ((((row) >> 1) & 7) << 4)))
#define FA_SBAR() __builtin_amdgcn_sched_barrier(0)
__device__ __forceinline__ int crow(int r, int hi) { return (r & 3) + 8 * (r >> 2) + 4 * hi; }
__device__ __forceinline__ unsigned cvtpk(float lo, float hi) { unsigned r; asm volatile("v_cvt_pk_bf16_f32 %0, %1, %2" : "=v"(r) : "v"(lo), "v"(hi)); return r; }
__device__ __forceinline__ void partialSM(f32x16& p0, f32x16& p1, float& m_reg, float& alpha) {
    float pmax = p0[0];
#pragma unroll
    for (int r = 1; r < 16; ++r) pmax = fmaxf(pmax, p0[r]);
#pragma unroll
    for (int r = 0; r < 16; ++r) pmax = fmaxf(pmax, p1[r]);
    { auto rr = __builtin_amdgcn_permlane32_swap(__float_as_uint(pmax), __float_as_uint(pmax), false, false);
      pmax = fmaxf(__uint_as_float(rr[0]), __uint_as_float(rr[1])); }
    float mn;
    if (__builtin_expect(__all(pmax - m_reg <= THR), 1)) { mn = m_reg; alpha = 1.f; }
    else { mn = fmaxf(m_reg, pmax); alpha = __builtin_amdgcn_exp2f(m_reg - mn); m_reg = mn; }
#pragma unroll
    for (int r = 0; r < 16; ++r) p0[r] = p0[r] - mn;
#pragma unroll
    for (int r = 0; r < 16; ++r) p1[r] = p1[r] - mn;
#pragma unroll
    for (int r = 0; r < 16; ++r) p0[r] = __builtin_amdgcn_exp2f(p0[r]);
}
__device__ __forceinline__ void finishSM(f32x16& p0, f32x16& p1, float alpha, float& l_reg, bf16x8& pa0, bf16x8& pa1, bf16x8& pa2, bf16x8& pa3) {
#pragma unroll
    for (int r = 0; r < 16; ++r) p1[r] = __builtin_amdgcn_exp2f(p1[r]);
    float ps = 0;
#pragma unroll
    for (int r = 0; r < 16; ++r) ps += p0[r];
#pragma unroll
    for (int r = 0; r < 16; ++r) ps += p1[r];
    { auto rr = __builtin_amdgcn_permlane32_swap(__float_as_uint(ps), __float_as_uint(ps), false, false);
      ps = __uint_as_float(rr[0]) + __uint_as_float(rr[1]); }
    l_reg = l_reg * alpha + ps;
#define FA_PK4(P, BASE, OUT) do { unsigned a0 = cvtpk(P[BASE + 0], P[BASE + 1]), a1 = cvtpk(P[BASE + 2], P[BASE + 3]);   \
    unsigned b0 = cvtpk(P[BASE + 4], P[BASE + 5]), b1 = cvtpk(P[BASE + 6], P[BASE + 7]);                              \
    auto r0 = __builtin_amdgcn_permlane32_swap(a0, b0, false, false); auto r1 = __builtin_amdgcn_permlane32_swap(a1, b1, false, false); \
    u32x4 w = {r0[0], r1[0], r0[1], r1[1]}; OUT = __builtin_bit_cast(bf16x8, w); } while (0)
    FA_PK4(p0, 0, pa0); FA_PK4(p0, 8, pa1); FA_PK4(p1, 0, pa2); FA_PK4(p1, 8, pa3);
#undef FA_PK4
}
__device__ __forceinline__ void qkt(f32x16& p0, f32x16& p1, const LAS unsigned char* Ks, const int (&kb)[4], const bf16x8* qr) {
    p0 = f32x16{}; p1 = f32x16{};
#pragma unroll
    for (int d0 = 0; d0 < 12; ++d0) {
        const bf16x8 b0 = *(const LAS bf16x8*)(Ks + kb[d0 & 3] + 128 * (d0 >> 2));
        const bf16x8 b1 = *(const LAS bf16x8*)(Ks + kb[d0 & 3] + 128 * (d0 >> 2) + 32 * 384);
        p0 = __builtin_amdgcn_mfma_f32_32x32x16_bf16(b0, qr[d0], p0, 0, 0, 0);
        p1 = __builtin_amdgcn_mfma_f32_32x32x16_bf16(b1, qr[d0], p1, 0, 0, 0); }
}
__device__ __forceinline__ int v_st(int k, int c) { const int kk = (k & ~0xC) | ((k & 4) << 1) | ((k & 8) >> 1); return ((kk >> 3) * 4 + (c >> 5)) * 512 + ((kk & 7) * 32 + (c & 31)) * 2; }
__device__ __forceinline__ int v_rd_base(int lane) { return ((lane & 3) << 3) | (((lane >> 2) & 3) << 6) | (((lane >> 4) & 1) << 5) | (((lane >> 5) & 1) << 8); }
constexpr int v_rd_off(int d0, int ks, int half) { return d0 * 512 + ks * 4096 + half * 2048; }
template <int OFF> __device__ __forceinline__ s16x4 tr_read(int vb) {
    s16x4 r; asm volatile("ds_read_b64_tr_b16 %0, %1 offset:%2" : "=&v"(r) : "v"(vb), "i"(OFF) : "memory"); return r;
}
template <int D0> __device__ __forceinline__ void pv_one(f32x16& od, int vb, bf16x8 pa0, bf16x8 pa1, bf16x8 pa2, bf16x8 pa3) {
    const s16x4 l0 = tr_read<v_rd_off(D0, 0, 0)>(vb), h0 = tr_read<v_rd_off(D0, 0, 1)>(vb), l1 = tr_read<v_rd_off(D0, 1, 0)>(vb), h1 = tr_read<v_rd_off(D0, 1, 1)>(vb);
    const s16x4 l2 = tr_read<v_rd_off(D0, 2, 0)>(vb), h2 = tr_read<v_rd_off(D0, 2, 1)>(vb), l3 = tr_read<v_rd_off(D0, 3, 0)>(vb), h3 = tr_read<v_rd_off(D0, 3, 1)>(vb);
    asm volatile("s_waitcnt lgkmcnt(0)" ::: "memory"); FA_SBAR();
#define FA_PK(L, H) (bf16x8){L[0], L[1], L[2], L[3], H[0], H[1], H[2], H[3]}
    od = __builtin_amdgcn_mfma_f32_32x32x16_bf16(pa0, FA_PK(l0, h0), od, 0, 0, 0);
    od = __builtin_amdgcn_mfma_f32_32x32x16_bf16(pa1, FA_PK(l1, h1), od, 0, 0, 0);
    od = __builtin_amdgcn_mfma_f32_32x32x16_bf16(pa2, FA_PK(l2, h2), od, 0, 0, 0);
    od = __builtin_amdgcn_mfma_f32_32x32x16_bf16(pa3, FA_PK(l3, h3), od, 0, 0, 0);
#undef FA_PK
}
__device__ __forceinline__ void pv_d0(f32x16* o, int vb, bf16x8 pa0, bf16x8 pa1, bf16x8 pa2, bf16x8 pa3) {
    pv_one<0>(o[0], vb, pa0, pa1, pa2, pa3); pv_one<1>(o[1], vb, pa0, pa1, pa2, pa3); pv_one<2>(o[2], vb, pa0, pa1, pa2, pa3); pv_one<3>(o[3], vb, pa0, pa1, pa2, pa3);
}

__device__ __forceinline__ void attn_unit(int bh, int qb, const bf16_t* __restrict__ Q, const bf16_t* __restrict__ Kf, const bf16_t* __restrict__ V,
                                          bf16_t* __restrict__ O, const f32x2* __restrict__ rope, LAS unsigned char* lds) {
    int tid_ = threadIdx.x; asm volatile("" : "+v"(tid_));
    const int tid = tid_, wid = __builtin_amdgcn_readfirstlane(tid >> 6), lane = tid & 63, r32 = lane & 31, hi = lane >> 5;
    LAS unsigned char* V_lds = lds + OFF_V; LAS unsigned char* K_lds = lds + OFF_K;
    LAS float* wsf = (LAS float*)(lds + OFF_WS) + wid * 64; LAS float* li_l = wsf; LAS float* al_l = wsf + 32;
    const int q0 = qb * 256, b = bh >> 3, h = bh & 7;
    const bf16_t* Kh = Kf + (size_t)bh * SEQ * DQK; const bf16_t* Vh = V + (size_t)bh * SEQ * DV;
    unsigned ksrc[3], vsrc[2];
#pragma unroll
    for (int i = 0; i < 3; ++i) { const int q = (wid * 3 + i) * 64 + lane, row = q / 24, chp = q - row * 24, ch = chp ^ ((row >> 1) & 7); ksrc[i] = (unsigned)(row * DQK + ch * 8) * 2u; }
#pragma unroll
    for (int i = 0; i < 2; ++i) { const int q = (wid * 2 + i) * 64 + lane, c8 = q & 3, kklo = (q >> 2) & 7, chi = (q >> 5) & 3, kkhi = q >> 7, kk = kkhi * 8 + kklo;
        const int k = (kk & ~0xC) | ((kk & 4) << 1) | ((kk & 8) >> 1), c = chi * 32 + c8 * 8; vsrc[i] = (unsigned)(k * DV + c) * 2u; }
#define FA_DMA_K(t, slot) do { const char* kb_ = (const char*)Kh + (size_t)(t) * (KVBLK * DQK * 2); _Pragma("unroll") for (int i_ = 0; i_ < 3; ++i_) \
        __builtin_amdgcn_global_load_lds((const unsigned*)(kb_ + ksrc[i_]), (LAS unsigned*)(K_lds + (slot) * SHM_K + (wid * 3 + i_) * 1024), 16, 0, 0); } while (0)
#define FA_DMA_V(t, soff) do { const char* vb_ = (const char*)Vh + (size_t)(t) * (KVBLK * DV * 2); _Pragma("unroll") for (int i_ = 0; i_ < 2; ++i_) \
        __builtin_amdgcn_global_load_lds((const unsigned*)(vb_ + vsrc[i_]), (LAS unsigned*)(V_lds + (soff) + (wid * 2 + i_) * 1024), 16, 0, 0); } while (0)
#define FA_DRAIN_BAR() do { asm volatile("s_waitcnt vmcnt(0)" ::: "memory"); __syncthreads(); } while (0)
    FA_DMA_K(0, 0); FA_DMA_V(0, 0);
    float m_reg = -1e30f, l_reg = 0.f; f32x16 o[4] = {}; bf16x8 qr[12];
    {   const int l = q0 + wid * QBLK + r32;
        const bf16_t* Qw = Q + ((size_t)bh * SEQ + l) * DQK + hi * 8;
#pragma unroll
        for (int d0 = 0; d0 < 8; ++d0) qr[d0] = *(const bf16x8*)(Qw + d0 * 16);
#pragma unroll
        for (int d0 = 8; d0 < 12; ++d0) { float f[8]; unpack8(*(const u32x4*)(Qw + d0 * 16), f);
            const f32x4* cs = (const f32x4*)(rope + l * 32 + 8 * (d0 - 8) + 4 * hi); const f32x4 c0 = cs[0], c1 = cs[1];
            float g[8];
            g[0] = f[0] * c0.x - f[1] * c0.y; g[1] = f[0] * c0.y + f[1] * c0.x; g[2] = f[2] * c0.z - f[3] * c0.w; g[3] = f[2] * c0.w + f[3] * c0.z;
            g[4] = f[4] * c1.x - f[5] * c1.y; g[5] = f[4] * c1.y + f[5] * c1.x; g[6] = f[6] * c1.z - f[7] * c1.w; g[7] = f[6] * c1.w + f[7] * c1.z;
            qr[d0] = __builtin_bit_cast(bf16x8, pack8(g)); }
    }
    const int vb0 = (int)(unsigned)(uintptr_t)V_lds + v_rd_base(lane);
    int kb[4];
#pragma unroll
    for (int j = 0; j < 4; ++j) kb[j] = FA_KSWZ(r32, (j * 16 + hi * 8) * 2);
#define FA_RESC(a) do { if (__any((a) < 1.f)) { if (hi == 0) al_l[r32] = (a); asm volatile("s_waitcnt lgkmcnt(0)" ::: "memory"); \
        _Pragma("unroll") for (int d = 0; d < 4; ++d) _Pragma("unroll") for (int r = 0; r < 16; ++r) o[d][r] *= al_l[crow(r, hi)]; } } while (0)
    f32x16 pA0, pA1, pB0, pB1; float alA, alB; bf16x8 pa0, pa1, pa2, pa3; constexpr int NT = SEQ / KVBLK;
    int vprev = 0, vcur = SHM_V, vnext = 2 * SHM_V;
#define FA_ROT() do { const int t_ = vprev; vprev = vcur; vcur = vnext; vnext = t_; } while (0)
    FA_DRAIN_BAR();
    FA_DMA_K(1, 1); FA_DMA_V(1, SHM_V);
    qkt(pA0, pA1, K_lds, kb, qr); partialSM(pA0, pA1, m_reg, alA);
    FA_DRAIN_BAR();
#pragma unroll 1
    for (int t = 1; t + 1 < NT; t += 2) {
        FA_DMA_K(t + 1, 0); FA_DMA_V(t + 1, vnext);
        FA_SBAR(); qkt(pB0, pB1, K_lds + SHM_K, kb, qr);
        finishSM(pA0, pA1, alA, l_reg, pa0, pa1, pa2, pa3); FA_SBAR();
        pv_d0(o, vb0 + vprev, pa0, pa1, pa2, pa3); partialSM(pB0, pB1, m_reg, alB);
        FA_DRAIN_BAR(); FA_RESC(alB); FA_ROT();
        if (t + 2 < NT) { FA_DMA_K(t + 2, 1); FA_DMA_V(t + 2, vnext); }
        FA_SBAR(); qkt(pA0, pA1, K_lds, kb, qr);
        finishSM(pB0, pB1, alB, l_reg, pa0, pa1, pa2, pa3); FA_SBAR();
        pv_d0(o, vb0 + vprev, pa0, pa1, pa2, pa3); partialSM(pA0, pA1, m_reg, alA);
        FA_DRAIN_BAR(); FA_RESC(alA); FA_ROT();
    }
    FA_SBAR(); qkt(pB0, pB1, K_lds + SHM_K, kb, qr);
    finishSM(pA0, pA1, alA, l_reg, pa0, pa1, pa2, pa3); FA_SBAR();
    pv_d0(o, vb0 + vprev, pa0, pa1, pa2, pa3); partialSM(pB0, pB1, m_reg, alB);
    FA_RESC(alB);
    finishSM(pB0, pB1, alB, l_reg, pa0, pa1, pa2, pa3); FA_SBAR();
    pv_d0(o, vb0 + vcur, pa0, pa1, pa2, pa3);
    if (hi == 0) li_l[r32] = l_reg;
    asm volatile("s_waitcnt lgkmcnt(0)" ::: "memory");
    float rli[16];
#pragma unroll
    for (int r = 0; r < 16; ++r) rli[r] = __builtin_amdgcn_rcpf(li_l[crow(r, hi)]);
    bf16_t* Ow = O + (size_t)(b * SEQ + q0 + wid * QBLK) * D + h * DV;
#pragma unroll
    for (int r = 0; r < 16; ++r) { const int orow = crow(r, hi);
#pragma unroll
        for (int d0 = 0; d0 < 4; ++d0) Ow[(size_t)orow * D + d0 * 32 + r32] = (bf16_t)f2bf(o[d0][r] * rli[r]); }
    __syncthreads();
#undef FA_DMA_K
#undef FA_DMA_V
#undef FA_DRAIN_BAR
#undef FA_RESC
#undef FA_ROT
}
}

__device__ __forceinline__ void fast_attn_phase(Frame& F, LAS unsigned char* ldsL) {
    const bf16_t* Q = (const bf16_t*)(F.ws + WS_Q); const bf16_t* Kf = (const bf16_t*)(F.ws + WS_K); const bf16_t* V = (const bf16_t*)(F.ws + WS_V); bf16_t* O = (bf16_t*)(F.ws + WS_O);
    const f32x2* rope = (const f32x2*)(F.ws + WS_ROPE);
    if (F.G == 256) { for (int i = 0; i < 2; ++i) fa::attn_unit((F.bid & 7) + 8 * i, F.bid >> 3, Q, Kf, V, O, rope, ldsL); }
    else { for (int u = F.bid; u < 512; u += F.G) fa::attn_unit(u >> 5, u & 31, Q, Kf, V, O, rope, ldsL); }
}

__device__ __forceinline__ void route_phase(Frame& F) {
    const float* X = F.out; const float* gn = F.in[I_NFFN] + 1024; const float* mod = (const float*)(F.ws + WS_MOD) + (size_t)1 * 2 * 6144;
    bf16_t* H = (bf16_t*)(F.ws + WS_H); const float* wr = F.in[I_ROUTER];
    unsigned* cnt = (unsigned*)(F.ws + WS_CTL) + CW_CNT; int* list = (int*)(F.ws + WS_LIST); int* tokinfo = (int*)(F.ws + WS_TOKINFO);
    int* le0 = (int*)F.lds; int* le1 = le0 + 64; float* lg0 = (float*)(le1 + 64); float* lg1 = lg0 + 64; int* lp0 = (int*)(lg1 + 64); int* lp1 = lp0 + 64;
    const int lane = F.lane;
    for (int chunk = F.bid; chunk < T / 64; chunk += F.G) {
        const int row0 = chunk * 64;
        for (int rr = 0; rr < 8; ++rr) {
            const int lr = F.wave * 8 + rr, m = row0 + lr, b = m >> 13; f32x4 hv[4];
            norm_row(X + (size_t)m * D, gn, mod + b * 6144 + 3 * 1024, mod + b * 6144 + 4 * 1024, H + (size_t)m * D, lane, hv);
            float lg[8];
#pragma unroll
            for (int e = 0; e < 8; ++e) lg[e] = 0.f;
#pragma unroll
            for (int j = 0; j < 4; ++j) { const float hx[4] = {hv[j].x, hv[j].y, hv[j].z, hv[j].w};
#pragma unroll
                for (int q = 0; q < 4; ++q) { const int k = 4 * lane + 256 * j + q; const f32x4 w0 = *(const f32x4*)(wr + (size_t)k * 8), w1 = *(const f32x4*)(wr + (size_t)k * 8 + 4);
                    lg[0] += hx[q] * w0.x; lg[1] += hx[q] * w0.y; lg[2] += hx[q] * w0.z; lg[3] += hx[q] * w0.w;
                    lg[4] += hx[q] * w1.x; lg[5] += hx[q] * w1.y; lg[6] += hx[q] * w1.z; lg[7] += hx[q] * w1.w; } }
#pragma unroll
            for (int e = 0; e < 8; ++e) lg[e] = wave_sum(lg[e]);
            int e0 = 0; float v0 = lg[0];
#pragma unroll
            for (int e = 1; e < 8; ++e) if (lg[e] > v0) { v0 = lg[e]; e0 = e; }
            int e1 = -1; float v1 = -3.0e38f;
#pragma unroll
            for (int e = 0; e < 8; ++e) if (e != e0 && lg[e] > v1) { v1 = lg[e]; e1 = e; }
            const float ex = __expf(v1 - v0), g0 = 1.0f / (1.0f + ex), g1 = ex / (1.0f + ex);
            if (lane == 0) { le0[lr] = e0; le1[lr] = e1; lg0[lr] = g0; lg1[lr] = g1; }
        }
        __syncthreads();
        if (F.tid < 8) { const int e = F.tid; int c = 0;
            for (int r = 0; r < 64; ++r) c += (le0[r] == e) + (le1[r] == e);
            const unsigned base = c ? atomicAdd(cnt + e, (unsigned)c) : 0u; int p = (int)base;
            for (int r = 0; r < 64; ++r) { if (le0[r] == e) { lp0[r] = p; list[e * T + p] = row0 + r; ++p; } if (le1[r] == e) { lp1[r] = p; list[e * T + p] = row0 + r; ++p; } }
        }
        __syncthreads();
        if (F.tid < 64) { const int r = F.tid; int* ti = tokinfo + (size_t)(row0 + r) * 8;
            ti[0] = le0[r]; ti[1] = lp0[r]; ti[2] = le1[r]; ti[3] = lp1[r]; ((float*)ti)[4] = lg0[r]; ((float*)ti)[5] = lg1[r]; }
        __syncthreads();
    }
}
struct MoEMeta { int rb[9]; int tiles[8]; };
__device__ __forceinline__ void moe_meta(Frame& F, MoEMeta& mm) {
    const unsigned* cnt = (const unsigned*)(F.ws + WS_CTL) + CW_CNT; int acc = 0;
#pragma unroll
    for (int e = 0; e < 8; ++e) { const int c = (int)__builtin_amdgcn_readfirstlane(__hip_atomic_load(cnt + e, __ATOMIC_RELAXED, __HIP_MEMORY_SCOPE_AGENT)); mm.rb[e] = acc; mm.tiles[e] = (c + 255) >> 8; acc += mm.tiles[e] * 256; }
    mm.rb[8] = acc;
}
__device__ __forceinline__ void gather_phase(Frame& F) {
    MoEMeta mm; moe_meta(F, mm);
    const unsigned* cnt = (const unsigned*)(F.ws + WS_CTL) + CW_CNT; const int* list = (const int*)(F.ws + WS_LIST);
    const bf16_t* H = (const bf16_t*)(F.ws + WS_H); bf16_t* XG = (bf16_t*)(F.ws + WS_XG);
    const int gw = F.bid * NWAVES + F.wave, NGW = F.G * NWAVES, lane = F.lane;
#pragma unroll
    for (int e = 0; e < 8; ++e) { const int c = (int)__hip_atomic_load(cnt + e, __ATOMIC_RELAXED, __HIP_MEMORY_SCOPE_AGENT);
        for (int p = gw; p < c; p += NGW) { const int tok = list[e * T + p];
            const u32x4* s = (const u32x4*)(H + (size_t)tok * D) + lane; u32x4* d = (u32x4*)(XG + (size_t)(mm.rb[e] + p) * D) + lane;
            d[0] = s[0]; d[64] = s[64]; } }
}
__device__ __forceinline__ void final_phase(Frame& F) {
    MoEMeta mm; moe_meta(F, mm);
    const int* tokinfo = (const int*)(F.ws + WS_TOKINFO); const bf16_t* YS = (const bf16_t*)(F.ws + WS_XG);
    const float* mod = (const float*)(F.ws + WS_MOD) + (size_t)1 * 2 * 6144; const float* fg = F.in[I_FING];
    const int gw = F.bid * NWAVES + F.wave, NGW = F.G * NWAVES, lane = F.lane;
    for (int m = gw; m < T; m += NGW) {
        const int* ti = tokinfo + (size_t)m * 8; const int e0 = ti[0], p0 = ti[1], e1 = ti[2], p1 = ti[3]; const float g0 = ((const float*)ti)[4], g1 = ((const float*)ti)[5];
        int r0 = 0, r1 = 0;
#pragma unroll
        for (int e = 0; e < 8; ++e) { if (e == e0) r0 = mm.rb[e] + p0; if (e == e1) r1 = mm.rb[e] + p1; }
        const int b = m >> 13; const float* gf = mod + b * 6144 + 5 * 1024;
        float* xr = F.out + (size_t)m * D; f32x4 v[4]; float s = 0.f;
#pragma unroll
        for (int j = 0; j < 4; ++j) { const int c = 4 * lane + 256 * j;
            const f32x4 x = *(const f32x4*)(xr + c), gg = *(const f32x4*)(gf + c);
            const u32x2 y0 = *(const u32x2*)(YS + (size_t)r0 * D + c), y1 = *(const u32x2*)(YS + (size_t)r1 * D + c);
            f32x4 y; y.x = g0 * __uint_as_float(y0.x << 16) + g1 * __uint_as_float(y1.x << 16); y.y = g0 * __uint_as_float(y0.x & 0xffff0000u) + g1 * __uint_as_float(y1.x & 0xffff0000u);
            y.z = g0 * __uint_as_float(y0.y << 16) + g1 * __uint_as_float(y1.y << 16); y.w = g0 * __uint_as_float(y0.y & 0xffff0000u) + g1 * __uint_as_float(y1.y & 0xffff0000u);
            v[j] = (f32x4){x.x + gg.x * y.x, x.y + gg.y * y.y, x.z + gg.z * y.z, x.w + gg.w * y.w};
            s += (v[j].x * v[j].x + v[j].y * v[j].y) + (v[j].z * v[j].z + v[j].w * v[j].w); }
        const float rstd = rsqrtf(wave_sum(s) * (1.0f / D) + RMS_EPS);
#pragma unroll
        for (int j = 0; j < 4; ++j) { const int c = 4 * lane + 256 * j; const f32x4 g4 = *(const f32x4*)(fg + c);
            *(f32x4*)(xr + c) = (f32x4){v[j].x * rstd * g4.x, v[j].y * rstd * g4.y, v[j].z * rstd * g4.z, v[j].w * rstd * g4.w}; }
    }
}

constexpr int NPH = 22;
constexpr int LDS_BYTES = 147456;

__global__ void __launch_bounds__(NTHREADS, 2) mega(Args args) {
    extern __shared__ __attribute__((aligned(16))) unsigned char lds[];
    Frame F; F.lds = lds; F.tid = threadIdx.x; F.lane = F.tid & 63; F.wave = __builtin_amdgcn_readfirstlane(F.tid >> 6);
    F.G = gridDim.x; F.bid = blockIdx.x; F.out = args.out; F.ws = args.ws; F.in = args.in;
    unsigned char* ws = args.ws;
    const int lo = args.lo, hi = args.hi;
#if MK_ONE_LAUNCH
    cg::grid_group grid = cg::this_grid();
#define GRID_BAR() grid.sync()
#else
#define GRID_BAR() do {} while (0)
#endif
#ifndef PHMASK
#define PHMASK 0x3fffff
#endif
#define IN(k) ((((PHMASK) >> (k)) & 1) && lo <= (k) && (k) < hi)
#define SEAM(k) do { if (IN(k) && IN((k) + 1)) GRID_BAR(); } while (0)
    const float* mod = (const float*)(ws + WS_MOD);
    bf16_t* H = (bf16_t*)(ws + WS_H);

    LAS unsigned char* ldsL = (LAS unsigned char*)lds;
#if FAST_GEMM
#define GEMM_DENSE(A_, lda_, Bt_, K_, M_, N_, EpiT, E_) do { pg8::Gemm g_{A_, Bt_, lda_, K_}; pg8::StaticOrder S_; S_.init(M_, N_, F.G, F.bid); \
        pg8::gemm_phase<pg8::Epi8<EpiT>, pg8::StaticOrder, true>(ldsL, g_, S_, pg8::Epi8<EpiT>{E_}); } while (0)
#define GEMM_DENSE_DUAL(A_, lda_, Bt_, K_, M_, NH_, EpiT, E_) do { pg8::Gemm g_{A_, Bt_, lda_, K_}; pg8::StaticOrder S_; S_.init(M_, 2 * (NH_), F.G, F.bid); \
        pg8::gemm_phase<pg8::Epi8Dual<EpiT>, pg8::StaticOrder, true>(ldsL, g_, S_, pg8::Epi8Dual<EpiT>{E_}); } while (0)
#define GEMM_DIAG(A_, lda_, Bt_, K_, EpiT, E_) do { pg8::Gemm g_{A_, Bt_, lda_, K_}; pg8::DiagOrder S_{128, F.G, F.bid}; \
        pg8::gemm_phase<pg8::Epi8<EpiT>, pg8::DiagOrder, true>(ldsL, g_, S_, pg8::Epi8<EpiT>{E_}); } while (0)
#else
#define GEMM_DENSE(A_, lda_, Bt_, K_, M_, N_, EpiT, E_) naive_gemm<false>(F, A_, lda_, Bt_, K_, M_, N_, E_, BOffNone{})
#define GEMM_DENSE_DUAL(A_, lda_, Bt_, K_, M_, NH_, EpiT, E_) naive_gemm<true>(F, A_, lda_, Bt_, K_, M_, NH_, E_, BOffNone{})
#define GEMM_DIAG(A_, lda_, Bt_, K_, EpiT, E_) naive_gemm<false>(F, A_, lda_, Bt_, K_, 32768, 256, E_, BOffDiag{})
#endif
#define WSB(off) ((bf16_t*)(ws + (off)))
    if (IN(0)) { p0_prologue(F); } SEAM(0);
    if (IN(1)) { norm_phase(F, F.in[I_X], F.in[I_NMIX], 0, 0); } SEAM(1);
    if (IN(2)) { EpiIn E{WSB(WS_UA), WSB(WS_VA), WSB(WS_AC)};
        GEMM_DENSE(H, D, WSB(WS_WIN), D, T, AB_IN, EpiIn, E); } SEAM(2);
    if (IN(3)) { EpiS5A E{(float*)(ws + WS_SS)};
        GEMM_DIAG(WSB(WS_AC), 512, WSB(WS_GTA), 256, EpiS5A, E);
        if (F.G == 256) { if (F.bid >= 128) { for (int j = 0; j < 3; ++j) sgu_unit(F, (F.bid - 128) * 3 + j); } else sgu_unit(F, 384 + F.bid); }
        else { for (int u = F.bid; u < 512; u += F.G) sgu_unit(F, u); } } SEAM(3);
    if (IN(4)) { if (F.wave == 0) { for (int id = F.bid; id < 128; id += F.G) scan_wave(F, id); } } SEAM(4);
    if (IN(5)) { EpiS5C E{WSB(WS_AC), F.in[I_S5D], WSB(WS_YG)};
        GEMM_DIAG(WSB(WS_AC), 512, WSB(WS_BTC), 512, EpiS5C, E); } SEAM(5);
    if (IN(6)) { EpiGlu E{WSB(WS_YG), WSB(WS_CAT)};
        GEMM_DENSE(WSB(WS_YG), 512, WSB(WS_WGLU), 512, T, 512, EpiGlu, E); } SEAM(6);
    if (IN(7)) { EpiRes E{F.in[I_X], F.out, mod + 2 * 1024};
        GEMM_DENSE(WSB(WS_CAT), D, WSB(WS_WOUT), D, T, D, EpiRes, E); } SEAM(7);
    if (IN(8)) { norm_phase(F, F.out, F.in[I_NFFN], 0, 3); } SEAM(8);
    if (IN(9)) { EpiSwiglu E{WSB(WS_HF), D_FF};
        GEMM_DENSE_DUAL(H, D, WSB(WS_W13), D, T, D_FF, EpiSwiglu, E); } SEAM(9);
    if (IN(10)) { EpiRes E{F.out, F.out, mod + 5 * 1024};
        GEMM_DENSE(WSB(WS_HF), D_FF, WSB(WS_W2), D_FF, T, D, EpiRes, E); } SEAM(10);
    if (IN(11)) { norm_phase(F, F.out, F.in[I_NMIX] + 1024, 1, 0); } SEAM(11);
    if (IN(12)) { EpiZ E{(float*)(ws + WS_Z)};
        GEMM_DENSE(H, D, WSB(WS_WMIN), D, T, CINP, EpiZ, E); } SEAM(12);
    if (IN(13)) { zsplit_phase(F); } SEAM(13);
    if (IN(14)) { EpiQ Eq{WSB(WS_Q)};
        GEMM_DENSE(WSB(WS_CQ), QL, WSB(WS_WUQ), QL, T, NH * DQK, EpiQ, Eq);
        EpiKV Ek{WSB(WS_K), WSB(WS_V)};
        GEMM_DENSE(WSB(WS_CKV), KVL, WSB(WS_WUKV), KVL, T, NH * 256, EpiKV, Ek); } SEAM(14);
#if FAST_ATTN
    if (IN(15)) { fast_attn_phase(F, ldsL); } SEAM(15);
#else
    if (IN(15)) { naive_attn_phase(F); } SEAM(15);
#endif
    if (IN(16)) { EpiRes E{F.out, F.out, mod + 2 * 6144 + 2 * 1024};
        GEMM_DENSE(WSB(WS_O), D, WSB(WS_WO), D, T, D, EpiRes, E); } SEAM(16);
    if (IN(17)) { route_phase(F); } SEAM(17);
    if (IN(18)) { gather_phase(F); } SEAM(18);
    if (IN(19)) { MoEMeta mm; moe_meta(F, mm); EpiSwiglu E{WSB(WS_HM), D_FFE};
#if FAST_GEMM
        pg8::MoEOrder S_; { int acc_ = 0;
#pragma unroll
            for (int e = 0; e < 8; ++e) { S_.ub[e] = acc_; S_.tl[e] = mm.tiles[e]; S_.tb[e] = mm.rb[e] >> 8; acc_ += mm.tiles[e] * 28; }
            S_.ub[8] = acc_; S_.nwg = acc_; S_.nN = 28; S_.G = F.G; S_.c = F.bid; }
        pg8::Gemm g_{WSB(WS_XG), WSB(WS_MW13), D, D};
        pg8::gemm_phase<pg8::Epi8Dual<EpiSwiglu>, pg8::MoEOrder, true>(ldsL, g_, S_, pg8::Epi8Dual<EpiSwiglu>{E});
#else
        BOffMoE bo;
#pragma unroll
        for (int e = 0; e < 9; ++e) bo.rb[e] = mm.rb[e];
        bo.nper = 7168;
        naive_gemm<true>(F, WSB(WS_XG), D, WSB(WS_MW13), D, mm.rb[8], D_FFE, E, bo);
#endif
    } SEAM(19);
    if (IN(20)) { MoEMeta mm; moe_meta(F, mm); EpiYS E{WSB(WS_XG)};
#if FAST_GEMM
        pg8::MoEOrder S_; { int acc_ = 0;
#pragma unroll
            for (int e = 0; e < 8; ++e) { S_.ub[e] = acc_; S_.tl[e] = mm.tiles[e]; S_.tb[e] = mm.rb[e] >> 8; acc_ += mm.tiles[e] * 4; }
            S_.ub[8] = acc_; S_.nwg = acc_; S_.nN = 4; S_.G = F.G; S_.c = F.bid; }
        pg8::Gemm g_{WSB(WS_HM), WSB(WS_MW2), D_FFE, D_FFE};
        pg8::gemm_phase<pg8::Epi8<EpiYS>, pg8::MoEOrder, true>(ldsL, g_, S_, pg8::Epi8<EpiYS>{E});
#else
        BOffMoE bo;
#pragma unroll
        for (int e = 0; e < 9; ++e) bo.rb[e] = mm.rb[e];
        bo.nper = 1024;
        naive_gemm<false>(F, WSB(WS_HM), D_FFE, WSB(WS_MW2), D_FFE, mm.rb[8], D, E, bo);
#endif
    } SEAM(20);
    if (IN(21)) { final_phase(F); }
}

extern "C" void kernel_launch(void* const* d_in, const int* in_sizes, int n_in, void* d_out, int out_size, void* d_ws, size_t ws_size, hipStream_t stream) {
    static int grid = 0;
    if (grid == 0) {
        if (n_in != 34 || out_size != T * D || ws_size < WS_END) { fprintf(stderr, "kernel_launch: unexpected shapes n_in %d out %d ws %zu (need %zu)\n", n_in, out_size, ws_size, (size_t)WS_END); grid = -1; return; }
        int dev = 0, cus = 0, per_cu = 0;
        hipGetDevice(&dev); hipDeviceGetAttribute(&cus, hipDeviceAttributeMultiprocessorCount, dev);
        if (hipFuncSetAttribute((const void*)mega, hipFuncAttributeMaxDynamicSharedMemorySize, LDS_BYTES) != hipSuccess) { fprintf(stderr, "hipFuncSetAttribute failed\n"); grid = -1; return; }
        if (hipOccupancyMaxActiveBlocksPerMultiprocessor(&per_cu, (const void*)mega, NTHREADS, LDS_BYTES) != hipSuccess || per_cu < 1) { fprintf(stderr, "occupancy query failed (%d)\n", per_cu); per_cu = 1; }
        (void)hipGetLastError();
        grid = cus * per_cu;
    }
    if (grid < 0) return;
    hipMemsetAsync((char*)d_ws + WS_CTL, 0, CTL_BYTES, stream);
    Args a{};
    for (int i = 0; i < 34; ++i) a.in[i] = (const float*)d_in[i];
    a.out = (float*)d_out; a.ws = (unsigned char*)d_ws;
#if MK_ONE_LAUNCH
    a.lo = 0; a.hi = NPH;
    void* kargs[] = {&a};
    hipError_t e = hipLaunchCooperativeKernel((const void*)mega, dim3(grid), dim3(NTHREADS), kargs, LDS_BYTES, stream);
    if (e != hipSuccess) fprintf(stderr, "cooperative launch failed: %s (grid %d)\n", hipGetErrorString(e), grid);
#else
    for (int ph = 0; ph < NPH; ++ph) { a.lo = ph; a.hi = ph + 1; hipLaunchKernelGGL(mega, dim3(grid), dim3(NTHREADS), LDS_BYTES, stream, a); }
#endif
}
```

```cpp
#include <hip/hip_runtime.h>
#include <hip/hip_cooperative_groups.h>
#include <cstdio>
#include <cstdint>
namespace cg = cooperative_groups;

#ifndef MK_ONE_LAUNCH
#define MK_ONE_LAUNCH 1
#endif
#ifndef FAST_GEMM
#define FAST_GEMM 1
#endif
#ifndef FAST_ATTN
#define FAST_ATTN 1
#endif

#define LAS __attribute__((address_space(3)))
typedef unsigned short bf16_t;
typedef short bf16x8 __attribute__((ext_vector_type(8)));
typedef float f32x4 __attribute__((ext_vector_type(4)));
typedef float f32x2 __attribute__((ext_vector_type(2)));
typedef unsigned u32x4 __attribute__((ext_vector_type(4)));
typedef unsigned u32x2 __attribute__((ext_vector_type(2)));

constexpr int D = 1024, SEQ = 8192, NBATCH = 2, T = NBATCH * SEQ;
constexpr int A_W = 512, B_W = 512, AB_IN = 1536;
constexpr int D_FF = 2816, NEXP = 8, D_FFE = 3584;
constexpr int QL = 384, KVL = 256, CIN = 704, CINP = 768, NH = 8, DQK = 192, DV = 128;
constexpr float RMS_EPS = 1e-6f;
constexpr int NTHREADS = 512, NWAVES = 8;
constexpr int RT_MAX = 34816;
constexpr float QSCALE = 0.07216878364870323f * 1.4426950408889634f;

constexpr size_t MiB = 1u << 20;
constexpr size_t WS_CTL = 0, CTL_BYTES = 64 * 1024;
constexpr size_t WS_MOD = 1 * MiB;
constexpr size_t WS_TOKINFO = 1 * MiB + 256 * 1024;
constexpr size_t WS_LIST = 2 * MiB;
constexpr size_t WS_MW13 = 4 * MiB;
constexpr size_t WS_MW2 = 116 * MiB;
constexpr size_t WS_XG = 172 * MiB;
constexpr size_t WS_O = 172 * MiB;
constexpr size_t WS_V = 204 * MiB;
constexpr size_t WS_HM = 240 * MiB;
constexpr size_t WS_WIN = 240 * MiB, WS_WGLU = 243 * MiB, WS_WOUT = 244 * MiB, WS_W13 = 246 * MiB, WS_W2 = 257 * MiB;
constexpr size_t WS_WMIN = 263 * MiB, WS_WUQ = 265 * MiB, WS_WUKV = 267 * MiB, WS_WO = 268 * MiB;
constexpr size_t WS_GTA = 270 * MiB, WS_BTC = 274 * MiB, WS_ROPE = 282 * MiB, WS_A16 = 284 * MiB;
constexpr size_t WS_H = 285 * MiB;
constexpr size_t WS_UA = 317 * MiB, WS_VA = 333 * MiB, WS_AC = 349 * MiB, WS_SS = 381 * MiB, WS_YG = 413 * MiB, WS_CAT = 429 * MiB;
constexpr size_t WS_HF = 317 * MiB;
constexpr size_t WS_Z = 317 * MiB, WS_Q = 317 * MiB, WS_CQ = 365 * MiB, WS_CKV = 377 * MiB, WS_K = 385 * MiB;
constexpr size_t WS_END = 478 * MiB;
constexpr int CW_CNT = 0;
constexpr int CW_BAR = 1024;

__device__ __forceinline__ float bf2f(unsigned h) { return __uint_as_float(h << 16); }
__device__ __forceinline__ unsigned f2bf(float f) { unsigned u = __float_as_uint(f); return (u + 0x7fffu + ((u >> 16) & 1u)) >> 16; }
__device__ __forceinline__ unsigned pk2(float lo, float hi) { return f2bf(lo) | (f2bf(hi) << 16); }
__device__ __forceinline__ void unpack8(const u32x4 w, float (&f)[8]) {
    f[0] = __uint_as_float(w.x << 16); f[1] = __uint_as_float(w.x & 0xffff0000u);
    f[2] = __uint_as_float(w.y << 16); f[3] = __uint_as_float(w.y & 0xffff0000u);
    f[4] = __uint_as_float(w.z << 16); f[5] = __uint_as_float(w.z & 0xffff0000u);
    f[6] = __uint_as_float(w.w << 16); f[7] = __uint_as_float(w.w & 0xffff0000u);
}
__device__ __forceinline__ u32x4 pack8(const float (&f)[8]) {
    u32x4 w; w.x = pk2(f[0], f[1]); w.y = pk2(f[2], f[3]); w.z = pk2(f[4], f[5]); w.w = pk2(f[6], f[7]); return w;
}
__device__ __forceinline__ float sigmoidf_(float x) { return 1.0f / (1.0f + __expf(-x)); }
__device__ __forceinline__ float siluf_(float x) { return x / (1.0f + __expf(-x)); }
__device__ __forceinline__ float gelu_tanh(float x) { const float z = 1.5957691216057308f * (x + 0.044715f * x * x * x); return x / (1.0f + __expf(-z)); }
__device__ __forceinline__ float wave_sum(float v) {
#pragma unroll
    for (int o = 1; o < 64; o <<= 1) v += __shfl_xor(v, o);
    return v;
}
__device__ __forceinline__ float wave_max(float v) {
#pragma unroll
    for (int o = 1; o < 64; o <<= 1) v = fmaxf(v, __shfl_xor(v, o));
    return v;
}

struct Args { const float* in[34]; float* out; unsigned char* ws; int lo, hi; };
struct Frame {
    unsigned char* lds;
    int tid, lane, wave, G, bid;
    const float* const* in;
    float* out; unsigned char* ws;
};
enum { I_X = 0, I_C, I_ADAW, I_ADAB, I_NMIX, I_NFFN, I_FING, I_ABWIN, I_SGUVG, I_SGUWS, I_SGUBS, I_LAMRE, I_LAMIM, I_LOGDT,
       I_BRE, I_BIM, I_CRE, I_CIM, I_S5D, I_WGLU, I_ABWOUT, I_FW1, I_FW3, I_FW2, I_MWIN, I_QNG, I_KVNG, I_WUQ, I_WUKV, I_WO,
       I_ROUTER, I_MW1, I_MW3, I_MW2 };

__device__ __forceinline__ int rowmap(int kind, int n) {
    switch (kind) {
        case 1: return 256 * (n >> 7) + (n & 127);
        case 2: return 256 * (n >> 7) + 128 + (n & 127);
        case 3: { if (n < 640) return n; const int i = n - 640; return 640 + 2 * (i & 31) + (i >> 5); }
        case 4: { const int h = n / 192, r = n - h * 192; if (r < 128) return n; const int i = r - 128; return h * 192 + 128 + 2 * (i & 31) + (i >> 5); }
        default: return n;
    }
}
__device__ __forceinline__ void transpose_item(const float* W, int N, bf16_t* WT, int ldd, int kind, float* scr, int kb, int nb, int lane) {
    const int k0 = 64 * kb, n0 = 32 * nb;
#pragma unroll 8
    for (int i = 0; i < 32; ++i) { const int kk = 2 * i + (lane >> 5); scr[kk * 33 + (lane & 31)] = W[(size_t)(k0 + kk) * N + n0 + (lane & 31)]; }
    asm volatile("s_waitcnt lgkmcnt(0)" ::: "memory");
    const int c = lane & 7;
#pragma unroll
    for (int j = 0; j < 4; ++j) { const int n = (lane >> 3) + 8 * j; const float* s = scr + (8 * c) * 33 + n;
        u32x4 o; o.x = pk2(s[0 * 33], s[1 * 33]); o.y = pk2(s[2 * 33], s[3 * 33]); o.z = pk2(s[4 * 33], s[5 * 33]); o.w = pk2(s[6 * 33], s[7 * 33]);
        *(u32x4*)(WT + (size_t)rowmap(kind, n0 + n) * ldd + k0 + 8 * c) = o; }
    asm volatile("s_waitcnt lgkmcnt(0)" ::: "memory");
}


__device__ __forceinline__ void p0_adaln_unit(Frame& F, int unit) {
    float* silu_c = (float*)F.lds;
    float* red = (float*)(F.lds + 8192);
    const float* c = F.in[I_C];
    for (int i = F.tid; i < 2048; i += NTHREADS) silu_c[i] = siluf_(c[i]);
    __syncthreads();
    const int col = unit * 64, layer = col / 6144, j = col - layer * 6144;
    const float* w = F.in[I_ADAW] + (size_t)layer * 1024 * 6144 + j + F.lane;
    float a0 = 0.f, a1 = 0.f;
    const int kbeg = F.wave * 128;
#pragma unroll 8
    for (int k = kbeg; k < kbeg + 128; ++k) { const float wv = w[(size_t)k * 6144]; a0 += silu_c[k] * wv; a1 += silu_c[1024 + k] * wv; }
    red[(F.wave * 2 + 0) * 64 + F.lane] = a0; red[(F.wave * 2 + 1) * 64 + F.lane] = a1;
    __syncthreads();
    if (F.tid < 128) { const int b = F.tid >> 6, l = F.tid & 63; float s = 0.f;
#pragma unroll
        for (int wv = 0; wv < 8; ++wv) s += red[(wv * 2 + b) * 64 + l];
        s += F.in[I_ADAB][layer * 6144 + j + l];
        ((float*)(F.ws + WS_MOD))[(size_t)(layer * 2 + b) * 6144 + j + l] = s; }
    __syncthreads();
}

__device__ __forceinline__ void p0_s5_unit(Frame& F, int g) {
    float* Pre = (float*)F.lds;
    float* Pim = Pre + 2 * 17 * 64;
    float* BBre = Pim + 2 * 17 * 64;
    float* BBim = BBre + 2 * 64 * 16;
    float* Cre = BBim + 2 * 64 * 16;
    float* Cim = Cre + 2 * 16 * 64;
    float* Kt = Cim + 2 * 16 * 64;
    const float* lam_re = F.in[I_LAMRE]; const float* lam_im = F.in[I_LAMIM]; const float* log_dt = F.in[I_LOGDT];
    for (int idx = F.tid; idx < 2 * 17 * 64; idx += NTHREADS) {
        const int dir = idx / (17 * 64), r = idx - dir * 17 * 64, j = r >> 6, p = r & 63;
        const float dt = expf(log_dt[dir * 32 + g]);
        const float lr = lam_re[(dir * 32 + g) * 64 + p], li = lam_im[(dir * 32 + g) * 64 + p];
        const float mag = expf(lr * dt * (float)j); float sn, cs; sincosf(li * dt * (float)j, &sn, &cs);
        Pre[idx] = mag * cs; Pim[idx] = mag * sn;
    }
    for (int idx = F.tid; idx < 2 * 16 * 64; idx += NTHREADS) {
        const int dir = idx >> 10, r = idx & 1023;
        Cre[idx] = F.in[I_CRE][(size_t)(dir * 32 + g) * 1024 + r]; Cim[idx] = F.in[I_CIM][(size_t)(dir * 32 + g) * 1024 + r];
    }
    __syncthreads();
    for (int idx = F.tid; idx < 2 * 64 * 16; idx += NTHREADS) {
        const int dir = idx >> 10, r = idx & 1023, p = r >> 4;
        const float lr = lam_re[(dir * 32 + g) * 64 + p], li = lam_im[(dir * 32 + g) * 64 + p];
        const float ar = Pre[(dir * 17 + 1) * 64 + p], ai = Pim[(dir * 17 + 1) * 64 + p];
        const float den = lr * lr + li * li;
        const float fr = ((ar - 1.0f) * lr + ai * li) / den, fi = (ai * lr - (ar - 1.0f) * li) / den;
        const float br = F.in[I_BRE][(size_t)(dir * 32 + g) * 1024 + r], bi = F.in[I_BIM][(size_t)(dir * 32 + g) * 1024 + r];
        BBre[idx] = fr * br - fi * bi; BBim[idx] = fr * bi + fi * br;
    }
    __syncthreads();
    for (int idx = F.tid; idx < 2 * 16 * 16 * 16; idx += NTHREADS) {
        const int dir = idx >> 12, j = (idx >> 8) & 15, h = (idx >> 4) & 15, hp = idx & 15;
        float s = 0.f;
        for (int p = 0; p < 64; ++p) {
            const float cr = Cre[(dir * 16 + h) * 64 + p], ci = Cim[(dir * 16 + h) * 64 + p];
            const float pr = Pre[(dir * 17 + j) * 64 + p], pi = Pim[(dir * 17 + j) * 64 + p];
            const float xr = cr * pr - ci * pi, xi = cr * pi + ci * pr;
            s += xr * BBre[(dir * 64 + p) * 16 + hp] - xi * BBim[(dir * 64 + p) * 16 + hp];
        }
        Kt[idx] = s;
    }
    __syncthreads();
    bf16_t* GtA = (bf16_t*)(F.ws + WS_GTA) + (size_t)g * 256 * 256;
    for (int ch = F.tid; ch < 256 * 32; ch += NTHREADS) {
        const int np = ch >> 5, k0 = (ch & 31) * 8, dir = np >> 7, ri = (np >> 6) & 1, p = np & 63, s = k0 >> 4, h0 = k0 & 15;
        const int e = dir == 0 ? 15 - s : s;
        const float pr = Pre[(dir * 17 + e) * 64 + p], pi = Pim[(dir * 17 + e) * 64 + p];
        float v[8];
#pragma unroll
        for (int j = 0; j < 8; ++j) { const float br = BBre[(dir * 64 + p) * 16 + h0 + j], bi = BBim[(dir * 64 + p) * 16 + h0 + j];
            v[j] = ri == 0 ? (pr * br - pi * bi) : (pr * bi + pi * br); }
        *(u32x4*)(GtA + (size_t)np * 256 + k0) = pack8(v);
    }
    bf16_t* BtC = (bf16_t*)(F.ws + WS_BTC) + (size_t)g * 256 * 512;
    for (int ch = F.tid; ch < 256 * 64; ch += NTHREADS) {
        const int np = ch >> 6, k0 = (ch & 63) * 8, t = np >> 4, h = np & 15;
        float v[8];
        if (k0 < 256) {
            const int s = k0 >> 4, h0 = k0 & 15;
#pragma unroll
            for (int j = 0; j < 8; ++j) { float x = 0.f;
                if (t >= s) x += Kt[((0 * 16 + (t - s)) * 16 + h) * 16 + h0 + j];
                if (s >= t) x += Kt[((1 * 16 + (s - t)) * 16 + h) * 16 + h0 + j];
                v[j] = x; }
        } else {
            const int q = k0 - 256, dir = q >> 7, ri = (q >> 6) & 1, p0 = q & 63;
            const int e = dir == 0 ? t + 1 : 16 - t;
#pragma unroll
            for (int j = 0; j < 8; ++j) { const int p = p0 + j;
                const float cr = Cre[(dir * 16 + h) * 64 + p], ci = Cim[(dir * 16 + h) * 64 + p];
                const float pr = Pre[(dir * 17 + e) * 64 + p], pi = Pim[(dir * 17 + e) * 64 + p];
                v[j] = ri == 0 ? (cr * pr - ci * pi) : -(cr * pi + ci * pr); }
        }
        *(u32x4*)(BtC + (size_t)np * 512 + k0) = pack8(v);
    }
    if (F.tid < 128) { const int dir = F.tid >> 6, p = F.tid & 63;
        f32x2 a; a.x = Pre[(dir * 17 + 16) * 64 + p]; a.y = Pim[(dir * 17 + 16) * 64 + p];
        ((f32x2*)(F.ws + WS_A16))[(g * 2 + dir) * 64 + p] = a; }
    __syncthreads();
}

__device__ __forceinline__ void p0_tmat(Frame& F, float* scr, int& base, const float* src, bf16_t* dst, int K, int N, int ldd, int kind, int nrep, size_t src_rep, size_t dst_rep) {
    const int gw = F.bid * NWAVES + F.wave, NGW = F.G * NWAVES;
    const int nblk = N / 32, per = (K / 64) * nblk, tot = per * nrep;
    int first = gw - (base % NGW); if (first < 0) first += NGW;
    for (int it = first; it < tot; it += NGW) {
        const int rep = it / per, r = it - rep * per;
        transpose_item(src + (size_t)rep * src_rep, N, dst + (size_t)rep * dst_rep, ldd, kind, scr, r / nblk, r % nblk, F.lane);
    }
    base += tot;
}
__device__ __forceinline__ void p0_prologue(Frame& F) {
    for (int u = F.bid; u < 225; u += F.G) {
        if (u < 192) p0_adaln_unit(F, u);
        else if (u < 224) p0_s5_unit(F, u - 192);
        else { u32x4 z = {0u, 0u, 0u, 0u}; u32x4* dst = (u32x4*)((bf16_t*)(F.ws + WS_WMIN) + (size_t)704 * 1024);
            for (int i = F.tid; i < 64 * 1024 / 8; i += NTHREADS) dst[i] = z; }
    }
    __syncthreads();
    { f32x2* rope = (f32x2*)(F.ws + WS_ROPE);
      for (int idx = F.bid * NTHREADS + F.tid; idx < SEQ * 32; idx += F.G * NTHREADS) {
          const int l = idx >> 5, i = idx & 31;
          const float inv = powf(10000.0f, -(float)(2 * i) / 64.0f);
          const float ang = (float)l * inv; float sn, cs; sincosf(ang, &sn, &cs);
          f32x2 v; v.x = cs; v.y = sn; rope[idx] = v; } }
    float* scr = (float*)(F.lds + F.wave * 16384);
    unsigned char* ws = F.ws; int base = 0;
    p0_tmat(F, scr, base, F.in[I_ABWIN], (bf16_t*)(ws + WS_WIN), 1024, 1536, 1024, 0, 1, 0, 0);
    p0_tmat(F, scr, base, F.in[I_WGLU], (bf16_t*)(ws + WS_WGLU), 512, 512, 512, 0, 1, 0, 0);
    p0_tmat(F, scr, base, F.in[I_ABWOUT], (bf16_t*)(ws + WS_WOUT), 1024, 1024, 1024, 0, 1, 0, 0);
    p0_tmat(F, scr, base, F.in[I_FW1], (bf16_t*)(ws + WS_W13), 1024, 2816, 1024, 1, 1, 0, 0);
    p0_tmat(F, scr, base, F.in[I_FW3], (bf16_t*)(ws + WS_W13), 1024, 2816, 1024, 2, 1, 0, 0);
    p0_tmat(F, scr, base, F.in[I_FW2], (bf16_t*)(ws + WS_W2), 2816, 1024, 2816, 0, 1, 0, 0);
    p0_tmat(F, scr, base, F.in[I_MWIN], (bf16_t*)(ws + WS_WMIN), 1024, 704, 1024, 3, 1, 0, 0);
    p0_tmat(F, scr, base, F.in[I_WUQ], (bf16_t*)(ws + WS_WUQ), 384, 1536, 384, 4, 1, 0, 0);
    p0_tmat(F, scr, base, F.in[I_WUKV], (bf16_t*)(ws + WS_WUKV), 256, 2048, 256, 0, 1, 0, 0);
    p0_tmat(F, scr, base, F.in[I_WO], (bf16_t*)(ws + WS_WO), 1024, 1024, 1024, 0, 1, 0, 0);
    p0_tmat(F, scr, base, F.in[I_MW1], (bf16_t*)(ws + WS_MW13), 1024, 3584, 1024, 1, 8, (size_t)1024 * 3584, (size_t)7168 * 1024);
    p0_tmat(F, scr, base, F.in[I_MW3], (bf16_t*)(ws + WS_MW13), 1024, 3584, 1024, 2, 8, (size_t)1024 * 3584, (size_t)7168 * 1024);
    p0_tmat(F, scr, base, F.in[I_MW2], (bf16_t*)(ws + WS_MW2), 3584, 1024, 3584, 0, 8, (size_t)3584 * 1024, (size_t)1024 * 3584);
}

__device__ __forceinline__ void norm_row(const float* xrow, const float* gn, const float* sh, const float* sc, bf16_t* orow, int lane, f32x4 (&hv)[4]) {
    const f32x4* xr = (const f32x4*)xrow + lane;
    f32x4 v[4]; float s = 0.f;
#pragma unroll
    for (int j = 0; j < 4; ++j) { v[j] = xr[64 * j]; s += (v[j].x * v[j].x + v[j].y * v[j].y) + (v[j].z * v[j].z + v[j].w * v[j].w); }
    const float rstd = rsqrtf(wave_sum(s) * (1.0f / D) + RMS_EPS);
    u32x2* o8 = (u32x2*)orow + lane;
#pragma unroll
    for (int j = 0; j < 4; ++j) {
        const f32x4 g4 = ((const f32x4*)gn)[lane + 64 * j], s4 = ((const f32x4*)sh)[lane + 64 * j], c4 = ((const f32x4*)sc)[lane + 64 * j];
        f32x4 h; h.x = v[j].x * rstd * g4.x * (1.0f + c4.x) + s4.x; h.y = v[j].y * rstd * g4.y * (1.0f + c4.y) + s4.y;
        h.z = v[j].z * rstd * g4.z * (1.0f + c4.z) + s4.z; h.w = v[j].w * rstd * g4.w * (1.0f + c4.w) + s4.w;
        hv[j] = h; u32x2 w; w.x = pk2(h.x, h.y); w.y = pk2(h.z, h.w); o8[64 * j] = w; }
}
__device__ __forceinline__ void norm_phase(Frame& F, const float* X, const float* gn, int layer, int which_shift) {
    const float* mod = (const float*)(F.ws + WS_MOD) + (size_t)layer * 2 * 6144;
    bf16_t* H = (bf16_t*)(F.ws + WS_H);
    const int gw = F.bid * NWAVES + F.wave, NGW = F.G * NWAVES;
    for (int m = gw; m < T; m += NGW) { const int b = m >> 13; f32x4 hv[4];
        norm_row(X + (size_t)m * D, gn, mod + b * 6144 + which_shift * 1024, mod + b * 6144 + (which_shift + 1) * 1024, H + (size_t)m * D, F.lane, hv); }
}

__device__ __forceinline__ void zsplit_phase(Frame& F) {
    const float* Z = (const float*)(F.ws + WS_Z); bf16_t* CQ = (bf16_t*)(F.ws + WS_CQ); bf16_t* CKV = (bf16_t*)(F.ws + WS_CKV); bf16_t* Kf = (bf16_t*)(F.ws + WS_K);
    const f32x2* rope = (const f32x2*)(F.ws + WS_ROPE);
    const float* gq = F.in[I_QNG]; const float* gkv = F.in[I_KVNG];
    const int gw = F.bid * NWAVES + F.wave, NGW = F.G * NWAVES, lane = F.lane;
    for (int m = gw; m < T; m += NGW) {
        const float* z = Z + (size_t)m * CINP; const int b = m >> 13, l = m & (SEQ - 1);
        float q[6], kv[4]; float s = 0.f, s2 = 0.f;
#pragma unroll
        for (int j = 0; j < 6; ++j) { q[j] = z[lane + 64 * j]; s += q[j] * q[j]; }
#pragma unroll
        for (int j = 0; j < 4; ++j) { kv[j] = z[QL + lane + 64 * j]; s2 += kv[j] * kv[j]; }
        const float kr = z[QL + KVL + lane];
        const float r1 = rsqrtf(wave_sum(s) * (1.0f / QL) + RMS_EPS), r2 = rsqrtf(wave_sum(s2) * (1.0f / KVL) + RMS_EPS);
#pragma unroll
        for (int j = 0; j < 6; ++j) CQ[(size_t)m * QL + lane + 64 * j] = (bf16_t)f2bf(q[j] * r1 * gq[lane + 64 * j]);
#pragma unroll
        for (int j = 0; j < 4; ++j) CKV[(size_t)m * KVL + lane + 64 * j] = (bf16_t)f2bf(kv[j] * r2 * gkv[lane + 64 * j]);
        const float other = __shfl_xor(kr, 1); const int i = lane >> 1; const f32x2 cs = rope[l * 32 + i];
        const float x1 = (lane & 1) ? other : kr, x2 = (lane & 1) ? kr : other;
        const float o = (lane & 1) ? (x1 * cs.y + x2 * cs.x) : (x1 * cs.x - x2 * cs.y);
        const bf16_t ob = (bf16_t)f2bf(o);
#pragma unroll
        for (int hh = 0; hh < NH; ++hh) Kf[((size_t)(b * NH + hh) * SEQ + l) * DQK + 128 + lane] = ob;
    }
}

__device__ __forceinline__ void sgu_unit(Frame& F, int unit) {
    constexpr int PIT = 136;
    bf16_t* Ws = (bf16_t*)F.lds;
    bf16_t* Vt = Ws + 128 * PIT;
    const int g = unit & 3, n = (unit >> 2) & 63, b = unit >> 8;
    const int tok0 = b * SEQ + n * 128;
    const bf16_t* VA = (const bf16_t*)(F.ws + WS_VA); const bf16_t* UA = (const bf16_t*)(F.ws + WS_UA); bf16_t* CAT = (bf16_t*)(F.ws + WS_CAT);
    const int tid = F.tid, lane = F.lane;
    {
        const int tk = tid >> 2, c0 = (tid & 3) * 32;
        const u32x4* src = (const u32x4*)(VA + (size_t)(tok0 + tk) * A_W + g * 128 + c0);
        float v[32]; float s = 0.f;
#pragma unroll
        for (int j = 0; j < 4; ++j) { float f[8]; unpack8(src[j], f);
#pragma unroll
            for (int e = 0; e < 8; ++e) { v[j * 8 + e] = f[e]; s += f[e] * f[e]; } }
        s += __shfl_xor(s, 1); s += __shfl_xor(s, 2);
        const float rstd = rsqrtf(s * (1.0f / 128.0f) + RMS_EPS);
        const float* vg = F.in[I_SGUVG] + g * 128 + c0;
#pragma unroll
        for (int e = 0; e < 32; ++e) Vt[(c0 + e) * PIT + tk] = (bf16_t)f2bf(v[e] * rstd * vg[e]);
        const f32x4* wsrc = (const f32x4*)(F.in[I_SGUWS] + (size_t)g * 128 * 128 + (size_t)tk * 128 + c0);
#pragma unroll
        for (int j = 0; j < 4; ++j) { const f32x4 a = wsrc[2 * j], bq = wsrc[2 * j + 1];
            u32x4 w; w.x = pk2(a.x, a.y); w.y = pk2(a.z, a.w); w.z = pk2(bq.x, bq.y); w.w = pk2(bq.z, bq.w);
            *(u32x4*)(Ws + tk * PIT + c0 + 8 * j) = w; }
    }
    __syncthreads();
    f32x4 acc[8];
#pragma unroll
    for (int nn = 0; nn < 8; ++nn) acc[nn] = (f32x4){0.f, 0.f, 0.f, 0.f};
    const int fr = lane & 15, fq = lane >> 4, w = F.wave;
#pragma unroll
    for (int kk = 0; kk < 4; ++kk) {
        const bf16x8 a = *(const bf16x8*)(Ws + (16 * w + fr) * PIT + 32 * kk + 8 * fq);
#pragma unroll
        for (int nn = 0; nn < 8; ++nn) { const bf16x8 bv = *(const bf16x8*)(Vt + (16 * nn + fr) * PIT + 32 * kk + 8 * fq);
            acc[nn] = __builtin_amdgcn_mfma_f32_16x16x32_bf16(a, bv, acc[nn], 0, 0, 0); }
    }
    const float* bs = F.in[I_SGUBS] + g * 128;
#pragma unroll
    for (int nn = 0; nn < 8; ++nn)
#pragma unroll
        for (int i = 0; i < 4; ++i) { const int q = 16 * w + 4 * fq + i, c = 16 * nn + fr;
            const float sv = acc[nn][i] + bs[q];
            const size_t tok = (size_t)(tok0 + q);
            const float u = bf2f(UA[tok * A_W + g * 128 + c]);
            CAT[tok * D + g * 128 + c] = (bf16_t)f2bf(u * sv); if (i == 3) asm volatile("" ::: "memory"); }
    __syncthreads();
}

__device__ __forceinline__ void scan_wave(Frame& F, int id) {
    const int b = id >> 6, g = (id >> 1) & 31, dir = id & 1, p = F.lane;
    const float* SS = (const float*)(F.ws + WS_SS); bf16_t* AC = (bf16_t*)(F.ws + WS_AC);
    const f32x2 a16 = ((const f32x2*)(F.ws + WS_A16))[(g * 2 + dir) * 64 + p];
    float xr = 0.f, xi = 0.f;
    const size_t row0 = (size_t)g * 1024 + b * 512;
#pragma unroll 8
    for (int i = 0; i < 512; ++i) {
        const int blk = dir == 0 ? i : 511 - i; const size_t row = row0 + blk;
        const float sr = SS[row * 256 + dir * 128 + p], si = SS[row * 256 + dir * 128 + 64 + p];
        AC[row * 512 + 256 + dir * 128 + p] = (bf16_t)f2bf(xr); AC[row * 512 + 256 + dir * 128 + 64 + p] = (bf16_t)f2bf(xi);
        const float nr = a16.x * xr - a16.y * xi + sr, ni = a16.x * xi + a16.y * xr + si;
        xr = nr; xi = ni;
    }
}

struct EpiIn {
    bf16_t *UA, *VA, *AC;
    __device__ __forceinline__ void operator()(int row, int col, const float (&v)[8]) const {
        if (col < 1024) { float o[8];
#pragma unroll
            for (int j = 0; j < 8; ++j) o[j] = gelu_tanh(v[j]);
            bf16_t* dst = col < 512 ? UA + (size_t)row * A_W + col : VA + (size_t)row * A_W + (col - 512);
            *(u32x4*)dst = pack8(o);
        } else { const int cp = col - 1024, g = cp >> 4, h0 = cp & 15;
            *(u32x4*)(AC + ((size_t)g * 1024 + (row >> 4)) * 512 + (row & 15) * 16 + h0) = pack8(v); }
    }
};
struct EpiS5A {
    float* SS;
    __device__ __forceinline__ void operator()(int row, int col, const float (&v)[8]) const {
        float* d = SS + (size_t)row * 256 + (col & 255);
        *(f32x4*)d = (f32x4){v[0], v[1], v[2], v[3]}; *(f32x4*)(d + 4) = (f32x4){v[4], v[5], v[6], v[7]};
    }
};
struct EpiS5C {
    const bf16_t* AC; const float* dsk; bf16_t* YG;
    __device__ __forceinline__ void operator()(int row, int col, const float (&v)[8]) const {
        const int g = row >> 10, blk = row & 1023, cl = col & 255, t = cl >> 4, h0 = cl & 15;
        float u[8]; unpack8(*(const u32x4*)(AC + (size_t)row * 512 + cl), u);
        float o[8];
#pragma unroll
        for (int j = 0; j < 8; ++j) o[j] = gelu_tanh(v[j] + dsk[g * 16 + h0 + j] * u[j]);
        *(u32x4*)(YG + (size_t)(blk * 16 + t) * B_W + g * 16 + h0) = pack8(o);
    }
};
struct EpiGlu {
    const bf16_t* YG; bf16_t* CAT;
    __device__ __forceinline__ void operator()(int row, int col, const float (&v)[8]) const {
        float y[8]; unpack8(*(const u32x4*)(YG + (size_t)row * B_W + col), y); float o[8];
#pragma unroll
        for (int j = 0; j < 8; ++j) o[j] = y[j] * sigmoidf_(v[j]);
        *(u32x4*)(CAT + (size_t)row * D + 512 + col) = pack8(o);
    }
};
struct EpiRes {
    const float* Xin; float* X; const float* gate;
    __device__ __forceinline__ void operator()(int row, int col, const float (&v)[8]) const {
        const int b = row >> 13; const float* gt = gate + b * 6144 + col; const float* xi = Xin + (size_t)row * D + col; float* xo = X + (size_t)row * D + col;
        const f32x4 x0 = *(const f32x4*)xi, x1 = *(const f32x4*)(xi + 4), g0 = *(const f32x4*)gt, g1 = *(const f32x4*)(gt + 4);
        *(f32x4*)xo = (f32x4){x0.x + g0.x * v[0], x0.y + g0.y * v[1], x0.z + g0.z * v[2], x0.w + g0.w * v[3]};
        *(f32x4*)(xo + 4) = (f32x4){x1.x + g1.x * v[4], x1.y + g1.y * v[5], x1.z + g1.z * v[6], x1.w + g1.w * v[7]};
    }
};
struct EpiSwiglu {
    bf16_t* O; int ldo;
    __device__ __forceinline__ void operator()(int row, int col, const float (&a)[8], const float (&b)[8]) const {
        float o[8];
#pragma unroll
        for (int j = 0; j < 8; ++j) o[j] = siluf_(a[j]) * b[j];
        *(u32x4*)(O + (size_t)row * ldo + (col % ldo)) = pack8(o);
    }
};
struct EpiZ {
    float* Z;
    __device__ __forceinline__ void operator()(int row, int col, const float (&v)[8]) const {
        float* d = Z + (size_t)row * CINP + col;
        *(f32x4*)d = (f32x4){v[0], v[1], v[2], v[3]}; *(f32x4*)(d + 4) = (f32x4){v[4], v[5], v[6], v[7]};
    }
};
struct EpiQ {
    bf16_t* Q;
    __device__ __forceinline__ void operator()(int row, int col, const float (&v)[8]) const {
        const int b = row >> 13, l = row & (SEQ - 1), h = col / 192, r = col - h * 192;
        float o[8];
#pragma unroll
        for (int j = 0; j < 8; ++j) o[j] = v[j] * QSCALE;
        *(u32x4*)(Q + ((size_t)(b * NH + h) * SEQ + l) * DQK + r) = pack8(o);
    }
};
struct EpiKV {
    bf16_t *Kf, *V;
    __device__ __forceinline__ void operator()(int row, int col, const float (&v)[8]) const {
        const int b = row >> 13, l = row & (SEQ - 1), h = col >> 8, r = col & 255;
        bf16_t* d = r < 128 ? Kf + ((size_t)(b * NH + h) * SEQ + l) * DQK + r : V + ((size_t)(b * NH + h) * SEQ + l) * DV + (r - 128);
        *(u32x4*)d = pack8(v);
    }
};
struct EpiYS {
    bf16_t* YS;
    __device__ __forceinline__ void operator()(int row, int col, const float (&v)[8]) const { *(u32x4*)(YS + (size_t)row * D + (col & 1023)) = pack8(v); }
};

struct BOffNone { __device__ __forceinline__ int operator()(int) const { return 0; } };
struct BOffDiag { __device__ __forceinline__ int operator()(int row) const { return (row >> 10) * 256; } };
struct BOffMoE { int rb[9]; int nper;
    __device__ __forceinline__ int operator()(int row) const { int e = 0;
#pragma unroll
        for (int j = 1; j < 8; ++j) if (row >= rb[j]) e = j;
        return e * nper; } };

template <bool DUAL, class Epi, class BOff>
__device__ __forceinline__ void naive_gemm(Frame& F, const bf16_t* A, int lda, const bf16_t* Bt, int K, int M, int Ncols, const Epi& E, const BOff& boff) {
    const int ncg = Ncols / 8; const long total = (long)M * ncg;
    for (long it = (long)F.bid * NTHREADS + F.tid; it < total; it += (long)F.G * NTHREADS) {
        const int cgp = (int)(it / M), row = (int)(it - (long)cgp * M), col = cgp * 8;
        const int bo = boff(row);
        const bf16_t* a = A + (size_t)row * lda;
        if constexpr (!DUAL) {
            const bf16_t* bp = Bt + (size_t)(bo + col) * K;
            float acc[8];
#pragma unroll
            for (int j = 0; j < 8; ++j) acc[j] = 0.f;
            for (int k = 0; k < K; k += 8) { float av[8]; unpack8(*(const u32x4*)(a + k), av);
#pragma unroll
                for (int j = 0; j < 8; ++j) { float bv[8]; unpack8(*(const u32x4*)(bp + (size_t)j * K + k), bv);
#pragma unroll
                    for (int e = 0; e < 8; ++e) acc[j] += av[e] * bv[e]; } }
            E(row, bo + col, acc);
        } else {
            const int brow = 256 * (col >> 7) + (col & 127);
            const bf16_t* bp = Bt + (size_t)(bo + brow) * K;
            float acc[8], acc2[8];
#pragma unroll
            for (int j = 0; j < 8; ++j) { acc[j] = 0.f; acc2[j] = 0.f; }
            for (int k = 0; k < K; k += 8) { float av[8]; unpack8(*(const u32x4*)(a + k), av);
#pragma unroll
                for (int j = 0; j < 8; ++j) { float bv[8]; unpack8(*(const u32x4*)(bp + (size_t)j * K + k), bv); float cv[8]; unpack8(*(const u32x4*)(bp + (size_t)(128 + j) * K + k), cv);
#pragma unroll
                    for (int e = 0; e < 8; ++e) { acc[j] += av[e] * bv[e]; acc2[j] += av[e] * cv[e]; } } }
            E(row, bo / 2 + col, acc, acc2);
        }
    }
}


namespace pg8 {
constexpr int BM = 256, BK = 64, HALF = 128, HTB = HALF * BK * 2, STAGE_BYTES = 8 * HTB, NXCD = 8, WGM = 8;
__host__ __device__ __forceinline__ int lds_byte(int r, int c) { const int st = (r >> 4) * 2 + (c >> 5), rr = r & 15, cc = c & 31, ob = rr * 64 + cc * 2; return st * 1024 + (ob ^ (((ob >> 9) & 1) << 5)); }
__host__ __device__ __forceinline__ void stage_rc(int b, int& R, int& C) { const int st = b / 1024, sb = b % 1024, swz = sb ^ (((sb >> 9) & 1) << 5); R = (st >> 1) * 16 + swz / 64; C = (st & 1) * 32 + (swz % 64) / 2; }
__host__ __device__ __forceinline__ int perm32(int rho) { const int n = rho >> 4, i = rho & 15; return 8 * (i >> 2) + 4 * n + (i & 3); }
struct Unit { int pm, pn; };
struct Gemm { const bf16_t* A; const bf16_t* Bt; int lda, K; };

struct StaticOrder {
    int nM, nN, nwg, G, c;
    __device__ void init(int M, int N, int G_, int c_) { nM = M / BM; nN = N / BM; nwg = nM * nN; G = G_; c = c_; }
    __device__ bool next(int i, Unit& u) const {
        const long L = (long)i * G + c; if (L >= nwg) return false;
        int wgid = (int)L; { const int q = nwg / NXCD, r = nwg % NXCD, xcd = wgid % NXCD, off = wgid / NXCD; wgid = (xcd < r ? xcd * (q + 1) : r * (q + 1) + (xcd - r) * q) + off; }
        const int nig = WGM * nN, gid = wgid / nig, fm = gid * WGM, gsz = (nM - fm) < WGM ? (nM - fm) : WGM;
        u.pm = fm + ((wgid % nig) % gsz); u.pn = (wgid % nig) / gsz; return true;
    }
};
struct DiagOrder {
    int n, G, c;
    __device__ bool next(int i, Unit& u) const { const int L = i * G + c; if (L >= n) return false; u.pm = L; u.pn = L >> 2; return true; }
};
struct MoEOrder {
    int ub[9], tb[8], tl[8]; int nN, G, c, nwg;
    __device__ bool next(int i, Unit& u) const {
        const int L = i * G + c; if (L >= nwg) return false;
        int wgid = L; { const int q = nwg / NXCD, r = nwg % NXCD, xcd = wgid % NXCD, off = wgid / NXCD; wgid = (xcd < r ? xcd * (q + 1) : r * (q + 1) + (xcd - r) * q) + off; }
        int e = 0, ube = 0, tbe = 0, tle = 1;
#pragma unroll
        for (int j = 0; j < 8; ++j) if (wgid >= ub[j] && wgid < ub[j + 1]) { e = j; ube = ub[j]; tbe = tb[j]; tle = tl[j]; }
        const int local = wgid - ube, nig = WGM * nN, gid = local / nig, fm = gid * WGM, gsz = (tle - fm) < WGM ? (tle - fm) : WGM;
        u.pm = tbe + fm + ((local % nig) % gsz); u.pn = e * nN + (local % nig) / gsz; return true;
    }
};

template <class Fn> struct Epi8 {
    static constexpr bool PERM = true; Fn f;
    __device__ __forceinline__ void operator()(const f32x4 (&acc)[2][2][4][2], const Unit& u, int wr, int wc, int fr, int fq) const {
#pragma unroll
        for (int ai = 0; ai < 2; ++ai)
#pragma unroll
            for (int m = 0; m < 4; ++m) { const int row = u.pm * BM + ai * HALF + wr * 64 + m * 16 + fr;
#pragma unroll
                for (int bj = 0; bj < 2; ++bj) { const int col = u.pn * BM + bj * HALF + wc * 32 + 8 * fq;
                    const f32x4 a = acc[ai][bj][m][0], b = acc[ai][bj][m][1];
                    const float v[8] = {a[0], a[1], a[2], a[3], b[0], b[1], b[2], b[3]}; f(row, col, v); }
                asm volatile("" ::: "memory"); }
    }
};
template <class Fn> struct Epi8Dual {
    static constexpr bool PERM = true; Fn f;
    __device__ __forceinline__ void operator()(const f32x4 (&acc)[2][2][4][2], const Unit& u, int wr, int wc, int fr, int fq) const {
#pragma unroll
        for (int ai = 0; ai < 2; ++ai)
#pragma unroll
            for (int m = 0; m < 4; ++m) { const int row = u.pm * BM + ai * HALF + wr * 64 + m * 16 + fr, col = u.pn * HALF + wc * 32 + 8 * fq;
                const f32x4 a0 = acc[ai][0][m][0], a1 = acc[ai][0][m][1], b0 = acc[ai][1][m][0], b1 = acc[ai][1][m][1];
                const float a[8] = {a0[0], a0[1], a0[2], a0[3], a1[0], a1[1], a1[2], a1[3]}; const float b[8] = {b0[0], b0[1], b0[2], b0[3], b1[0], b1[1], b1[2], b1[3]};
                f(row, col, a, b); }
    }
};

template <class Epi, class Sched, bool ALIGN_EPI>
__device__ __forceinline__ void gemm_phase(LAS unsigned char* lds, const Gemm g, const Sched& S, const Epi& E) {
    int tid_ = threadIdx.x; asm volatile("" : "+v"(tid_));
    const int tid = tid_, wid = __builtin_amdgcn_readfirstlane(tid >> 6), lane = tid & 63, wr = wid >> 2, wc = wid & 3, fr = lane & 15, fq = lane >> 4;
    const int K = g.K, nt = K / BK, lda = g.lda;
    unsigned voffA[2], voffB[2];
#pragma unroll
    for (int i = 0; i < 2; ++i) { int R, C; stage_rc(tid * 16 + i * 8192, R, C); const int Rb = Epi::PERM ? ((R & ~31) + perm32(R & 31)) : R;
        voffA[i] = (unsigned)(R * lda + C) * 2u; voffB[i] = (unsigned)(Rb * K + C) * 2u; }
    const size_t kstep = (size_t)(BK * 2);
    const size_t hstepA = (size_t)HALF * lda * 2, hstepB = (size_t)HALF * K * 2;
    const size_t tstepA = 2 * hstepA, tstepB = 2 * hstepB;
    const unsigned ldsw = (unsigned)wid * 1024u;
    const int aoff = lds_byte(wr * 64 + fr, fq * 8), boff = lds_byte(wc * 32 + fr, fq * 8);
#define PG8_SA(b, h) (((b) * 2 + (h)) * HTB)
#define PG8_SB(b, h) ((4 + (b) * 2 + (h)) * HTB)
#define PG8_STAGE(bufoff, gbase, voff) do { _Pragma("unroll") for (int _i = 0; _i < 2; ++_i) \
        __builtin_amdgcn_global_load_lds((const unsigned*)((const char*)(gbase) + (voff)[_i]), (LAS unsigned*)(lds + (bufoff) + ldsw + _i * 8192), 16, 0, 0); } while (0)
#define PG8_LDA(dst, b, h) do { _Pragma("unroll") for (int m = 0; m < 4; ++m) _Pragma("unroll") for (int k = 0; k < 2; ++k) dst[m][k] = *(const LAS bf16x8*)(lds + PG8_SA(b, h) + aoff + m * 2048 + k * 1024); } while (0)
#define PG8_LDB(dst, b, h) do { _Pragma("unroll") for (int n = 0; n < 2; ++n) _Pragma("unroll") for (int k = 0; k < 2; ++k) dst[n][k] = *(const LAS bf16x8*)(lds + PG8_SB(b, h) + boff + n * 2048 + k * 1024); } while (0)
#define PG8_MMA(ai, bj, At, Bt) do { __builtin_amdgcn_s_setprio(1); _Pragma("unroll") for (int m = 0; m < 4; ++m) _Pragma("unroll") for (int n = 0; n < 2; ++n) _Pragma("unroll") for (int k = 0; k < 2; ++k) \
        acc[ai][bj][m][n] = __builtin_amdgcn_mfma_f32_16x16x32_bf16(Bt[n][k], At[m][k], acc[ai][bj][m][n], 0, 0, 0); __builtin_amdgcn_s_setprio(0); } while (0)
#define PG8_WAIT_V(n) asm volatile("s_waitcnt vmcnt(" #n ")" ::: "memory")
#define PG8_WAIT_L(n) asm volatile("s_waitcnt lgkmcnt(" #n ")" ::: "memory")
#define PG8_BAR __builtin_amdgcn_s_barrier()
#define PG8_SCHED __builtin_amdgcn_sched_barrier(0)
    Unit cur, nxt; int ui = 0;
    if (!S.next(0, cur)) return;
    f32x4 acc[2][2][4][2];
#pragma unroll
    for (int a = 0; a < 2; ++a)
#pragma unroll
        for (int b = 0; b < 2; ++b)
#pragma unroll
            for (int m = 0; m < 4; ++m)
#pragma unroll
                for (int n = 0; n < 2; ++n) acc[a][b][m][n] = (f32x4){0.f, 0.f, 0.f, 0.f};
    bf16x8 At[4][2], B0[2][2], B1[2][2];
    const char* cA = (const char*)g.A + (size_t)cur.pm * tstepA; const char* cB = (const char*)g.Bt + (size_t)cur.pn * tstepB;
    PG8_STAGE(PG8_SB(0, 0), cB, voffB); PG8_STAGE(PG8_SB(0, 1), cB + hstepB, voffB); PG8_STAGE(PG8_SA(0, 0), cA, voffA); PG8_STAGE(PG8_SA(0, 1), cA + hstepA, voffA);
    if (wr == 1) PG8_BAR;
    PG8_WAIT_V(2); PG8_BAR;
    PG8_STAGE(PG8_SB(1, 0), cB + kstep, voffB); PG8_STAGE(PG8_SA(1, 0), cA + kstep, voffA); PG8_STAGE(PG8_SB(1, 1), cB + hstepB + kstep, voffB);
    PG8_WAIT_V(6); PG8_BAR;
    for (;;) {
        const bool has_next = S.next(ui + 1, nxt);
        const char* nA = has_next ? (const char*)g.A + (size_t)nxt.pm * tstepA : cA; const char* nB = has_next ? (const char*)g.Bt + (size_t)nxt.pn * tstepB : cB;
#pragma unroll 1
        for (int t = 0; t < nt; t += 2) {
            const bool last = (t == nt - 2);
            const char* a1 = cA + (size_t)(t + 1) * kstep;
            const char* a2 = last ? nA : cA + (size_t)(t + 2) * kstep; const char* b2 = last ? nB : cB + (size_t)(t + 2) * kstep;
            const char* a3 = a2 + kstep; const char* b3 = b2 + kstep;
            PG8_LDB(B0, 0, 0); PG8_LDB(B1, 0, 1); PG8_SCHED; PG8_LDA(At, 0, 0); PG8_STAGE(PG8_SA(1, 1), a1 + hstepA, voffA);
            PG8_WAIT_V(8); PG8_WAIT_L(0); PG8_BAR; PG8_MMA(0, 0, At, B0); PG8_MMA(0, 1, At, B1); PG8_BAR; PG8_SCHED;
            PG8_LDA(At, 0, 1); PG8_STAGE(PG8_SB(0, 0), b2, voffB); PG8_STAGE(PG8_SB(0, 1), b2 + hstepB, voffB); PG8_STAGE(PG8_SA(0, 0), a2, voffA);
            PG8_WAIT_V(8); PG8_WAIT_L(0); PG8_BAR; PG8_MMA(1, 0, At, B0); PG8_MMA(1, 1, At, B1); PG8_BAR; PG8_SCHED;
            PG8_LDB(B0, 1, 0); PG8_LDB(B1, 1, 1); PG8_SCHED; PG8_LDA(At, 1, 0); PG8_STAGE(PG8_SA(0, 1), a2 + hstepA, voffA);
            PG8_WAIT_V(8); PG8_WAIT_L(0); PG8_BAR; PG8_MMA(0, 0, At, B0); PG8_MMA(0, 1, At, B1); PG8_BAR; PG8_SCHED;
            PG8_LDA(At, 1, 1); PG8_STAGE(PG8_SB(1, 0), b3, voffB); PG8_STAGE(PG8_SB(1, 1), b3 + hstepB, voffB); PG8_STAGE(PG8_SA(1, 0), a3, voffA);
            PG8_WAIT_V(8); PG8_WAIT_L(0); PG8_BAR; PG8_MMA(1, 0, At, B0); PG8_MMA(1, 1, At, B1); PG8_BAR; PG8_SCHED;
        }
        if constexpr (ALIGN_EPI) { if (wr == 0) PG8_BAR; }
        E(acc, cur, wr, wc, fr, fq);
        if (!has_next) break;
#pragma unroll
        for (int a = 0; a < 2; ++a)
#pragma unroll
            for (int b = 0; b < 2; ++b)
#pragma unroll
                for (int m = 0; m < 4; ++m)
#pragma unroll
                    for (int n = 0; n < 2; ++n) acc[a][b][m][n] = (f32x4){0.f, 0.f, 0.f, 0.f};
        cur = nxt; cA = nA; cB = nB; ++ui;
        if constexpr (ALIGN_EPI) { if (wr == 1) PG8_BAR; }
    }
    PG8_WAIT_V(0);
    if constexpr (!ALIGN_EPI) { if (wr == 0) PG8_BAR; }
    PG8_BAR;
#undef PG8_SA
#undef PG8_SB
#undef PG8_STAGE
#undef PG8_LDA
#undef PG8_LDB
#undef PG8_MMA
#undef PG8_WAIT_V
#undef PG8_WAIT_L
#undef PG8_BAR
#undef PG8_SCHED
}
}

__device__ __forceinline__ void naive_attn_phase(Frame& F) {
    const bf16_t* Q = (const bf16_t*)(F.ws + WS_Q); const bf16_t* Kf = (const bf16_t*)(F.ws + WS_K); const bf16_t* V = (const bf16_t*)(F.ws + WS_V); bf16_t* O = (bf16_t*)(F.ws + WS_O);
    float* qs = (float*)(F.lds) + F.wave * 192;
    const int gw = F.bid * NWAVES + F.wave, NGW = F.G * NWAVES, lane = F.lane;
    for (int r = gw; r < NBATCH * NH * SEQ; r += NGW) {
        const int bh = r >> 13, l = r & (SEQ - 1), b = bh >> 3, h = bh & 7;
        const bf16_t* qrow = Q + (size_t)r * DQK;
        qs[lane] = bf2f(qrow[lane]); qs[64 + lane] = bf2f(qrow[64 + lane]);
        { const float qv = bf2f(qrow[128 + lane]), other = __shfl_xor(qv, 1); const f32x2 cs = ((const f32x2*)(F.ws + WS_ROPE))[l * 32 + (lane >> 1)];
          const float x1 = (lane & 1) ? other : qv, x2 = (lane & 1) ? qv : other;
          qs[128 + lane] = (lane & 1) ? (x1 * cs.y + x2 * cs.x) : (x1 * cs.x - x2 * cs.y); }
        asm volatile("s_waitcnt lgkmcnt(0)" ::: "memory");
        float m = -1e30f, lsum = 0.f, o0 = 0.f, o1 = 0.f;
        const bf16_t* Kb = Kf + (size_t)bh * SEQ * DQK; const bf16_t* Vb = V + (size_t)bh * SEQ * DV;
        for (int j0 = 0; j0 < SEQ; j0 += 64) {
            const u32x4* kr = (const u32x4*)(Kb + (size_t)(j0 + lane) * DQK); float s = 0.f;
#pragma unroll 4
            for (int c = 0; c < 24; ++c) { float kv[8]; unpack8(kr[c], kv); const f32x4 q0 = *(const f32x4*)(qs + c * 8), q1 = *(const f32x4*)(qs + c * 8 + 4);
                s += q0.x * kv[0] + q0.y * kv[1] + q0.z * kv[2] + q0.w * kv[3] + q1.x * kv[4] + q1.y * kv[5] + q1.z * kv[6] + q1.w * kv[7]; }
            const float mn = fmaxf(m, wave_max(s)), alpha = exp2f(m - mn), pw = exp2f(s - mn);
            lsum = lsum * alpha + wave_sum(pw); m = mn; o0 *= alpha; o1 *= alpha;
            const unsigned* vp = (const unsigned*)(Vb + (size_t)j0 * DV) + lane;
#pragma unroll 8
            for (int j = 0; j < 64; ++j) { const float pj = __shfl(pw, j); const unsigned vv = vp[(size_t)j * (DV / 2)];
                o0 += pj * __uint_as_float(vv << 16); o1 += pj * __uint_as_float(vv & 0xffff0000u); }
        }
        const float inv = 1.0f / lsum;
        unsigned* orow = (unsigned*)(O + (size_t)(b * SEQ + l) * D + h * 128) + lane;
        *orow = pk2(o0 * inv, o1 * inv);
    }
}


namespace fa {
using s16x4 = __attribute__((ext_vector_type(4))) short;
using f32x16 = __attribute__((ext_vector_type(16))) float;
constexpr int KVBLK = 64, QBLK = 32;
constexpr int SHM_V = KVBLK * DV * 2, SHM_K = KVBLK * DQK * 2;
constexpr int OFF_V = 0, OFF_K = 3 * SHM_V, OFF_WS = OFF_K + 2 * SHM_K, LDS_USED = OFF_WS + NWAVES * 64 * 4;
constexpr float THR = 8.0f;
#define FA_KSWZ(row, colB) ((row) * 384 + ((colB) ^ ((((row) >> 1) & 7) << 4)))
#define FA_SBAR() __builtin_amdgcn_sched_barrier(0)
__device__ __forceinline__ int crow(int r, int hi) { return (r & 3) + 8 * (r >> 2) + 4 * hi; }
__device__ __forceinline__ unsigned cvtpk(float lo, float hi) { unsigned r; asm volatile("v_cvt_pk_bf16_f32 %0, %1, %2" : "=v"(r) : "v"(lo), "v"(hi)); return r; }
__device__ __forceinline__ void partialSM(f32x16& p0, f32x16& p1, float& m_reg, float& alpha) {
    float pmax = p0[0];
#pragma unroll
    for (int r = 1; r < 16; ++r) pmax = fmaxf(pmax, p0[r]);
#pragma unroll
    for (int r = 0; r < 16; ++r) pmax = fmaxf(pmax, p1[r]);
    { auto rr = __builtin_amdgcn_permlane32_swap(__float_as_uint(pmax), __float_as_uint(pmax), false, false);
      pmax = fmaxf(__uint_as_float(rr[0]), __uint_as_float(rr[1])); }
    float mn;
    if (__builtin_expect(__all(pmax - m_reg <= THR), 1)) { mn = m_reg; alpha = 1.f; }
    else { mn = fmaxf(m_reg, pmax); alpha = __builtin_amdgcn_exp2f(m_reg - mn); m_reg = mn; }
#pragma unroll
    for (int r = 0; r < 16; ++r) p0[r] = p0[r] - mn;
#pragma unroll
    for (int r = 0; r < 16; ++r) p1[r] = p1[r] - mn;
#pragma unroll
    for (int r = 0; r < 16; ++r) p0[r] = __builtin_amdgcn_exp2f(p0[r]);
}
__device__ __forceinline__ void finishSM(f32x16& p0, f32x16& p1, float alpha, float& l_reg, bf16x8& pa0, bf16x8& pa1, bf16x8& pa2, bf16x8& pa3) {
#pragma unroll
    for (int r = 0; r < 16; ++r) p1[r] = __builtin_amdgcn_exp2f(p1[r]);
    float ps = 0;
#pragma unroll
    for (int r = 0; r < 16; ++r) ps += p0[r];
#pragma unroll
    for (int r = 0; r < 16; ++r) ps += p1[r];
    { auto rr = __builtin_amdgcn_permlane32_swap(__float_as_uint(ps), __float_as_uint(ps), false, false);
      ps = __uint_as_float(rr[0]) + __uint_as_float(rr[1]); }
    l_reg = l_reg * alpha + ps;
#define FA_PK4(P, BASE, OUT) do { unsigned a0 = cvtpk(P[BASE + 0], P[BASE + 1]), a1 = cvtpk(P[BASE + 2], P[BASE + 3]);   \
    unsigned b0 = cvtpk(P[BASE + 4], P[BASE + 5]), b1 = cvtpk(P[BASE + 6], P[BASE + 7]);                              \
    auto r0 = __builtin_amdgcn_permlane32_swap(a0, b0, false, false); auto r1 = __builtin_amdgcn_permlane32_swap(a1, b1, false, false); \
    u32x4 w = {r0[0], r1[0], r0[1], r1[1]}; OUT = __builtin_bit_cast(bf16x8, w); } while (0)
    FA_PK4(p0, 0, pa0); FA_PK4(p0, 8, pa1); FA_PK4(p1, 0, pa2); FA_PK4(p1, 8, pa3);
#undef FA_PK4
}
__device__ __forceinline__ void qkt(f32x16& p0, f32x16& p1, const LAS unsigned char* Ks, const int (&kb)[4], const bf16x8* qr) {
    p0 = f32x16{}; p1 = f32x16{};
#pragma unroll
    for (int d0 = 0; d0 < 12; ++d0) {
        const bf16x8 b0 = *(const LAS bf16x8*)(Ks + kb[d0 & 3] + 128 * (d0 >> 2));
        const bf16x8 b1 = *(const LAS bf16x8*)(Ks + kb[d0 & 3] + 128 * (d0 >> 2) + 32 * 384);
        p0 = __builtin_amdgcn_mfma_f32_32x32x16_bf16(b0, qr[d0], p0, 0, 0, 0);
        p1 = __builtin_amdgcn_mfma_f32_32x32x16_bf16(b1, qr[d0], p1, 0, 0, 0); }
}
__device__ __forceinline__ int v_st(int k, int c) { const int kk = (k & ~0xC) | ((k & 4) << 1) | ((k & 8) >> 1); return ((kk >> 3) * 4 + (c >> 5)) * 512 + ((kk & 7) * 32 + (c & 31)) * 2; }
__device__ __forceinline__ int v_rd_base(int lane) { return ((lane & 3) << 3) | (((lane >> 2) & 3) << 6) | (((lane >> 4) & 1) << 5) | (((lane >> 5) & 1) << 8); }
constexpr int v_rd_off(int d0, int ks, int half) { return d0 * 512 + ks * 4096 + half * 2048; }
template <int OFF> __device__ __forceinline__ s16x4 tr_read(int vb) {
    s16x4 r; asm volatile("ds_read_b64_tr_b16 %0, %1 offset:%2" : "=&v"(r) : "v"(vb), "i"(OFF) : "memory"); return r;
}
template <int D0> __device__ __forceinline__ void pv_one(f32x16& od, int vb, bf16x8 pa0, bf16x8 pa1, bf16x8 pa2, bf16x8 pa3) {
    const s16x4 l0 = tr_read<v_rd_off(D0, 0, 0)>(vb), h0 = tr_read<v_rd_off(D0, 0, 1)>(vb), l1 = tr_read<v_rd_off(D0, 1, 0)>(vb), h1 = tr_read<v_rd_off(D0, 1, 1)>(vb);
    const s16x4 l2 = tr_read<v_rd_off(D0, 2, 0)>(vb), h2 = tr_read<v_rd_off(D0, 2, 1)>(vb), l3 = tr_read<v_rd_off(D0, 3, 0)>(vb), h3 = tr_read<v_rd_off(D0, 3, 1)>(vb);
    asm volatile("s_waitcnt lgkmcnt(0)" ::: "memory"); FA_SBAR();
#define FA_PK(L, H) (bf16x8){L[0], L[1], L[2], L[3], H[0], H[1], H[2], H[3]}
    od = __builtin_amdgcn_mfma_f32_32x32x16_bf16(pa0, FA_PK(l0, h0), od, 0, 0, 0);
    od = __builtin_amdgcn_mfma_f32_32x32x16_bf16(pa1, FA_PK(l1, h1), od, 0, 0, 0);
    od = __builtin_amdgcn_mfma_f32_32x32x16_bf16(pa2, FA_PK(l2, h2), od, 0, 0, 0);
    od = __builtin_amdgcn_mfma_f32_32x32x16_bf16(pa3, FA_PK(l3, h3), od, 0, 0, 0);
#undef FA_PK
}
__device__ __forceinline__ void pv_d0(f32x16* o, int vb, bf16x8 pa0, bf16x8 pa1, bf16x8 pa2, bf16x8 pa3) {
    pv_one<0>(o[0], vb, pa0, pa1, pa2, pa3); pv_one<1>(o[1], vb, pa0, pa1, pa2, pa3); pv_one<2>(o[2], vb, pa0, pa1, pa2, pa3); pv_one<3>(o[3], vb, pa0, pa1, pa2, pa3);
}

__device__ __forceinline__ void attn_unit(int bh, int qb, const bf16_t* __restrict__ Q, const bf16_t* __restrict__ Kf, const bf16_t* __restrict__ V,
                                          bf16_t* __restrict__ O, const f32x2* __restrict__ rope, LAS unsigned char* lds) {
    int tid_ = threadIdx.x; asm volatile("" : "+v"(tid_));
    const int tid = tid_, wid = __builtin_amdgcn_readfirstlane(tid >> 6), lane = tid & 63, r32 = lane & 31, hi = lane >> 5;
    LAS unsigned char* V_lds = lds + OFF_V; LAS unsigned char* K_lds = lds + OFF_K;
    LAS float* wsf = (LAS float*)(lds + OFF_WS) + wid * 64; LAS float* li_l = wsf; LAS float* al_l = wsf + 32;
    const int q0 = qb * 256, b = bh >> 3, h = bh & 7;
    const bf16_t* Kh = Kf + (size_t)bh * SEQ * DQK; const bf16_t* Vh = V + (size_t)bh * SEQ * DV;
    unsigned ksrc[3], vsrc[2];
#pragma unroll
    for (int i = 0; i < 3; ++i) { const int q = (wid * 3 + i) * 64 + lane, row = q / 24, chp = q - row * 24, ch = chp ^ ((row >> 1) & 7); ksrc[i] = (unsigned)(row * DQK + ch * 8) * 2u; }
#pragma unroll
    for (int i = 0; i < 2; ++i) { const int q = (wid * 2 + i) * 64 + lane, c8 = q & 3, kklo = (q >> 2) & 7, chi = (q >> 5) & 3, kkhi = q >> 7, kk = kkhi * 8 + kklo;
        const int k = (kk & ~0xC) | ((kk & 4) << 1) | ((kk & 8) >> 1), c = chi * 32 + c8 * 8; vsrc[i] = (unsigned)(k * DV + c) * 2u; }
#define FA_DMA_K(t, slot) do { const char* kb_ = (const char*)Kh + (size_t)(t) * (KVBLK * DQK * 2); _Pragma("unroll") for (int i_ = 0; i_ < 3; ++i_) \
        __builtin_amdgcn_global_load_lds((const unsigned*)(kb_ + ksrc[i_]), (LAS unsigned*)(K_lds + (slot) * SHM_K + (wid * 3 + i_) * 1024), 16, 0, 0); } while (0)
#define FA_DMA_V(t, soff) do { const char* vb_ = (const char*)Vh + (size_t)(t) * (KVBLK * DV * 2); _Pragma("unroll") for (int i_ = 0; i_ < 2; ++i_) \
        __builtin_amdgcn_global_load_lds((const unsigned*)(vb_ + vsrc[i_]), (LAS unsigned*)(V_lds + (soff) + (wid * 2 + i_) * 1024), 16, 0, 0); } while (0)
#define FA_DRAIN_BAR() do { asm volatile("s_waitcnt vmcnt(0)" ::: "memory"); __syncthreads(); } while (0)
    FA_DMA_K(0, 0); FA_DMA_V(0, 0);
    float m_reg = -1e30f, l_reg = 0.f; f32x16 o[4] = {}; bf16x8 qr[12];
    {   const int l = q0 + wid * QBLK + r32;
        const bf16_t* Qw = Q + ((size_t)bh * SEQ + l) * DQK + hi * 8;
#pragma unroll
        for (int d0 = 0; d0 < 8; ++d0) qr[d0] = *(const bf16x8*)(Qw + d0 * 16);
#pragma unroll
        for (int d0 = 8; d0 < 12; ++d0) { float f[8]; unpack8(*(const u32x4*)(Qw + d0 * 16), f);
            const f32x4* cs = (const f32x4*)(rope + l * 32 + 8 * (d0 - 8) + 4 * hi); const f32x4 c0 = cs[0], c1 = cs[1];
            float g[8];
            g[0] = f[0] * c0.x - f[1] * c0.y; g[1] = f[0] * c0.y + f[1] * c0.x; g[2] = f[2] * c0.z - f[3] * c0.w; g[3] = f[2] * c0.w + f[3] * c0.z;
            g[4] = f[4] * c1.x - f[5] * c1.y; g[5] = f[4] * c1.y + f[5] * c1.x; g[6] = f[6] * c1.z - f[7] * c1.w; g[7] = f[6] * c1.w + f[7] * c1.z;
            qr[d0] = __builtin_bit_cast(bf16x8, pack8(g)); }
    }
    const int vb0 = (int)(unsigned)(uintptr_t)V_lds + v_rd_base(lane);
    int kb[4];
#pragma unroll
    for (int j = 0; j < 4; ++j) kb[j] = FA_KSWZ(r32, (j * 16 + hi * 8) * 2);
#define FA_RESC(a) do { if (__any((a) < 1.f)) { if (hi == 0) al_l[r32] = (a); asm volatile("s_waitcnt lgkmcnt(0)" ::: "memory"); \
        _Pragma("unroll") for (int d = 0; d < 4; ++d) _Pragma("unroll") for (int r = 0; r < 16; ++r) o[d][r] *= al_l[crow(r, hi)]; } } while (0)
    f32x16 pA0, pA1, pB0, pB1; float alA, alB; bf16x8 pa0, pa1, pa2, pa3; constexpr int NT = SEQ / KVBLK;
    int vprev = 0, vcur = SHM_V, vnext = 2 * SHM_V;
#define FA_ROT() do { const int t_ = vprev; vprev = vcur; vcur = vnext; vnext = t_; } while (0)
    FA_DRAIN_BAR();
    FA_DMA_K(1, 1); FA_DMA_V(1, SHM_V);
    qkt(pA0, pA1, K_lds, kb, qr); partialSM(pA0, pA1, m_reg, alA);
    FA_DRAIN_BAR();
#pragma unroll 1
    for (int t = 1; t + 1 < NT; t += 2) {
        FA_DMA_K(t + 1, 0); FA_DMA_V(t + 1, vnext);
        FA_SBAR(); qkt(pB0, pB1, K_lds + SHM_K, kb, qr);
        finishSM(pA0, pA1, alA, l_reg, pa0, pa1, pa2, pa3); FA_SBAR();
        pv_d0(o, vb0 + vprev, pa0, pa1, pa2, pa3); partialSM(pB0, pB1, m_reg, alB);
        FA_DRAIN_BAR(); FA_RESC(alB); FA_ROT();
        if (t + 2 < NT) { FA_DMA_K(t + 2, 1); FA_DMA_V(t + 2, vnext); }
        FA_SBAR(); qkt(pA0, pA1, K_lds, kb, qr);
        finishSM(pB0, pB1, alB, l_reg, pa0, pa1, pa2, pa3); FA_SBAR();
        pv_d0(o, vb0 + vprev, pa0, pa1, pa2, pa3); partialSM(pA0, pA1, m_reg, alA);
        FA_DRAIN_BAR(); FA_RESC(alA); FA_ROT();
    }
    FA_SBAR(); qkt(pB0, pB1, K_lds + SHM_K, kb, qr);
    finishSM(pA0, pA1, alA, l_reg, pa0, pa1, pa2, pa3); FA_SBAR();
    pv_d0(o, vb0 + vprev, pa0, pa1, pa2, pa3); partialSM(pB0, pB1, m_reg, alB);
    FA_RESC(alB);
    finishSM(pB0, pB1, alB, l_reg, pa0, pa1, pa2, pa3); FA_SBAR();
    pv_d0(o, vb0 + vcur, pa0, pa1, pa2, pa3);
    if (hi == 0) li_l[r32] = l_reg;
    asm volatile("s_waitcnt lgkmcnt(0)" ::: "memory");
    float rli[16];
#pragma unroll
    for (int r = 0; r < 16; ++r) rli[r] = __builtin_amdgcn_rcpf(li_l[crow(r, hi)]);
    bf16_t* Ow = O + (size_t)(b * SEQ + q0 + wid * QBLK) * D + h * DV;
#pragma unroll
    for (int r = 0; r < 16; ++r) { const int orow = crow(r, hi);
#pragma unroll
        for (int d0 = 0; d0 < 4; ++d0) Ow[(size_t)orow * D + d0 * 32 + r32] = (bf16_t)f2bf(o[d0][r] * rli[r]); }
    __syncthreads();
#undef FA_DMA_K
#undef FA_DMA_V
#undef FA_DRAIN_BAR
#undef FA_RESC
#undef FA_ROT
}
}

__device__ __forceinline__ void fast_attn_phase(Frame& F, LAS unsigned char* ldsL) {
    const bf16_t* Q = (const bf16_t*)(F.ws + WS_Q); const bf16_t* Kf = (const bf16_t*)(F.ws + WS_K); const bf16_t* V = (const bf16_t*)(F.ws + WS_V); bf16_t* O = (bf16_t*)(F.ws + WS_O);
    const f32x2* rope = (const f32x2*)(F.ws + WS_ROPE);
    if (F.G == 256) { for (int i = 0; i < 2; ++i) fa::attn_unit((F.bid & 7) + 8 * i, F.bid >> 3, Q, Kf, V, O, rope, ldsL); }
    else { for (int u = F.bid; u < 512; u += F.G) fa::attn_unit(u >> 5, u & 31, Q, Kf, V, O, rope, ldsL); }
}

__device__ __forceinline__ void route_phase(Frame& F) {
    const float* X = F.out; const float* gn = F.in[I_NFFN] + 1024; const float* mod = (const float*)(F.ws + WS_MOD) + (size_t)1 * 2 * 6144;
    bf16_t* H = (bf16_t*)(F.ws + WS_H); const float* wr = F.in[I_ROUTER];
    unsigned* cnt = (unsigned*)(F.ws + WS_CTL) + CW_CNT; int* list = (int*)(F.ws + WS_LIST); int* tokinfo = (int*)(F.ws + WS_TOKINFO);
    int* le0 = (int*)F.lds; int* le1 = le0 + 64; float* lg0 = (float*)(le1 + 64); float* lg1 = lg0 + 64; int* lp0 = (int*)(lg1 + 64); int* lp1 = lp0 + 64;
    const int lane = F.lane;
    for (int chunk = F.bid; chunk < T / 64; chunk += F.G) {
        const int row0 = chunk * 64;
        for (int rr = 0; rr < 8; ++rr) {
            const int lr = F.wave * 8 + rr, m = row0 + lr, b = m >> 13; f32x4 hv[4];
            norm_row(X + (size_t)m * D, gn, mod + b * 6144 + 3 * 1024, mod + b * 6144 + 4 * 1024, H + (size_t)m * D, lane, hv);
            float lg[8];
#pragma unroll
            for (int e = 0; e < 8; ++e) lg[e] = 0.f;
#pragma unroll
            for (int j = 0; j < 4; ++j) { const float hx[4] = {hv[j].x, hv[j].y, hv[j].z, hv[j].w};
#pragma unroll
                for (int q = 0; q < 4; ++q) { const int k = 4 * lane + 256 * j + q; const f32x4 w0 = *(const f32x4*)(wr + (size_t)k * 8), w1 = *(const f32x4*)(wr + (size_t)k * 8 + 4);
                    lg[0] += hx[q] * w0.x; lg[1] += hx[q] * w0.y; lg[2] += hx[q] * w0.z; lg[3] += hx[q] * w0.w;
                    lg[4] += hx[q] * w1.x; lg[5] += hx[q] * w1.y; lg[6] += hx[q] * w1.z; lg[7] += hx[q] * w1.w; } }
#pragma unroll
            for (int e = 0; e < 8; ++e) lg[e] = wave_sum(lg[e]);
            int e0 = 0; float v0 = lg[0];
#pragma unroll
            for (int e = 1; e < 8; ++e) if (lg[e] > v0) { v0 = lg[e]; e0 = e; }
            int e1 = -1; float v1 = -3.0e38f;
#pragma unroll
            for (int e = 0; e < 8; ++e) if (e != e0 && lg[e] > v1) { v1 = lg[e]; e1 = e; }
            const float ex = __expf(v1 - v0), g0 = 1.0f / (1.0f + ex), g1 = ex / (1.0f + ex);
            if (lane == 0) { le0[lr] = e0; le1[lr] = e1; lg0[lr] = g0; lg1[lr] = g1; }
        }
        __syncthreads();
        if (F.tid < 8) { const int e = F.tid; int c = 0;
            for (int r = 0; r < 64; ++r) c += (le0[r] == e) + (le1[r] == e);
            const unsigned base = c ? atomicAdd(cnt + e, (unsigned)c) : 0u; int p = (int)base;
            for (int r = 0; r < 64; ++r) { if (le0[r] == e) { lp0[r] = p; list[e * T + p] = row0 + r; ++p; } if (le1[r] == e) { lp1[r] = p; list[e * T + p] = row0 + r; ++p; } }
        }
        __syncthreads();
        if (F.tid < 64) { const int r = F.tid; int* ti = tokinfo + (size_t)(row0 + r) * 8;
            ti[0] = le0[r]; ti[1] = lp0[r]; ti[2] = le1[r]; ti[3] = lp1[r]; ((float*)ti)[4] = lg0[r]; ((float*)ti)[5] = lg1[r]; }
        __syncthreads();
    }
}
struct MoEMeta { int rb[9]; int tiles[8]; };
__device__ __forceinline__ void moe_meta(Frame& F, MoEMeta& mm) {
    const unsigned* cnt = (const unsigned*)(F.ws + WS_CTL) + CW_CNT; int acc = 0;
#pragma unroll
    for (int e = 0; e < 8; ++e) { const int c = (int)__builtin_amdgcn_readfirstlane(__hip_atomic_load(cnt + e, __ATOMIC_RELAXED, __HIP_MEMORY_SCOPE_AGENT)); mm.rb[e] = acc; mm.tiles[e] = (c + 255) >> 8; acc += mm.tiles[e] * 256; }
    mm.rb[8] = acc;
}
__device__ __forceinline__ void gather_phase(Frame& F) {
    MoEMeta mm; moe_meta(F, mm);
    const unsigned* cnt = (const unsigned*)(F.ws + WS_CTL) + CW_CNT; const int* list = (const int*)(F.ws + WS_LIST);
    const bf16_t* H = (const bf16_t*)(F.ws + WS_H); bf16_t* XG = (bf16_t*)(F.ws + WS_XG);
    const int gw = F.bid * NWAVES + F.wave, NGW = F.G * NWAVES, lane = F.lane;
#pragma unroll
    for (int e = 0; e < 8; ++e) { const int c = (int)__hip_atomic_load(cnt + e, __ATOMIC_RELAXED, __HIP_MEMORY_SCOPE_AGENT);
        for (int p = gw; p < c; p += NGW) { const int tok = list[e * T + p];
            const u32x4* s = (const u32x4*)(H + (size_t)tok * D) + lane; u32x4* d = (u32x4*)(XG + (size_t)(mm.rb[e] + p) * D) + lane;
            d[0] = s[0]; d[64] = s[64]; } }
}
__device__ __forceinline__ void final_phase(Frame& F) {
    MoEMeta mm; moe_meta(F, mm);
    const int* tokinfo = (const int*)(F.ws + WS_TOKINFO); const bf16_t* YS = (const bf16_t*)(F.ws + WS_XG);
    const float* mod = (const float*)(F.ws + WS_MOD) + (size_t)1 * 2 * 6144; const float* fg = F.in[I_FING];
    const int gw = F.bid * NWAVES + F.wave, NGW = F.G * NWAVES, lane = F.lane;
    for (int m = gw; m < T; m += NGW) {
        const int* ti = tokinfo + (size_t)m * 8; const int e0 = ti[0], p0 = ti[1], e1 = ti[2], p1 = ti[3]; const float g0 = ((const float*)ti)[4], g1 = ((const float*)ti)[5];
        int r0 = 0, r1 = 0;
#pragma unroll
        for (int e = 0; e < 8; ++e) { if (e == e0) r0 = mm.rb[e] + p0; if (e == e1) r1 = mm.rb[e] + p1; }
        const int b = m >> 13; const float* gf = mod + b * 6144 + 5 * 1024;
        float* xr = F.out + (size_t)m * D; f32x4 v[4]; float s = 0.f;
#pragma unroll
        for (int j = 0; j < 4; ++j) { const int c = 4 * lane + 256 * j;
            const f32x4 x = *(const f32x4*)(xr + c), gg = *(const f32x4*)(gf + c);
            const u32x2 y0 = *(const u32x2*)(YS + (size_t)r0 * D + c), y1 = *(const u32x2*)(YS + (size_t)r1 * D + c);
            f32x4 y; y.x = g0 * __uint_as_float(y0.x << 16) + g1 * __uint_as_float(y1.x << 16); y.y = g0 * __uint_as_float(y0.x & 0xffff0000u) + g1 * __uint_as_float(y1.x & 0xffff0000u);
            y.z = g0 * __uint_as_float(y0.y << 16) + g1 * __uint_as_float(y1.y << 16); y.w = g0 * __uint_as_float(y0.y & 0xffff0000u) + g1 * __uint_as_float(y1.y & 0xffff0000u);
            v[j] = (f32x4){x.x + gg.x * y.x, x.y + gg.y * y.y, x.z + gg.z * y.z, x.w + gg.w * y.w};
            s += (v[j].x * v[j].x + v[j].y * v[j].y) + (v[j].z * v[j].z + v[j].w * v[j].w); }
        const float rstd = rsqrtf(wave_sum(s) * (1.0f / D) + RMS_EPS);
#pragma unroll
        for (int j = 0; j < 4; ++j) { const int c = 4 * lane + 256 * j; const f32x4 g4 = *(const f32x4*)(fg + c);
            *(f32x4*)(xr + c) = (f32x4){v[j].x * rstd * g4.x, v[j].y * rstd * g4.y, v[j].z * rstd * g4.z, v[j].w * rstd * g4.w}; }
    }
}


#define XB_TMO      128
#define XB_XCNT(j)  (256  + 64 * (j))
#define XB_XSUB(j)  (1280 + 64 * (j))
#define XB_XGEN(j)  (2304 + 64 * (j))
#define XB_TOP      3328
#define XB_TOPGEN   3392
#define XCD_BAR_WORDS 3456
#define XB_SPIN_CAP (1u << 22)
__device__ __forceinline__ unsigned xb_ld(unsigned* p)              { return __hip_atomic_load(p, __ATOMIC_RELAXED, __HIP_MEMORY_SCOPE_AGENT); }
__device__ __forceinline__ unsigned xb_add(unsigned* p, unsigned v) { return __hip_atomic_fetch_add(p, v, __ATOMIC_RELAXED, __HIP_MEMORY_SCOPE_AGENT); }
__device__ __forceinline__ unsigned xb_xcc_id() { return (unsigned)__builtin_amdgcn_s_getreg((3 << 11) | 20) & 0xFu; }
#define XB_SPIN(cond, bar) do { unsigned _sp = 0; while (cond) { __builtin_amdgcn_s_sleep(1); \
    if ((++_sp & 255u) == 0u) { if (xb_ld(&(bar)[XB_TMO])) break; if (_sp > XB_SPIN_CAP) { atomicAdd(&(bar)[XB_TMO], 1u); break; } } } } while (0)
struct XcdBarrier { unsigned* bar; unsigned x; volatile LAS unsigned* st; };
__device__ __forceinline__ XcdBarrier xcd_barrier_post(unsigned* bar, volatile LAS unsigned* st) {
    XcdBarrier b; b.bar = bar; b.x = xb_xcc_id(); b.st = st;
    if (threadIdx.x == 0) (void)xb_add(&bar[XB_XCNT(b.x)], 1u);
    return b;
}
__device__ __forceinline__ void xcd_barrier_complete(unsigned* bar, unsigned x, unsigned& nloc, unsigned& nx) {
    const unsigned G = gridDim.x * gridDim.y * gridDim.z;
    unsigned sum, cnt, mine, sp = 0u;
    for (;;) {
        sum = 0u; cnt = 0u; mine = 0u;
#pragma unroll
        for (unsigned j = 0; j < 16; ++j) { const unsigned c = xb_ld(&bar[XB_XCNT(j)]); sum += c; cnt += (c > 0u) ? 1u : 0u; mine = (j == x) ? c : mine; }
        if (sum == G) break;
        __builtin_amdgcn_s_sleep(1);
        if ((++sp & 255u) == 0u) { if (xb_ld(&bar[XB_TMO])) break; if (sp > XB_SPIN_CAP) { atomicAdd(&bar[XB_TMO], 1u); break; } }
    }
    nloc = mine > 0u ? mine : 1u; nx = cnt > 0u ? cnt : 1u;
}
__device__ __forceinline__ void xcd_barrier(const XcdBarrier& b) {
    asm volatile("s_waitcnt vmcnt(0)" ::: "memory");
    __syncthreads();
    if (threadIdx.x == 0) {
        unsigned* bar = b.bar;
        __builtin_amdgcn_s_waitcnt(0);
        unsigned nloc = b.st[0], nx = b.st[1];
        if (nloc == 0u) { xcd_barrier_complete(bar, b.x, nloc, nx); b.st[0] = nloc; b.st[1] = nx; }
        const unsigned old = xb_add(&bar[XB_XSUB(b.x)], 1u);
        const unsigned gen = old / nloc;
        if (old + 1u == (gen + 1u) * nloc) {
            __builtin_amdgcn_fence(__ATOMIC_RELEASE, "agent");
            asm volatile("s_waitcnt vmcnt(0)" ::: "memory");
            const unsigned og = xb_add(&bar[XB_TOP], 1u);
            const unsigned tg = og / nx;
            if (og + 1u == (tg + 1u) * nx) xb_add(&bar[XB_TOPGEN], 1u);
            else XB_SPIN(xb_ld(&bar[XB_TOPGEN]) == tg, bar);
            __builtin_amdgcn_fence(__ATOMIC_ACQUIRE, "agent");
            xb_add(&bar[XB_XGEN(b.x)], 1u);
            asm volatile("s_waitcnt vmcnt(0)" ::: "memory");
        } else {
            XB_SPIN(xb_ld(&bar[XB_XGEN(b.x)]) == gen, bar);
            __builtin_amdgcn_fence(__ATOMIC_ACQUIRE, "agent");
            asm volatile("s_waitcnt vmcnt(0)" ::: "memory");
        }
    }
    __syncthreads();
}

constexpr int NPH = 22;
constexpr int LDS_BYTES = 147456;

__global__ void __launch_bounds__(NTHREADS, 2) mega(Args args) {
    extern __shared__ __attribute__((aligned(16))) unsigned char lds[];
    Frame F; F.lds = lds; F.tid = threadIdx.x; F.lane = F.tid & 63; F.wave = __builtin_amdgcn_readfirstlane(F.tid >> 6);
    F.G = gridDim.x; F.bid = blockIdx.x; F.out = args.out; F.ws = args.ws; F.in = args.in;
    unsigned char* ws = args.ws;
    const int lo = args.lo, hi = args.hi;
#if MK_ONE_LAUNCH
    cg::grid_group grid = cg::this_grid();
    volatile LAS unsigned* MISC = (volatile LAS unsigned*)((LAS unsigned char*)lds + 131072 + 320);
    if (threadIdx.x < 16) MISC[threadIdx.x] = 0u;
    __syncthreads();
    XcdBarrier xbar = xcd_barrier_post((unsigned*)(ws + WS_CTL) + CW_BAR, MISC + 8);
#define GRID_BAR(k) do { if ((k) == 0) grid.sync(); else xcd_barrier(xbar); } while (0)
#else
#define GRID_BAR(k) do {} while (0)
#endif
#ifndef PHMASK
#define PHMASK 0x3fffff
#endif
#define IN(k) ((((PHMASK) >> (k)) & 1) && lo <= (k) && (k) < hi)
#define SEAM(k) do { if (IN(k) && IN((k) + 1)) GRID_BAR(k); } while (0)
    const float* mod = (const float*)(ws + WS_MOD);
    bf16_t* H = (bf16_t*)(ws + WS_H);

    LAS unsigned char* ldsL = (LAS unsigned char*)lds;
#if FAST_GEMM
#define GEMM_DENSE(A_, lda_, Bt_, K_, M_, N_, EpiT, E_) do { pg8::Gemm g_{A_, Bt_, lda_, K_}; pg8::StaticOrder S_; S_.init(M_, N_, F.G, F.bid); \
        pg8::gemm_phase<pg8::Epi8<EpiT>, pg8::StaticOrder, true>(ldsL, g_, S_, pg8::Epi8<EpiT>{E_}); } while (0)
#define GEMM_DENSE_DUAL(A_, lda_, Bt_, K_, M_, NH_, EpiT, E_) do { pg8::Gemm g_{A_, Bt_, lda_, K_}; pg8::StaticOrder S_; S_.init(M_, 2 * (NH_), F.G, F.bid); \
        pg8::gemm_phase<pg8::Epi8Dual<EpiT>, pg8::StaticOrder, true>(ldsL, g_, S_, pg8::Epi8Dual<EpiT>{E_}); } while (0)
#define GEMM_DIAG(A_, lda_, Bt_, K_, EpiT, E_) do { pg8::Gemm g_{A_, Bt_, lda_, K_}; pg8::DiagOrder S_{128, F.G, F.bid}; \
        pg8::gemm_phase<pg8::Epi8<EpiT>, pg8::DiagOrder, true>(ldsL, g_, S_, pg8::Epi8<EpiT>{E_}); } while (0)
#else
#define GEMM_DENSE(A_, lda_, Bt_, K_, M_, N_, EpiT, E_) naive_gemm<false>(F, A_, lda_, Bt_, K_, M_, N_, E_, BOffNone{})
#define GEMM_DENSE_DUAL(A_, lda_, Bt_, K_, M_, NH_, EpiT, E_) naive_gemm<true>(F, A_, lda_, Bt_, K_, M_, NH_, E_, BOffNone{})
#define GEMM_DIAG(A_, lda_, Bt_, K_, EpiT, E_) naive_gemm<false>(F, A_, lda_, Bt_, K_, 32768, 256, E_, BOffDiag{})
#endif
#define WSB(off) ((bf16_t*)(ws + (off)))
    if (IN(0)) { p0_prologue(F); } SEAM(0);
    if (IN(1)) { norm_phase(F, F.in[I_X], F.in[I_NMIX], 0, 0); } SEAM(1);
    if (IN(2)) { EpiIn E{WSB(WS_UA), WSB(WS_VA), WSB(WS_AC)};
        GEMM_DENSE(H, D, WSB(WS_WIN), D, T, AB_IN, EpiIn, E); } SEAM(2);
    if (IN(3)) { EpiS5A E{(float*)(ws + WS_SS)};
        GEMM_DIAG(WSB(WS_AC), 512, WSB(WS_GTA), 256, EpiS5A, E);
        if (F.G == 256) { if (F.bid >= 128) { for (int j = 0; j < 3; ++j) sgu_unit(F, (F.bid - 128) * 3 + j); } else sgu_unit(F, 384 + F.bid); }
        else { for (int u = F.bid; u < 512; u += F.G) sgu_unit(F, u); } } SEAM(3);
    if (IN(4)) { if (F.wave == 0) { for (int id = F.bid; id < 128; id += F.G) scan_wave(F, id); } } SEAM(4);
    if (IN(5)) { EpiS5C E{WSB(WS_AC), F.in[I_S5D], WSB(WS_YG)};
        GEMM_DIAG(WSB(WS_AC), 512, WSB(WS_BTC), 512, EpiS5C, E); } SEAM(5);
    if (IN(6)) { EpiGlu E{WSB(WS_YG), WSB(WS_CAT)};
        GEMM_DENSE(WSB(WS_YG), 512, WSB(WS_WGLU), 512, T, 512, EpiGlu, E); } SEAM(6);
    if (IN(7)) { EpiRes E{F.in[I_X], F.out, mod + 2 * 1024};
        GEMM_DENSE(WSB(WS_CAT), D, WSB(WS_WOUT), D, T, D, EpiRes, E); } SEAM(7);
    if (IN(8)) { norm_phase(F, F.out, F.in[I_NFFN], 0, 3); } SEAM(8);
    if (IN(9)) { EpiSwiglu E{WSB(WS_HF), D_FF};
        GEMM_DENSE_DUAL(H, D, WSB(WS_W13), D, T, D_FF, EpiSwiglu, E); } SEAM(9);
    if (IN(10)) { EpiRes E{F.out, F.out, mod + 5 * 1024};
        GEMM_DENSE(WSB(WS_HF), D_FF, WSB(WS_W2), D_FF, T, D, EpiRes, E); } SEAM(10);
    if (IN(11)) { norm_phase(F, F.out, F.in[I_NMIX] + 1024, 1, 0); } SEAM(11);
    if (IN(12)) { EpiZ E{(float*)(ws + WS_Z)};
        GEMM_DENSE(H, D, WSB(WS_WMIN), D, T, CINP, EpiZ, E); } SEAM(12);
    if (IN(13)) { zsplit_phase(F); } SEAM(13);
    if (IN(14)) { EpiQ Eq{WSB(WS_Q)};
        GEMM_DENSE(WSB(WS_CQ), QL, WSB(WS_WUQ), QL, T, NH * DQK, EpiQ, Eq);
        EpiKV Ek{WSB(WS_K), WSB(WS_V)};
        GEMM_DENSE(WSB(WS_CKV), KVL, WSB(WS_WUKV), KVL, T, NH * 256, EpiKV, Ek); } SEAM(14);
#if FAST_ATTN
    if (IN(15)) { fast_attn_phase(F, ldsL); } SEAM(15);
#else
    if (IN(15)) { naive_attn_phase(F); } SEAM(15);
#endif
    if (IN(16)) { EpiRes E{F.out, F.out, mod + 2 * 6144 + 2 * 1024};
        GEMM_DENSE(WSB(WS_O), D, WSB(WS_WO), D, T, D, EpiRes, E); } SEAM(16);
    if (IN(17)) { route_phase(F); } SEAM(17);
    if (IN(18)) { gather_phase(F); } SEAM(18);
    if (IN(19)) { MoEMeta mm; moe_meta(F, mm); EpiSwiglu E{WSB(WS_HM), D_FFE};
#if FAST_GEMM
        pg8::MoEOrder S_; { int acc_ = 0;
#pragma unroll
            for (int e = 0; e < 8; ++e) { S_.ub[e] = acc_; S_.tl[e] = mm.tiles[e]; S_.tb[e] = mm.rb[e] >> 8; acc_ += mm.tiles[e] * 28; }
            S_.ub[8] = acc_; S_.nwg = acc_; S_.nN = 28; S_.G = F.G; S_.c = F.bid; }
        pg8::Gemm g_{WSB(WS_XG), WSB(WS_MW13), D, D};
        pg8::gemm_phase<pg8::Epi8Dual<EpiSwiglu>, pg8::MoEOrder, true>(ldsL, g_, S_, pg8::Epi8Dual<EpiSwiglu>{E});
#else
        BOffMoE bo;
#pragma unroll
        for (int e = 0; e < 9; ++e) bo.rb[e] = mm.rb[e];
        bo.nper = 7168;
        naive_gemm<true>(F, WSB(WS_XG), D, WSB(WS_MW13), D, mm.rb[8], D_FFE, E, bo);
#endif
    } SEAM(19);
    if (IN(20)) { MoEMeta mm; moe_meta(F, mm); EpiYS E{WSB(WS_XG)};
#if FAST_GEMM
        pg8::MoEOrder S_; { int acc_ = 0;
#pragma unroll
            for (int e = 0; e < 8; ++e) { S_.ub[e] = acc_; S_.tl[e] = mm.tiles[e]; S_.tb[e] = mm.rb[e] >> 8; acc_ += mm.tiles[e] * 4; }
            S_.ub[8] = acc_; S_.nwg = acc_; S_.nN = 4; S_.G = F.G; S_.c = F.bid; }
        pg8::Gemm g_{WSB(WS_HM), WSB(WS_MW2), D_FFE, D_FFE};
        pg8::gemm_phase<pg8::Epi8<EpiYS>, pg8::MoEOrder, true>(ldsL, g_, S_, pg8::Epi8<EpiYS>{E});
#else
        BOffMoE bo;
#pragma unroll
        for (int e = 0; e < 9; ++e) bo.rb[e] = mm.rb[e];
        bo.nper = 1024;
        naive_gemm<false>(F, WSB(WS_HM), D_FFE, WSB(WS_MW2), D_FFE, mm.rb[8], D, E, bo);
#endif
    } SEAM(20);
    if (IN(21)) { final_phase(F); }
}

extern "C" void kernel_launch(void* const* d_in, const int* in_sizes, int n_in, void* d_out, int out_size, void* d_ws, size_t ws_size, hipStream_t stream) {
    static int grid = 0;
    if (grid == 0) {
        if (n_in != 34 || out_size != T * D || ws_size < WS_END) { fprintf(stderr, "kernel_launch: unexpected shapes n_in %d out %d ws %zu (need %zu)\n", n_in, out_size, ws_size, (size_t)WS_END); grid = -1; return; }
        int dev = 0, cus = 0, per_cu = 0;
        hipGetDevice(&dev); hipDeviceGetAttribute(&cus, hipDeviceAttributeMultiprocessorCount, dev);
        if (hipFuncSetAttribute((const void*)mega, hipFuncAttributeMaxDynamicSharedMemorySize, LDS_BYTES) != hipSuccess) { fprintf(stderr, "hipFuncSetAttribute failed\n"); grid = -1; return; }
        if (hipOccupancyMaxActiveBlocksPerMultiprocessor(&per_cu, (const void*)mega, NTHREADS, LDS_BYTES) != hipSuccess || per_cu < 1) { fprintf(stderr, "occupancy query failed (%d)\n", per_cu); per_cu = 1; }
        (void)hipGetLastError();
        grid = cus * per_cu;
    }
    if (grid < 0) return;
    hipMemsetAsync((char*)d_ws + WS_CTL, 0, CTL_BYTES, stream);
    Args a{};
    for (int i = 0; i < 34; ++i) a.in[i] = (const float*)d_in[i];
    a.out = (float*)d_out; a.ws = (unsigned char*)d_ws;
#if MK_ONE_LAUNCH
    a.lo = 0; a.hi = NPH;
    void* kargs[] = {&a};
    hipError_t e = hipLaunchCooperativeKernel((const void*)mega, dim3(grid), dim3(NTHREADS), kargs, LDS_BYTES, stream);
    if (e != hipSuccess) fprintf(stderr, "cooperative launch failed: %s (grid %d)\n", hipGetErrorString(e), grid);
#else
    for (int ph = 0; ph < NPH; ++ph) { a.lo = ph; a.hi = ph + 1; hipLaunchKernelGGL(mega, dim3(grid), dim3(NTHREADS), LDS_BYTES, stream, a); }
#endif
}
```

```cpp
#include <hip/hip_runtime.h>
#include <hip/hip_cooperative_groups.h>
#include <cstdio>
#include <cstdint>
namespace cg = cooperative_groups;

#ifndef MK_ONE_LAUNCH
#define MK_ONE_LAUNCH 1
#endif
#ifndef LEAK_MASK
#define LEAK_MASK 0
#endif
#ifndef LEAK_ID
#define LEAK_ID 0
#endif
#ifndef DUP_PHASE
#define DUP_PHASE -1
#endif
#ifndef FAST_GEMM
#define FAST_GEMM 1
#endif
#ifndef FAST_ATTN
#define FAST_ATTN 1
#endif

#define LAS __attribute__((address_space(3)))
typedef unsigned short bf16_t;
typedef short bf16x8 __attribute__((ext_vector_type(8)));
typedef float f32x4 __attribute__((ext_vector_type(4)));
typedef float f32x2 __attribute__((ext_vector_type(2)));
typedef unsigned u32x4 __attribute__((ext_vector_type(4)));
typedef unsigned u32x2 __attribute__((ext_vector_type(2)));

constexpr int D = 1024, SEQ = 8192, NBATCH = 2, T = NBATCH * SEQ;
constexpr int A_W = 512, B_W = 512, AB_IN = 1536;
constexpr int D_FF = 2816, NEXP = 8, D_FFE = 3584;
constexpr int QL = 384, KVL = 256, CIN = 704, CINP = 768, NH = 8, DQK = 192, DV = 128;
constexpr float RMS_EPS = 1e-6f;
constexpr int NTHREADS = 512, NWAVES = 8;
constexpr int RT_MAX = 34816;
constexpr float QSCALE = 0.07216878364870323f * 1.4426950408889634f;

constexpr size_t MiB = 1u << 20;
constexpr size_t WS_CTL = 0, CTL_BYTES = 64 * 1024;
constexpr size_t WS_MOD = 1 * MiB;
constexpr size_t WS_TOKINFO = 1 * MiB + 256 * 1024;
constexpr size_t WS_LIST = 2 * MiB;
constexpr size_t WS_MW13 = 4 * MiB;
constexpr size_t WS_MW2 = 116 * MiB;
constexpr size_t WS_XG = 172 * MiB;
constexpr size_t WS_O = 172 * MiB;
constexpr size_t WS_V = 204 * MiB;
constexpr size_t WS_HM = 240 * MiB;
constexpr size_t WS_WIN = 240 * MiB, WS_WGLU = 243 * MiB, WS_WOUT = 244 * MiB, WS_W13 = 246 * MiB, WS_W2 = 257 * MiB;
constexpr size_t WS_WMIN = 263 * MiB, WS_WUQ = 265 * MiB, WS_WUKV = 267 * MiB, WS_WO = 268 * MiB;
constexpr size_t WS_GTA = 270 * MiB, WS_BTC = 274 * MiB, WS_ROPE = 282 * MiB, WS_A16 = 284 * MiB;
constexpr size_t WS_H = 285 * MiB;
constexpr size_t WS_UA = 317 * MiB, WS_VA = 333 * MiB, WS_AC = 349 * MiB, WS_SS = 381 * MiB, WS_YG = 413 * MiB, WS_CAT = 429 * MiB;
constexpr size_t WS_HF = 317 * MiB;
constexpr size_t WS_Z = 317 * MiB, WS_Q = 317 * MiB, WS_CQ = 365 * MiB, WS_CKV = 377 * MiB, WS_K = 385 * MiB;
constexpr size_t WS_END = 478 * MiB;
constexpr int CW_CNT = 0;
constexpr int CW_KMAX = 128;
constexpr int CW_KRMAX = 256;
constexpr int CW_XRANK = 320;
constexpr int CW_CONV = 64;
constexpr int CW_BAR = 1024;

__device__ __forceinline__ float bf2f(unsigned h) { return __uint_as_float(h << 16); }
__device__ __forceinline__ unsigned f2bf(float f) { unsigned u = __float_as_uint(f); return (u + 0x7fffu + ((u >> 16) & 1u)) >> 16; }
__device__ __forceinline__ unsigned pk2(float lo, float hi) { return f2bf(lo) | (f2bf(hi) << 16); }
__device__ __forceinline__ void unpack8(const u32x4 w, float (&f)[8]) {
    f[0] = __uint_as_float(w.x << 16); f[1] = __uint_as_float(w.x & 0xffff0000u);
    f[2] = __uint_as_float(w.y << 16); f[3] = __uint_as_float(w.y & 0xffff0000u);
    f[4] = __uint_as_float(w.z << 16); f[5] = __uint_as_float(w.z & 0xffff0000u);
    f[6] = __uint_as_float(w.w << 16); f[7] = __uint_as_float(w.w & 0xffff0000u);
}
__device__ __forceinline__ u32x4 pack8(const float (&f)[8]) {
    u32x4 w; w.x = pk2(f[0], f[1]); w.y = pk2(f[2], f[3]); w.z = pk2(f[4], f[5]); w.w = pk2(f[6], f[7]); return w;
}
__device__ __forceinline__ float sigmoidf_(float x) { return 1.0f / (1.0f + __expf(-x)); }
__device__ __forceinline__ float siluf_(float x) { return x / (1.0f + __expf(-x)); }
__device__ __forceinline__ float gelu_tanh(float x) { const float z = 1.5957691216057308f * (x + 0.044715f * x * x * x); return x / (1.0f + __expf(-z)); }
__device__ __forceinline__ float wave_sum(float v) {
#pragma unroll
    for (int o = 1; o < 64; o <<= 1) v += __shfl_xor(v, o);
    return v;
}
__device__ __forceinline__ float wave_max(float v) {
#pragma unroll
    for (int o = 1; o < 64; o <<= 1) v = fmaxf(v, __shfl_xor(v, o));
    return v;
}

struct Args { const float* in[34]; float* out; unsigned char* ws; int lo, hi; };
struct Frame {
    unsigned char* lds;
    int tid, lane, wave, G, bid;
    const float* const* in;
    float* out; unsigned char* ws;
};
enum { I_X = 0, I_C, I_ADAW, I_ADAB, I_NMIX, I_NFFN, I_FING, I_ABWIN, I_SGUVG, I_SGUWS, I_SGUBS, I_LAMRE, I_LAMIM, I_LOGDT,
       I_BRE, I_BIM, I_CRE, I_CIM, I_S5D, I_WGLU, I_ABWOUT, I_FW1, I_FW3, I_FW2, I_MWIN, I_QNG, I_KVNG, I_WUQ, I_WUKV, I_WO,
       I_ROUTER, I_MW1, I_MW3, I_MW2 };

__device__ __forceinline__ int rowmap(int kind, int n) {
    switch (kind) {
        case 1: return 256 * (n >> 7) + (n & 127);
        case 2: return 256 * (n >> 7) + 128 + (n & 127);
        case 3: { if (n < 640) return n; const int i = n - 640; return 640 + 2 * (i & 31) + (i >> 5); }
        case 4: { const int h = n / 192, r = n - h * 192; if (r < 128) return n; const int i = r - 128; return h * 192 + 128 + 2 * (i & 31) + (i >> 5); }
        default: return n;
    }
}
constexpr int TSCR_BYTES = 64 * 65 * 4;
__device__ __forceinline__ void transpose_item(const float* W, int N, bf16_t* WT, int ldd, int kind, float* scr, int kb, int nb, int lane) {
    const int k0 = 64 * kb, n0 = 64 * nb;
    const float* src = W + (size_t)(k0 + (lane >> 4)) * N + n0 + (lane & 15) * 4;
    float* dstl = scr + (lane >> 4) * 65 + (lane & 15) * 4;
#pragma unroll 8
    for (int i = 0; i < 16; ++i) { const f32x4 v = *(const f32x4*)(src + (size_t)(4 * i) * N); float* d = dstl + (4 * i) * 65; d[0] = v.x; d[1] = v.y; d[2] = v.z; d[3] = v.w; }
    asm volatile("s_waitcnt lgkmcnt(0)" ::: "memory");
    const int c = lane & 7;
#pragma unroll
    for (int j = 0; j < 8; ++j) { const int n = (lane >> 3) + 8 * j; const float* sp = scr + (8 * c) * 65 + n;
        u32x4 o; o.x = pk2(sp[0 * 65], sp[1 * 65]); o.y = pk2(sp[2 * 65], sp[3 * 65]); o.z = pk2(sp[4 * 65], sp[5 * 65]); o.w = pk2(sp[6 * 65], sp[7 * 65]);
        *(u32x4*)(WT + (size_t)rowmap(kind, n0 + n) * ldd + k0 + 8 * c) = o; }
    asm volatile("s_waitcnt lgkmcnt(0)" ::: "memory");
}
constexpr int BG_TICKET = 2;
constexpr int MOE_ITEMS_PER_MAT = 8 * 16 * 56, MOE_ITEMS = 3 * MOE_ITEMS_PER_MAT;
__device__ __forceinline__ void bg_convert(unsigned char* lds_gen, unsigned char* ws, const float* const* in, int wave, int lane, int budget) {
    unsigned* ticket = (unsigned*)(ws + WS_CTL) + CW_CONV;
    float* scr = (float*)(lds_gen + wave * TSCR_BYTES);
    for (int it = 0; it < budget; ++it) {
        unsigned t = 0; if (lane == 0) t = atomicAdd(ticket, 1u);
        t = (unsigned)__builtin_amdgcn_readfirstlane((int)t) * (unsigned)BG_TICKET;
        if (t >= (unsigned)MOE_ITEMS) break;
#pragma unroll 1
        for (int q = 0; q < BG_TICKET; ++q) {
            const int tt = (int)t + q;
            const int mat = tt / MOE_ITEMS_PER_MAT, r0 = tt - mat * MOE_ITEMS_PER_MAT, rep = r0 / 896, r = r0 - rep * 896;
            if (mat < 2) transpose_item(in[mat == 0 ? I_MW1 : I_MW3] + (size_t)rep * 1024 * 3584, 3584, (bf16_t*)(ws + WS_MW13) + (size_t)rep * 7168 * 1024, 1024, mat == 0 ? 1 : 2, scr, r / 56, r % 56, lane);
            else transpose_item(in[I_MW2] + (size_t)rep * 3584 * 1024, 1024, (bf16_t*)(ws + WS_MW2) + (size_t)rep * 1024 * 3584, 3584, 0, scr, r / 16, r % 16, lane);
        }
    }
}

__device__ __forceinline__ void p0_adaln_unit(Frame& F, int unit) {
    float* silu_c = (float*)F.lds;
    float* red = (float*)(F.lds + 8192);
    const float* c = F.in[I_C];
    for (int i = F.tid; i < 2048; i += NTHREADS) silu_c[i] = siluf_(c[i]);
    __syncthreads();
    const int col = unit * 64, layer = col / 6144, j = col - layer * 6144;
    const float* w = F.in[I_ADAW] + (size_t)layer * 1024 * 6144 + j + F.lane;
    float a0 = 0.f, a1 = 0.f;
    const int kbeg = F.wave * 128;
#pragma unroll 8
    for (int k = kbeg; k < kbeg + 128; ++k) { const float wv = w[(size_t)k * 6144]; a0 += silu_c[k] * wv; a1 += silu_c[1024 + k] * wv; }
    red[(F.wave * 2 + 0) * 64 + F.lane] = a0; red[(F.wave * 2 + 1) * 64 + F.lane] = a1;
    __syncthreads();
    if (F.tid < 128) { const int b = F.tid >> 6, l = F.tid & 63; float s = 0.f;
#pragma unroll
        for (int wv = 0; wv < 8; ++wv) s += red[(wv * 2 + b) * 64 + l];
        s += F.in[I_ADAB][layer * 6144 + j + l];
        ((float*)(F.ws + WS_MOD))[(size_t)(layer * 2 + b) * 6144 + j + l] = s; }
    __syncthreads();
}

__device__ __forceinline__ void p0_s5_unit(Frame& F, int g) {
    float* Pre = (float*)F.lds;
    float* Pim = Pre + 2 * 17 * 64;
    float* BBre = Pim + 2 * 17 * 64;
    float* BBim = BBre + 2 * 64 * 16;
    float* Cre = BBim + 2 * 64 * 16;
    float* Cim = Cre + 2 * 16 * 64;
    float* Kt = Cim + 2 * 16 * 64;
    const float* lam_re = F.in[I_LAMRE]; const float* lam_im = F.in[I_LAMIM]; const float* log_dt = F.in[I_LOGDT];
    for (int idx = F.tid; idx < 2 * 17 * 64; idx += NTHREADS) {
        const int dir = idx / (17 * 64), r = idx - dir * 17 * 64, j = r >> 6, p = r & 63;
        const float dt = expf(log_dt[dir * 32 + g]);
        const float lr = lam_re[(dir * 32 + g) * 64 + p], li = lam_im[(dir * 32 + g) * 64 + p];
        const float mag = expf(lr * dt * (float)j); float sn, cs; sincosf(li * dt * (float)j, &sn, &cs);
        Pre[idx] = mag * cs; Pim[idx] = mag * sn;
    }
    for (int idx = F.tid; idx < 2 * 16 * 64; idx += NTHREADS) {
        const int dir = idx >> 10, r = idx & 1023;
        Cre[idx] = F.in[I_CRE][(size_t)(dir * 32 + g) * 1024 + r]; Cim[idx] = F.in[I_CIM][(size_t)(dir * 32 + g) * 1024 + r];
    }
    __syncthreads();
    for (int idx = F.tid; idx < 2 * 64 * 16; idx += NTHREADS) {
        const int dir = idx >> 10, r = idx & 1023, p = r >> 4;
        const float lr = lam_re[(dir * 32 + g) * 64 + p], li = lam_im[(dir * 32 + g) * 64 + p];
        const float ar = Pre[(dir * 17 + 1) * 64 + p], ai = Pim[(dir * 17 + 1) * 64 + p];
        const float den = lr * lr + li * li;
        const float fr = ((ar - 1.0f) * lr + ai * li) / den, fi = (ai * lr - (ar - 1.0f) * li) / den;
        const float br = F.in[I_BRE][(size_t)(dir * 32 + g) * 1024 + r], bi = F.in[I_BIM][(size_t)(dir * 32 + g) * 1024 + r];
        BBre[idx] = fr * br - fi * bi; BBim[idx] = fr * bi + fi * br;
    }
    __syncthreads();
    for (int idx = F.tid; idx < 2 * 16 * 16 * 16; idx += NTHREADS) {
        const int dir = idx >> 12, j = (idx >> 8) & 15, h = (idx >> 4) & 15, hp = idx & 15;
        float s = 0.f;
        for (int p = 0; p < 64; ++p) {
            const float cr = Cre[(dir * 16 + h) * 64 + p], ci = Cim[(dir * 16 + h) * 64 + p];
            const float pr = Pre[(dir * 17 + j) * 64 + p], pi = Pim[(dir * 17 + j) * 64 + p];
            const float xr = cr * pr - ci * pi, xi = cr * pi + ci * pr;
            s += xr * BBre[(dir * 64 + p) * 16 + hp] - xi * BBim[(dir * 64 + p) * 16 + hp];
        }
        Kt[idx] = s;
    }
    __syncthreads();
    bf16_t* GtA = (bf16_t*)(F.ws + WS_GTA) + (size_t)g * 256 * 256;
    for (int ch = F.tid; ch < 256 * 32; ch += NTHREADS) {
        const int np = ch >> 5, k0 = (ch & 31) * 8, dir = np >> 7, ri = (np >> 6) & 1, p = np & 63, s = k0 >> 4, h0 = k0 & 15;
        const int e = dir == 0 ? 15 - s : s;
        const float pr = Pre[(dir * 17 + e) * 64 + p], pi = Pim[(dir * 17 + e) * 64 + p];
        float v[8];
#pragma unroll
        for (int j = 0; j < 8; ++j) { const float br = BBre[(dir * 64 + p) * 16 + h0 + j], bi = BBim[(dir * 64 + p) * 16 + h0 + j];
            v[j] = ri == 0 ? (pr * br - pi * bi) : (pr * bi + pi * br); }
        *(u32x4*)(GtA + (size_t)np * 256 + k0) = pack8(v);
    }
    bf16_t* BtC = (bf16_t*)(F.ws + WS_BTC) + (size_t)g * 256 * 512;
    for (int ch = F.tid; ch < 256 * 64; ch += NTHREADS) {
        const int np = ch >> 6, k0 = (ch & 63) * 8, t = np >> 4, h = np & 15;
        float v[8];
        if (k0 < 256) {
            const int s = k0 >> 4, h0 = k0 & 15;
#pragma unroll
            for (int j = 0; j < 8; ++j) { float x = 0.f;
                if (t >= s) x += Kt[((0 * 16 + (t - s)) * 16 + h) * 16 + h0 + j];
                if (s >= t) x += Kt[((1 * 16 + (s - t)) * 16 + h) * 16 + h0 + j];
                v[j] = x; }
        } else {
            const int q = k0 - 256, dir = q >> 7, ri = (q >> 6) & 1, p0 = q & 63;
            const int e = dir == 0 ? t + 1 : 16 - t;
#pragma unroll
            for (int j = 0; j < 8; ++j) { const int p = p0 + j;
                const float cr = Cre[(dir * 16 + h) * 64 + p], ci = Cim[(dir * 16 + h) * 64 + p];
                const float pr = Pre[(dir * 17 + e) * 64 + p], pi = Pim[(dir * 17 + e) * 64 + p];
                v[j] = ri == 0 ? (cr * pr - ci * pi) : -(cr * pi + ci * pr); }
        }
        *(u32x4*)(BtC + (size_t)np * 512 + k0) = pack8(v);
    }
    if (F.tid < 128) { const int dir = F.tid >> 6, p = F.tid & 63;
        f32x2 a; a.x = Pre[(dir * 17 + 16) * 64 + p]; a.y = Pim[(dir * 17 + 16) * 64 + p];
        ((f32x2*)(F.ws + WS_A16))[(g * 2 + dir) * 64 + p] = a; }
    __syncthreads();
}

__device__ __forceinline__ void p0_tmat(Frame& F, float* scr, int& base, const float* src, bf16_t* dst, int K, int N, int ldd, int kind, int nrep, size_t src_rep, size_t dst_rep) {
    const int gw = F.bid * NWAVES + F.wave, NGW = F.G * NWAVES;
    const int nblk = N / 64, per = (K / 64) * nblk, tot = per * nrep;
    int first = gw - (base % NGW); if (first < 0) first += NGW;
    for (int it = first; it < tot; it += NGW) {
        const int rep = it / per, r = it - rep * per;
        transpose_item(src + (size_t)rep * src_rep, N, dst + (size_t)rep * dst_rep, ldd, kind, scr, r / nblk, r % nblk, F.lane);
    }
    base += tot;
}
__device__ __forceinline__ void p0_prologue(Frame& F) {
    __syncthreads();
    for (int u = F.bid; u < 225; u += F.G) {
        if (u < 192) p0_adaln_unit(F, u);
        else if (u < 224) p0_s5_unit(F, u - 192);
        else { u32x4 z = {0u, 0u, 0u, 0u}; u32x4* dst = (u32x4*)((bf16_t*)(F.ws + WS_WMIN) + (size_t)704 * 1024);
            for (int i = F.tid; i < 64 * 1024 / 8; i += NTHREADS) dst[i] = z; }
    }
    __syncthreads();
    { f32x2* rope = (f32x2*)(F.ws + WS_ROPE);
      for (int idx = F.bid * NTHREADS + F.tid; idx < SEQ * 32; idx += F.G * NTHREADS) {
          const int l = idx >> 5, i = idx & 31;
          const float inv = powf(10000.0f, -(float)(2 * i) / 64.0f);
          const float ang = (float)l * inv; float sn, cs; sincosf(ang, &sn, &cs);
          f32x2 v; v.x = cs; v.y = sn; rope[idx] = v; } }
    float* scr = (float*)(F.lds + F.wave * TSCR_BYTES);
    unsigned char* ws = F.ws; int base = 0;
    p0_tmat(F, scr, base, F.in[I_ABWIN], (bf16_t*)(ws + WS_WIN), 1024, 1536, 1024, 0, 1, 0, 0);
    p0_tmat(F, scr, base, F.in[I_WGLU], (bf16_t*)(ws + WS_WGLU), 512, 512, 512, 0, 1, 0, 0);
    p0_tmat(F, scr, base, F.in[I_ABWOUT], (bf16_t*)(ws + WS_WOUT), 1024, 1024, 1024, 0, 1, 0, 0);
    p0_tmat(F, scr, base, F.in[I_FW1], (bf16_t*)(ws + WS_W13), 1024, 2816, 1024, 1, 1, 0, 0);
    p0_tmat(F, scr, base, F.in[I_FW3], (bf16_t*)(ws + WS_W13), 1024, 2816, 1024, 2, 1, 0, 0);
    p0_tmat(F, scr, base, F.in[I_FW2], (bf16_t*)(ws + WS_W2), 2816, 1024, 2816, 0, 1, 0, 0);
    p0_tmat(F, scr, base, F.in[I_MWIN], (bf16_t*)(ws + WS_WMIN), 1024, 704, 1024, 3, 1, 0, 0);
    p0_tmat(F, scr, base, F.in[I_WUQ], (bf16_t*)(ws + WS_WUQ), 384, 1536, 384, 4, 1, 0, 0);
    p0_tmat(F, scr, base, F.in[I_WUKV], (bf16_t*)(ws + WS_WUKV), 256, 2048, 256, 0, 1, 0, 0);
    p0_tmat(F, scr, base, F.in[I_WO], (bf16_t*)(ws + WS_WO), 1024, 1024, 1024, 0, 1, 0, 0);
    p0_tmat(F, scr, base, F.in[I_MW1], (bf16_t*)(ws + WS_MW13), 1024, 3584, 1024, 1, 8, (size_t)1024 * 3584, (size_t)7168 * 1024);
    p0_tmat(F, scr, base, F.in[I_MW3], (bf16_t*)(ws + WS_MW13), 1024, 3584, 1024, 2, 8, (size_t)1024 * 3584, (size_t)7168 * 1024);
    p0_tmat(F, scr, base, F.in[I_MW2], (bf16_t*)(ws + WS_MW2), 3584, 1024, 3584, 0, 8, (size_t)3584 * 1024, (size_t)1024 * 3584);
}

__device__ __forceinline__ void norm_row(const float* xrow, const float* gn, const float* sh, const float* sc, bf16_t* orow, int lane, f32x4 (&hv)[4]) {
    const f32x4* xr = (const f32x4*)xrow + lane;
    f32x4 v[4]; float s = 0.f;
#pragma unroll
    for (int j = 0; j < 4; ++j) { v[j] = xr[64 * j]; s += (v[j].x * v[j].x + v[j].y * v[j].y) + (v[j].z * v[j].z + v[j].w * v[j].w); }
    const float rstd = rsqrtf(wave_sum(s) * (1.0f / D) + RMS_EPS);
    u32x2* o8 = (u32x2*)orow + lane;
#pragma unroll
    for (int j = 0; j < 4; ++j) {
        const f32x4 g4 = ((const f32x4*)gn)[lane + 64 * j], s4 = ((const f32x4*)sh)[lane + 64 * j], c4 = ((const f32x4*)sc)[lane + 64 * j];
        f32x4 h; h.x = v[j].x * rstd * g4.x * (1.0f + c4.x) + s4.x; h.y = v[j].y * rstd * g4.y * (1.0f + c4.y) + s4.y;
        h.z = v[j].z * rstd * g4.z * (1.0f + c4.z) + s4.z; h.w = v[j].w * rstd * g4.w * (1.0f + c4.w) + s4.w;
        hv[j] = h; u32x2 w; w.x = pk2(h.x, h.y); w.y = pk2(h.z, h.w); o8[64 * j] = w; }
}
__device__ __forceinline__ void norm_phase(Frame& F, const float* X, const float* gn, int layer, int which_shift) {
    const float* mod = (const float*)(F.ws + WS_MOD) + (size_t)layer * 2 * 6144;
    bf16_t* H = (bf16_t*)(F.ws + WS_H);
    const int gw = F.bid * NWAVES + F.wave, NGW = F.G * NWAVES;
    for (int m = gw; m < T; m += NGW) { const int b = m >> 13; f32x4 hv[4];
        norm_row(X + (size_t)m * D, gn, mod + b * 6144 + which_shift * 1024, mod + b * 6144 + (which_shift + 1) * 1024, H + (size_t)m * D, F.lane, hv); }
}

__device__ __forceinline__ void zsplit_phase(Frame& F) {
    const float* Z = (const float*)(F.ws + WS_Z); bf16_t* CQ = (bf16_t*)(F.ws + WS_CQ); bf16_t* CKV = (bf16_t*)(F.ws + WS_CKV); bf16_t* Kf = (bf16_t*)(F.ws + WS_K);
    const f32x2* rope = (const f32x2*)(F.ws + WS_ROPE);
    const float* gq = F.in[I_QNG]; const float* gkv = F.in[I_KVNG];
    const int gw = F.bid * NWAVES + F.wave, NGW = F.G * NWAVES, lane = F.lane;
    float krmax0 = 0.f, krmax1 = 0.f;
    for (int m = gw; m < T; m += NGW) {
        const float* z = Z + (size_t)m * CINP; const int b = m >> 13, l = m & (SEQ - 1);
        float q[6], kv[4]; float s = 0.f, s2 = 0.f;
#pragma unroll
        for (int j = 0; j < 6; ++j) { q[j] = z[lane + 64 * j]; s += q[j] * q[j]; }
#pragma unroll
        for (int j = 0; j < 4; ++j) { kv[j] = z[QL + lane + 64 * j]; s2 += kv[j] * kv[j]; }
        const float kr = z[QL + KVL + lane];
        const float r1 = rsqrtf(wave_sum(s) * (1.0f / QL) + RMS_EPS), r2 = rsqrtf(wave_sum(s2) * (1.0f / KVL) + RMS_EPS);
#pragma unroll
        for (int j = 0; j < 6; ++j) CQ[(size_t)m * QL + lane + 64 * j] = (bf16_t)f2bf(q[j] * r1 * gq[lane + 64 * j]);
#pragma unroll
        for (int j = 0; j < 4; ++j) CKV[(size_t)m * KVL + lane + 64 * j] = (bf16_t)f2bf(kv[j] * r2 * gkv[lane + 64 * j]);
        const float other = __shfl_xor(kr, 1); const int i = lane >> 1; const f32x2 cs = rope[l * 32 + i];
        const float x1 = (lane & 1) ? other : kr, x2 = (lane & 1) ? kr : other;
        const float o = (lane & 1) ? (x1 * cs.y + x2 * cs.x) : (x1 * cs.x - x2 * cs.y);
        const bf16_t ob = (bf16_t)f2bf(o);
        { const float orr = bf2f(ob), n2 = wave_sum(orr * orr); if (b == 0) krmax0 = fmaxf(krmax0, n2); else krmax1 = fmaxf(krmax1, n2); }
#pragma unroll
        for (int hh = 0; hh < NH; ++hh) Kf[((size_t)(b * NH + hh) * SEQ + l) * DQK + 128 + lane] = ob;
    }
    { float* red = (float*)F.lds; if (lane == 0) { red[F.wave * 2] = krmax0; red[F.wave * 2 + 1] = krmax1; }
      __syncthreads();
      if (F.tid < 2) { float m = 0.f;
#pragma unroll
          for (int w = 0; w < NWAVES; ++w) m = fmaxf(m, red[w * 2 + F.tid]);
          atomicMax((unsigned*)(F.ws + WS_CTL) + CW_KRMAX + F.tid, __float_as_uint(m)); }
      __syncthreads(); }
}

__device__ __forceinline__ void sgu_unit(Frame& F, int unit) {
    constexpr int PIT = 136;
    bf16_t* Ws = (bf16_t*)F.lds;
    bf16_t* Vt = Ws + 128 * PIT;
    const int g = unit & 3, n = (unit >> 2) & 63, b = unit >> 8;
    const int tok0 = b * SEQ + n * 128;
    const bf16_t* VA = (const bf16_t*)(F.ws + WS_VA); const bf16_t* UA = (const bf16_t*)(F.ws + WS_UA); bf16_t* CAT = (bf16_t*)(F.ws + WS_CAT);
    const int tid = F.tid, lane = F.lane;
    {
        const int tk = tid >> 2, c0 = (tid & 3) * 32;
        const u32x4* src = (const u32x4*)(VA + (size_t)(tok0 + tk) * A_W + g * 128 + c0);
        float v[32]; float s = 0.f;
#pragma unroll
        for (int j = 0; j < 4; ++j) { float f[8]; unpack8(src[j], f);
#pragma unroll
            for (int e = 0; e < 8; ++e) { v[j * 8 + e] = f[e]; s += f[e] * f[e]; } }
        s += __shfl_xor(s, 1); s += __shfl_xor(s, 2);
        const float rstd = rsqrtf(s * (1.0f / 128.0f) + RMS_EPS);
        const float* vg = F.in[I_SGUVG] + g * 128 + c0;
#pragma unroll
        for (int e = 0; e < 32; ++e) Vt[(c0 + e) * PIT + tk] = (bf16_t)f2bf(v[e] * rstd * vg[e]);
        const f32x4* wsrc = (const f32x4*)(F.in[I_SGUWS] + (size_t)g * 128 * 128 + (size_t)tk * 128 + c0);
#pragma unroll
        for (int j = 0; j < 4; ++j) { const f32x4 a = wsrc[2 * j], bq = wsrc[2 * j + 1];
            u32x4 w; w.x = pk2(a.x, a.y); w.y = pk2(a.z, a.w); w.z = pk2(bq.x, bq.y); w.w = pk2(bq.z, bq.w);
            *(u32x4*)(Ws + tk * PIT + c0 + 8 * j) = w; }
    }
    __syncthreads();
    f32x4 acc[8];
#pragma unroll
    for (int nn = 0; nn < 8; ++nn) acc[nn] = (f32x4){0.f, 0.f, 0.f, 0.f};
    const int fr = lane & 15, fq = lane >> 4, w = F.wave;
#pragma unroll
    for (int kk = 0; kk < 4; ++kk) {
        const bf16x8 a = *(const bf16x8*)(Ws + (16 * w + fr) * PIT + 32 * kk + 8 * fq);
#pragma unroll
        for (int nn = 0; nn < 8; ++nn) { const bf16x8 bv = *(const bf16x8*)(Vt + (16 * nn + fr) * PIT + 32 * kk + 8 * fq);
            acc[nn] = __builtin_amdgcn_mfma_f32_16x16x32_bf16(a, bv, acc[nn], 0, 0, 0); }
    }
    const float* bs = F.in[I_SGUBS] + g * 128;
#pragma unroll
    for (int nn = 0; nn < 8; ++nn)
#pragma unroll
        for (int i = 0; i < 4; ++i) { const int q = 16 * w + 4 * fq + i, c = 16 * nn + fr;
            const float sv = acc[nn][i] + bs[q];
            const size_t tok = (size_t)(tok0 + q);
            const float u = bf2f(UA[tok * A_W + g * 128 + c]);
            CAT[tok * D + g * 128 + c] = (bf16_t)f2bf(u * sv); if (i == 3) asm volatile("" ::: "memory"); }
    __syncthreads();
}

__device__ __forceinline__ void scan_wave(Frame& F, int id) {
    const int b = id >> 6, g = (id >> 1) & 31, dir = id & 1, p = F.lane;
    const float* SS = (const float*)(F.ws + WS_SS); bf16_t* AC = (bf16_t*)(F.ws + WS_AC);
    const f32x2 a16 = ((const f32x2*)(F.ws + WS_A16))[(g * 2 + dir) * 64 + p];
    float xr = 0.f, xi = 0.f;
    const size_t row0 = (size_t)g * 1024 + b * 512;
#pragma unroll 8
    for (int i = 0; i < 512; ++i) {
        const int blk = dir == 0 ? i : 511 - i; const size_t row = row0 + blk;
        const float sr = SS[row * 256 + dir * 128 + p], si = SS[row * 256 + dir * 128 + 64 + p];
        AC[row * 512 + 256 + dir * 128 + p] = (bf16_t)f2bf(xr); AC[row * 512 + 256 + dir * 128 + 64 + p] = (bf16_t)f2bf(xi);
        const float nr = a16.x * xr - a16.y * xi + sr, ni = a16.x * xi + a16.y * xr + si;
        xr = nr; xi = ni;
    }
}

struct EpiIn {
    bf16_t *UA, *VA, *AC;
    __device__ __forceinline__ void operator()(int row, int col, const float (&v)[8]) const {
        if (col < 1024) { float o[8];
#pragma unroll
            for (int j = 0; j < 8; ++j) o[j] = gelu_tanh(v[j]);
            bf16_t* dst = col < 512 ? UA + (size_t)row * A_W + col : VA + (size_t)row * A_W + (col - 512);
            *(u32x4*)dst = pack8(o);
        } else { const int cp = col - 1024, g = cp >> 4, h0 = cp & 15;
            *(u32x4*)(AC + ((size_t)g * 1024 + (row >> 4)) * 512 + (row & 15) * 16 + h0) = pack8(v); }
    }
};
struct EpiS5A {
    float* SS;
    __device__ __forceinline__ void operator()(int row, int col, const float (&v)[8]) const {
        float* d = SS + (size_t)row * 256 + (col & 255);
        *(f32x4*)d = (f32x4){v[0], v[1], v[2], v[3]}; *(f32x4*)(d + 4) = (f32x4){v[4], v[5], v[6], v[7]};
    }
};
struct EpiS5C {
    const bf16_t* AC; const float* dsk; bf16_t* YG;
    __device__ __forceinline__ void operator()(int row, int col, const float (&v)[8]) const {
        const int g = row >> 10, blk = row & 1023, cl = col & 255, t = cl >> 4, h0 = cl & 15;
        float u[8]; unpack8(*(const u32x4*)(AC + (size_t)row * 512 + cl), u);
        float o[8];
#pragma unroll
        for (int j = 0; j < 8; ++j) o[j] = gelu_tanh(v[j] + dsk[g * 16 + h0 + j] * u[j]);
        *(u32x4*)(YG + (size_t)(blk * 16 + t) * B_W + g * 16 + h0) = pack8(o);
    }
};
struct EpiGlu {
    const bf16_t* YG; bf16_t* CAT;
    __device__ __forceinline__ void operator()(int row, int col, const float (&v)[8]) const {
        float y[8]; unpack8(*(const u32x4*)(YG + (size_t)row * B_W + col), y); float o[8];
#pragma unroll
        for (int j = 0; j < 8; ++j) o[j] = y[j] * sigmoidf_(v[j]);
        *(u32x4*)(CAT + (size_t)row * D + 512 + col) = pack8(o);
    }
};
struct EpiRes {
    const float* Xin; float* X; const float* gate;
    __device__ __forceinline__ void operator()(int row, int col, const float (&v)[8]) const {
        const int b = row >> 13; const float* gt = gate + b * 6144 + col; const float* xi = Xin + (size_t)row * D + col; float* xo = X + (size_t)row * D + col;
        const f32x4 x0 = *(const f32x4*)xi, x1 = *(const f32x4*)(xi + 4), g0 = *(const f32x4*)gt, g1 = *(const f32x4*)(gt + 4);
        *(f32x4*)xo = (f32x4){x0.x + g0.x * v[0], x0.y + g0.y * v[1], x0.z + g0.z * v[2], x0.w + g0.w * v[3]};
        *(f32x4*)(xo + 4) = (f32x4){x1.x + g1.x * v[4], x1.y + g1.y * v[5], x1.z + g1.z * v[6], x1.w + g1.w * v[7]};
    }
};
struct EpiSwiglu {
    bf16_t* O; int ldo;
    __device__ __forceinline__ void operator()(int row, int col, const float (&a)[8], const float (&b)[8]) const {
        float o[8];
#pragma unroll
        for (int j = 0; j < 8; ++j) o[j] = siluf_(a[j]) * b[j];
        *(u32x4*)(O + (size_t)row * ldo + (col % ldo)) = pack8(o);
    }
};
struct EpiZ {
    float* Z;
    __device__ __forceinline__ void operator()(int row, int col, const float (&v)[8]) const {
        float* d = Z + (size_t)row * CINP + col;
        *(f32x4*)d = (f32x4){v[0], v[1], v[2], v[3]}; *(f32x4*)(d + 4) = (f32x4){v[4], v[5], v[6], v[7]};
    }
};
struct EpiQ {
    bf16_t* Q;
    __device__ __forceinline__ void operator()(int row, int col, const float (&v)[8]) const {
        const int b = row >> 13, l = row & (SEQ - 1), h = col / 192, r = col - h * 192;
        float o[8];
#pragma unroll
        for (int j = 0; j < 8; ++j) o[j] = v[j] * QSCALE;
        *(u32x4*)(Q + ((size_t)(b * NH + h) * SEQ + l) * DQK + r) = pack8(o);
    }
};
struct EpiKV {
    bf16_t *Kf, *V;
    __device__ __forceinline__ void operator()(int row, int col, const float (&v)[8]) const {
        const int b = row >> 13, l = row & (SEQ - 1), h = col >> 8, r = col & 255;
        bf16_t* d = r < 128 ? Kf + ((size_t)(b * NH + h) * SEQ + l) * DQK + r : V + ((size_t)(b * NH + h) * SEQ + l) * DV + (r - 128);
        *(u32x4*)d = pack8(v);
    }
};
struct EpiYS {
    bf16_t* YS;
    __device__ __forceinline__ void operator()(int row, int col, const float (&v)[8]) const { *(u32x4*)(YS + (size_t)row * D + (col & 1023)) = pack8(v); }
};

struct BOffNone { __device__ __forceinline__ int operator()(int) const { return 0; } };
struct BOffDiag { __device__ __forceinline__ int operator()(int row) const { return (row >> 10) * 256; } };
struct BOffMoE { int rb[9]; int nper;
    __device__ __forceinline__ int operator()(int row) const { int e = 0;
#pragma unroll
        for (int j = 1; j < 8; ++j) if (row >= rb[j]) e = j;
        return e * nper; } };

template <bool DUAL, class Epi, class BOff>
__device__ __forceinline__ void naive_gemm(Frame& F, const bf16_t* A, int lda, const bf16_t* Bt, int K, int M, int Ncols, const Epi& E, const BOff& boff) {
    const int ncg = Ncols / 8; const long total = (long)M * ncg;
    for (long it = (long)F.bid * NTHREADS + F.tid; it < total; it += (long)F.G * NTHREADS) {
        const int cgp = (int)(it / M), row = (int)(it - (long)cgp * M), col = cgp * 8;
        const int bo = boff(row);
        const bf16_t* a = A + (size_t)row * lda;
        if constexpr (!DUAL) {
            const bf16_t* bp = Bt + (size_t)(bo + col) * K;
            float acc[8];
#pragma unroll
            for (int j = 0; j < 8; ++j) acc[j] = 0.f;
            for (int k = 0; k < K; k += 8) { float av[8]; unpack8(*(const u32x4*)(a + k), av);
#pragma unroll
                for (int j = 0; j < 8; ++j) { float bv[8]; unpack8(*(const u32x4*)(bp + (size_t)j * K + k), bv);
#pragma unroll
                    for (int e = 0; e < 8; ++e) acc[j] += av[e] * bv[e]; } }
            E(row, bo + col, acc);
        } else {
            const int brow = 256 * (col >> 7) + (col & 127);
            const bf16_t* bp = Bt + (size_t)(bo + brow) * K;
            float acc[8], acc2[8];
#pragma unroll
            for (int j = 0; j < 8; ++j) { acc[j] = 0.f; acc2[j] = 0.f; }
            for (int k = 0; k < K; k += 8) { float av[8]; unpack8(*(const u32x4*)(a + k), av);
#pragma unroll
                for (int j = 0; j < 8; ++j) { float bv[8]; unpack8(*(const u32x4*)(bp + (size_t)j * K + k), bv); float cv[8]; unpack8(*(const u32x4*)(bp + (size_t)(128 + j) * K + k), cv);
#pragma unroll
                    for (int e = 0; e < 8; ++e) { acc[j] += av[e] * bv[e]; acc2[j] += av[e] * cv[e]; } } }
            E(row, bo / 2 + col, acc, acc2);
        }
    }
}


namespace pg8 {
constexpr int BM = 256, BK = 64, HALF = 128, HTB = HALF * BK * 2, STAGE_BYTES = 8 * HTB, NXCD = 8, WGM = 8;
__host__ __device__ __forceinline__ int lds_byte(int r, int c) { const int st = (r >> 4) * 2 + (c >> 5), rr = r & 15, cc = c & 31, ob = rr * 64 + cc * 2; return st * 1024 + (ob ^ (((ob >> 9) & 1) << 5)); }
__host__ __device__ __forceinline__ void stage_rc(int b, int& R, int& C) { const int st = b / 1024, sb = b % 1024, swz = sb ^ (((sb >> 9) & 1) << 5); R = (st >> 1) * 16 + swz / 64; C = (st & 1) * 32 + (swz % 64) / 2; }
__host__ __device__ __forceinline__ int perm32(int rho) { const int n = rho >> 4, i = rho & 15; return 8 * (i >> 2) + 4 * n + (i & 3); }
struct Unit { int pm, pn; };
struct Gemm { const bf16_t* A; const bf16_t* Bt; int lda, K; };

struct StaticOrder {
    int nM, nN, nwg, G, c;
    __device__ void init(int M, int N, int G_, int c_) { nM = M / BM; nN = N / BM; nwg = nM * nN; G = G_; c = c_; }
    __device__ bool next(int i, Unit& u) const {
        const long L = (long)i * G + c; if (L >= nwg) return false;
        int wgid = (int)L; { const int q = nwg / NXCD, r = nwg % NXCD, xcd = wgid % NXCD, off = wgid / NXCD; wgid = (xcd < r ? xcd * (q + 1) : r * (q + 1) + (xcd - r) * q) + off; }
        const int nig = WGM * nN, gid = wgid / nig, fm = gid * WGM, gsz = (nM - fm) < WGM ? (nM - fm) : WGM;
        u.pm = fm + ((wgid % nig) % gsz); u.pn = (wgid % nig) / gsz; return true;
    }
};
struct DiagOrder {
    int n, G, c;
    __device__ bool next(int i, Unit& u) const { const int L = i * G + c; if (L >= n) return false; u.pm = L; u.pn = L >> 2; return true; }
};
struct MoEOrder {
    int ub[9], tb[8], tl[8]; int nN, G, c, nwg;
    __device__ bool next(int i, Unit& u) const {
        const int L = i * G + c; if (L >= nwg) return false;
        int wgid = L; { const int q = nwg / NXCD, r = nwg % NXCD, xcd = wgid % NXCD, off = wgid / NXCD; wgid = (xcd < r ? xcd * (q + 1) : r * (q + 1) + (xcd - r) * q) + off; }
        int e = 0, ube = 0, tbe = 0, tle = 1;
#pragma unroll
        for (int j = 0; j < 8; ++j) if (wgid >= ub[j] && wgid < ub[j + 1]) { e = j; ube = ub[j]; tbe = tb[j]; tle = tl[j]; }
        const int local = wgid - ube, nig = WGM * nN, gid = local / nig, fm = gid * WGM, gsz = (tle - fm) < WGM ? (tle - fm) : WGM;
        u.pm = tbe + fm + ((local % nig) % gsz); u.pn = e * nN + (local % nig) / gsz; return true;
    }
};

template <class Fn> struct Epi8 {
    static constexpr bool PERM = true; Fn f;
    __device__ __forceinline__ void operator()(const f32x4 (&acc)[2][2][4][2], const Unit& u, int wr, int wc, int fr, int fq) const {
#pragma unroll
        for (int ai = 0; ai < 2; ++ai)
#pragma unroll
            for (int m = 0; m < 4; ++m) { const int row = u.pm * BM + ai * HALF + wr * 64 + m * 16 + fr;
#pragma unroll
                for (int bj = 0; bj < 2; ++bj) { const int col = u.pn * BM + bj * HALF + wc * 32 + 8 * fq;
                    const f32x4 a = acc[ai][bj][m][0], b = acc[ai][bj][m][1];
                    const float v[8] = {a[0], a[1], a[2], a[3], b[0], b[1], b[2], b[3]}; f(row, col, v); }
                asm volatile("" ::: "memory"); }
    }
};
template <class Fn> struct Epi8Dual {
    static constexpr bool PERM = true; Fn f;
    __device__ __forceinline__ void operator()(const f32x4 (&acc)[2][2][4][2], const Unit& u, int wr, int wc, int fr, int fq) const {
#pragma unroll
        for (int ai = 0; ai < 2; ++ai)
#pragma unroll
            for (int m = 0; m < 4; ++m) { const int row = u.pm * BM + ai * HALF + wr * 64 + m * 16 + fr, col = u.pn * HALF + wc * 32 + 8 * fq;
                const f32x4 a0 = acc[ai][0][m][0], a1 = acc[ai][0][m][1], b0 = acc[ai][1][m][0], b1 = acc[ai][1][m][1];
                const float a[8] = {a0[0], a0[1], a0[2], a0[3], a1[0], a1[1], a1[2], a1[3]}; const float b[8] = {b0[0], b0[1], b0[2], b0[3], b1[0], b1[1], b1[2], b1[3]};
                f(row, col, a, b); }
    }
};


struct EpiKVMax {
    static constexpr bool PERM = true; bf16_t *Kf, *V; unsigned* kmax;
    __device__ __forceinline__ void operator()(const f32x4 (&acc)[2][2][4][2], const Unit& u, int wr, int wc, int fr, int fq) const {
        const int h = u.pn, b = (u.pm * BM) >> 13; float pmax = 0.f;
#pragma unroll
        for (int ai = 0; ai < 2; ++ai)
#pragma unroll
            for (int m = 0; m < 4; ++m) { const int row = u.pm * BM + ai * HALF + wr * 64 + m * 16 + fr, l = row & (SEQ - 1); const int c0 = wc * 32 + 8 * fq;
                { const f32x4 a = acc[ai][0][m][0], bq = acc[ai][0][m][1]; const float v[8] = {a[0], a[1], a[2], a[3], bq[0], bq[1], bq[2], bq[3]};
                  const u32x4 w = pack8(v); *(u32x4*)(Kf + ((size_t)(b * NH + h) * SEQ + l) * DQK + c0) = w;
                  float r[8]; unpack8(w, r); float s = 0.f;
#pragma unroll
                  for (int j = 0; j < 8; ++j) s += r[j] * r[j];
                  s += __shfl_xor(s, 16); s += __shfl_xor(s, 32); pmax = fmaxf(pmax, s); }
                { const f32x4 a = acc[ai][1][m][0], bq = acc[ai][1][m][1]; const float v[8] = {a[0], a[1], a[2], a[3], bq[0], bq[1], bq[2], bq[3]};
                  *(u32x4*)(V + ((size_t)(b * NH + h) * SEQ + l) * DV + c0) = pack8(v); }
                asm volatile("" ::: "memory"); }
#pragma unroll
        for (int o = 1; o < 16; o <<= 1) pmax = fmaxf(pmax, __shfl_xor(pmax, o));
        if (fr == 0 && fq == 0) atomicMax(kmax + (b * NH + h) * 4 + wc, __float_as_uint(pmax));
    }
};

template <class Epi, class Sched, bool ALIGN_EPI>
__device__ __forceinline__ void gemm_phase(LAS unsigned char* lds, const Gemm g, const Sched& S, const Epi& E) {
    int tid_ = threadIdx.x; asm volatile("" : "+v"(tid_));
    const int tid = tid_, wid = __builtin_amdgcn_readfirstlane(tid >> 6), lane = tid & 63, wr = wid >> 2, wc = wid & 3, fr = lane & 15, fq = lane >> 4;
    const int K = g.K, nt = K / BK, lda = g.lda;
    unsigned voffA[2], voffB[2];
#pragma unroll
    for (int i = 0; i < 2; ++i) { int R, C; stage_rc(tid * 16 + i * 8192, R, C); const int Rb = Epi::PERM ? ((R & ~31) + perm32(R & 31)) : R;
        voffA[i] = (unsigned)(R * lda + C) * 2u; voffB[i] = (unsigned)(Rb * K + C) * 2u; }
    const size_t kstep = (size_t)(BK * 2);
    const size_t hstepA = (size_t)HALF * lda * 2, hstepB = (size_t)HALF * K * 2;
    const size_t tstepA = 2 * hstepA, tstepB = 2 * hstepB;
    const unsigned ldsw = (unsigned)wid * 1024u;
    const int aoff = lds_byte(wr * 64 + fr, fq * 8), boff = lds_byte(wc * 32 + fr, fq * 8);
#define PG8_SA(b, h) (((b) * 2 + (h)) * HTB)
#define PG8_SB(b, h) ((4 + (b) * 2 + (h)) * HTB)
#define PG8_STAGE(bufoff, gbase, voff) do { _Pragma("unroll") for (int _i = 0; _i < 2; ++_i) \
        __builtin_amdgcn_global_load_lds((const unsigned*)((const char*)(gbase) + (voff)[_i]), (LAS unsigned*)(lds + (bufoff) + ldsw + _i * 8192), 16, 0, 0); } while (0)
#define PG8_LDA(dst, b, h) do { _Pragma("unroll") for (int m = 0; m < 4; ++m) _Pragma("unroll") for (int k = 0; k < 2; ++k) dst[m][k] = *(const LAS bf16x8*)(lds + PG8_SA(b, h) + aoff + m * 2048 + k * 1024); } while (0)
#define PG8_LDB(dst, b, h) do { _Pragma("unroll") for (int n = 0; n < 2; ++n) _Pragma("unroll") for (int k = 0; k < 2; ++k) dst[n][k] = *(const LAS bf16x8*)(lds + PG8_SB(b, h) + boff + n * 2048 + k * 1024); } while (0)
#define PG8_MMA(ai, bj, At, Bt) do { __builtin_amdgcn_s_setprio(1); _Pragma("unroll") for (int m = 0; m < 4; ++m) _Pragma("unroll") for (int n = 0; n < 2; ++n) _Pragma("unroll") for (int k = 0; k < 2; ++k) \
        acc[ai][bj][m][n] = __builtin_amdgcn_mfma_f32_16x16x32_bf16(Bt[n][k], At[m][k], acc[ai][bj][m][n], 0, 0, 0); __builtin_amdgcn_s_setprio(0); } while (0)
#define PG8_WAIT_V(n) asm volatile("s_waitcnt vmcnt(" #n ")" ::: "memory")
#define PG8_WAIT_L(n) asm volatile("s_waitcnt lgkmcnt(" #n ")" ::: "memory")
#define PG8_BAR __builtin_amdgcn_s_barrier()
#define PG8_SCHED __builtin_amdgcn_sched_barrier(0)
    Unit cur, nxt; int ui = 0;
    if (!S.next(0, cur)) return;
    f32x4 acc[2][2][4][2];
#pragma unroll
    for (int a = 0; a < 2; ++a)
#pragma unroll
        for (int b = 0; b < 2; ++b)
#pragma unroll
            for (int m = 0; m < 4; ++m)
#pragma unroll
                for (int n = 0; n < 2; ++n) acc[a][b][m][n] = (f32x4){0.f, 0.f, 0.f, 0.f};
    bf16x8 At[4][2], B0[2][2], B1[2][2];
    const char* cA = (const char*)g.A + (size_t)cur.pm * tstepA; const char* cB = (const char*)g.Bt + (size_t)cur.pn * tstepB;
    PG8_STAGE(PG8_SB(0, 0), cB, voffB); PG8_STAGE(PG8_SB(0, 1), cB + hstepB, voffB); PG8_STAGE(PG8_SA(0, 0), cA, voffA); PG8_STAGE(PG8_SA(0, 1), cA + hstepA, voffA);
    if (wr == 1) PG8_BAR;
    PG8_WAIT_V(2); PG8_BAR;
    PG8_STAGE(PG8_SB(1, 0), cB + kstep, voffB); PG8_STAGE(PG8_SA(1, 0), cA + kstep, voffA); PG8_STAGE(PG8_SB(1, 1), cB + hstepB + kstep, voffB);
    PG8_WAIT_V(6); PG8_BAR;
    for (;;) {
        const bool has_next = S.next(ui + 1, nxt);
        const char* nA = has_next ? (const char*)g.A + (size_t)nxt.pm * tstepA : cA; const char* nB = has_next ? (const char*)g.Bt + (size_t)nxt.pn * tstepB : cB;
#pragma unroll 1
        for (int t = 0; t < nt; t += 2) {
            const bool last = (t == nt - 2);
            const char* a1 = cA + (size_t)(t + 1) * kstep;
            const char* a2 = last ? nA : cA + (size_t)(t + 2) * kstep; const char* b2 = last ? nB : cB + (size_t)(t + 2) * kstep;
            const char* a3 = a2 + kstep; const char* b3 = b2 + kstep;
            PG8_LDB(B0, 0, 0); PG8_LDB(B1, 0, 1); PG8_SCHED; PG8_LDA(At, 0, 0); PG8_STAGE(PG8_SA(1, 1), a1 + hstepA, voffA);
            PG8_WAIT_V(8); PG8_WAIT_L(0); PG8_BAR; PG8_MMA(0, 0, At, B0); PG8_MMA(0, 1, At, B1); PG8_BAR; PG8_SCHED;
            PG8_LDA(At, 0, 1); PG8_STAGE(PG8_SB(0, 0), b2, voffB); PG8_STAGE(PG8_SB(0, 1), b2 + hstepB, voffB); PG8_STAGE(PG8_SA(0, 0), a2, voffA);
            PG8_WAIT_V(8); PG8_WAIT_L(0); PG8_BAR; PG8_MMA(1, 0, At, B0); PG8_MMA(1, 1, At, B1); PG8_BAR; PG8_SCHED;
            PG8_LDB(B0, 1, 0); PG8_LDB(B1, 1, 1); PG8_SCHED; PG8_LDA(At, 1, 0); PG8_STAGE(PG8_SA(0, 1), a2 + hstepA, voffA);
            PG8_WAIT_V(8); PG8_WAIT_L(0); PG8_BAR; PG8_MMA(0, 0, At, B0); PG8_MMA(0, 1, At, B1); PG8_BAR; PG8_SCHED;
            PG8_LDA(At, 1, 1); PG8_STAGE(PG8_SB(1, 0), b3, voffB); PG8_STAGE(PG8_SB(1, 1), b3 + hstepB, voffB); PG8_STAGE(PG8_SA(1, 0), a3, voffA);
            PG8_WAIT_V(8); PG8_WAIT_L(0); PG8_BAR; PG8_MMA(1, 0, At, B0); PG8_MMA(1, 1, At, B1); PG8_BAR; PG8_SCHED;
        }
        if constexpr (ALIGN_EPI) { if (wr == 0) PG8_BAR; }
        E(acc, cur, wr, wc, fr, fq);
        if (!has_next) break;
#pragma unroll
        for (int a = 0; a < 2; ++a)
#pragma unroll
            for (int b = 0; b < 2; ++b)
#pragma unroll
                for (int m = 0; m < 4; ++m)
#pragma unroll
                    for (int n = 0; n < 2; ++n) acc[a][b][m][n] = (f32x4){0.f, 0.f, 0.f, 0.f};
        cur = nxt; cA = nA; cB = nB; ++ui;
        if constexpr (ALIGN_EPI) { if (wr == 1) PG8_BAR; }
    }
    PG8_WAIT_V(0);
    if constexpr (!ALIGN_EPI) { if (wr == 0) PG8_BAR; }
    PG8_BAR;
#undef PG8_SA
#undef PG8_SB
#undef PG8_STAGE
#undef PG8_LDA
#undef PG8_LDB
#undef PG8_MMA
#undef PG8_WAIT_V
#undef PG8_WAIT_L
#undef PG8_BAR
#undef PG8_SCHED
}
}

__device__ __forceinline__ void naive_attn_phase(Frame& F) {
    const bf16_t* Q = (const bf16_t*)(F.ws + WS_Q); const bf16_t* Kf = (const bf16_t*)(F.ws + WS_K); const bf16_t* V = (const bf16_t*)(F.ws + WS_V); bf16_t* O = (bf16_t*)(F.ws + WS_O);
    float* qs = (float*)(F.lds) + F.wave * 192;
    const int gw = F.bid * NWAVES + F.wave, NGW = F.G * NWAVES, lane = F.lane;
    for (int r = gw; r < NBATCH * NH * SEQ; r += NGW) {
        const int bh = r >> 13, l = r & (SEQ - 1), b = bh >> 3, h = bh & 7;
        const bf16_t* qrow = Q + (size_t)r * DQK;
        qs[lane] = bf2f(qrow[lane]); qs[64 + lane] = bf2f(qrow[64 + lane]);
        { const float qv = bf2f(qrow[128 + lane]), other = __shfl_xor(qv, 1); const f32x2 cs = ((const f32x2*)(F.ws + WS_ROPE))[l * 32 + (lane >> 1)];
          const float x1 = (lane & 1) ? other : qv, x2 = (lane & 1) ? qv : other;
          qs[128 + lane] = (lane & 1) ? (x1 * cs.y + x2 * cs.x) : (x1 * cs.x - x2 * cs.y); }
        asm volatile("s_waitcnt lgkmcnt(0)" ::: "memory");
        float m = -1e30f, lsum = 0.f, o0 = 0.f, o1 = 0.f;
        const bf16_t* Kb = Kf + (size_t)bh * SEQ * DQK; const bf16_t* Vb = V + (size_t)bh * SEQ * DV;
        for (int j0 = 0; j0 < SEQ; j0 += 64) {
            const u32x4* kr = (const u32x4*)(Kb + (size_t)(j0 + lane) * DQK); float s = 0.f;
#pragma unroll 4
            for (int c = 0; c < 24; ++c) { float kv[8]; unpack8(kr[c], kv); const f32x4 q0 = *(const f32x4*)(qs + c * 8), q1 = *(const f32x4*)(qs + c * 8 + 4);
                s += q0.x * kv[0] + q0.y * kv[1] + q0.z * kv[2] + q0.w * kv[3] + q1.x * kv[4] + q1.y * kv[5] + q1.z * kv[6] + q1.w * kv[7]; }
            const float mn = fmaxf(m, wave_max(s)), alpha = exp2f(m - mn), pw = exp2f(s - mn);
            lsum = lsum * alpha + wave_sum(pw); m = mn; o0 *= alpha; o1 *= alpha;
            const unsigned* vp = (const unsigned*)(Vb + (size_t)j0 * DV) + lane;
#pragma unroll 8
            for (int j = 0; j < 64; ++j) { const float pj = __shfl(pw, j); const unsigned vv = vp[(size_t)j * (DV / 2)];
                o0 += pj * __uint_as_float(vv << 16); o1 += pj * __uint_as_float(vv & 0xffff0000u); }
        }
        const float inv = 1.0f / lsum;
        unsigned* orow = (unsigned*)(O + (size_t)(b * SEQ + l) * D + h * 128) + lane;
        *orow = pk2(o0 * inv, o1 * inv);
    }
}


namespace fa {
using s16x4 = __attribute__((ext_vector_type(4))) short;
using f32x16 = __attribute__((ext_vector_type(16))) float;
constexpr int KVBLK = 64, QBLK = 32;
constexpr int SHM_V = KVBLK * DV * 2, SHM_K = KVBLK * DQK * 2;
constexpr int OFF_V = 0, OFF_K = 3 * SHM_V, OFF_WS = OFF_K + 2 * SHM_K, LDS_USED = OFF_WS + NWAVES * 64 * 4;
#define FA_KSWZ(row, colB) ((row) * 384 + ((colB) ^ ((((row) >> 1) & 7) << 4)))
#define FA_SBAR() __builtin_amdgcn_sched_barrier(0)
__device__ __forceinline__ int crow(int r, int hi) { return (r & 3) + 8 * (r >> 2) + 4 * hi; }
__device__ __forceinline__ unsigned cvtpk(float lo, float hi) { unsigned r; asm volatile("v_cvt_pk_bf16_f32 %0, %1, %2" : "=v"(r) : "v"(lo), "v"(hi)); return r; }
__device__ __forceinline__ void sumpack(const f32x16& p0, const f32x16& p1, float& l_reg, bf16x8& pa0, bf16x8& pa1, bf16x8& pa2, bf16x8& pa3) {
    float ps = 0;
#pragma unroll
    for (int r = 0; r < 16; ++r) ps += p0[r];
#pragma unroll
    for (int r = 0; r < 16; ++r) ps += p1[r];
    l_reg += ps;
#define FA_PK4(P, BASE, OUT) do { unsigned a0 = cvtpk(P[BASE + 0], P[BASE + 1]), a1 = cvtpk(P[BASE + 2], P[BASE + 3]);   \
    unsigned b0 = cvtpk(P[BASE + 4], P[BASE + 5]), b1 = cvtpk(P[BASE + 6], P[BASE + 7]);                              \
    auto r0 = __builtin_amdgcn_permlane32_swap(a0, b0, false, false); auto r1 = __builtin_amdgcn_permlane32_swap(a1, b1, false, false); \
    u32x4 w = {r0[0], r1[0], r0[1], r1[1]}; OUT = __builtin_bit_cast(bf16x8, w); } while (0)
    FA_PK4(p0, 0, pa0); FA_PK4(p0, 8, pa1); FA_PK4(p1, 0, pa2); FA_PK4(p1, 8, pa3);
#undef FA_PK4
}
__device__ __forceinline__ void qkt(f32x16& p0, f32x16& p1, const LAS unsigned char* Ks, const int (&kb)[4], const bf16x8* qr) {
    p0 = f32x16{}; p1 = f32x16{};
#pragma unroll
    for (int d0 = 0; d0 < 12; ++d0) {
        const bf16x8 b0 = *(const LAS bf16x8*)(Ks + kb[d0 & 3] + 128 * (d0 >> 2));
        const bf16x8 b1 = *(const LAS bf16x8*)(Ks + kb[d0 & 3] + 128 * (d0 >> 2) + 32 * 384);
        p0 = __builtin_amdgcn_mfma_f32_32x32x16_bf16(b0, qr[d0], p0, 0, 0, 0);
        p1 = __builtin_amdgcn_mfma_f32_32x32x16_bf16(b1, qr[d0], p1, 0, 0, 0); }
}
__device__ __forceinline__ int v_st(int k, int c) { const int kk = (k & ~0xC) | ((k & 4) << 1) | ((k & 8) >> 1); return ((kk >> 3) * 4 + (c >> 5)) * 512 + ((kk & 7) * 32 + (c & 31)) * 2; }
__device__ __forceinline__ int v_rd_base(int lane) { return ((lane & 3) << 3) | (((lane >> 2) & 3) << 6) | (((lane >> 4) & 1) << 5) | (((lane >> 5) & 1) << 8); }
constexpr int v_rd_off(int d0, int ks, int half) { return d0 * 512 + ks * 4096 + half * 2048; }
template <int OFF> __device__ __forceinline__ s16x4 tr_read(int vb) {
    s16x4 r; asm volatile("ds_read_b64_tr_b16 %0, %1 offset:%2" : "=&v"(r) : "v"(vb), "i"(OFF) : "memory"); return r;
}
template <int I> __device__ __forceinline__ void exp2pair(f32x16& x0, f32x16& x1, float mref) {
    if constexpr (I < 8) { x0[2 * I] = __builtin_amdgcn_exp2f(x0[2 * I] - mref); x0[2 * I + 1] = __builtin_amdgcn_exp2f(x0[2 * I + 1] - mref); }
    else { x1[2 * (I - 8)] = __builtin_amdgcn_exp2f(x1[2 * (I - 8)] - mref); x1[2 * (I - 8) + 1] = __builtin_amdgcn_exp2f(x1[2 * (I - 8) + 1] - mref); }
}
template <int D0> __device__ __forceinline__ void v_read_group(s16x4 (&vr)[8], int vb) {
    vr[0] = tr_read<v_rd_off(D0, 0, 0)>(vb); vr[1] = tr_read<v_rd_off(D0, 0, 1)>(vb); vr[2] = tr_read<v_rd_off(D0, 1, 0)>(vb); vr[3] = tr_read<v_rd_off(D0, 1, 1)>(vb);
    vr[4] = tr_read<v_rd_off(D0, 2, 0)>(vb); vr[5] = tr_read<v_rd_off(D0, 2, 1)>(vb); vr[6] = tr_read<v_rd_off(D0, 3, 0)>(vb); vr[7] = tr_read<v_rd_off(D0, 3, 1)>(vb);
}
template <int D0, bool EXPS> __device__ __forceinline__ void pv_group(f32x16& od, const s16x4 (&vr)[8], bf16x8 pa0, bf16x8 pa1, bf16x8 pa2, bf16x8 pa3, f32x16& x0, f32x16& x1, float mref) {
#define FA_PK(L, H) (bf16x8){L[0], L[1], L[2], L[3], H[0], H[1], H[2], H[3]}
    od = __builtin_amdgcn_mfma_f32_32x32x16_bf16(pa0, FA_PK(vr[0], vr[1]), od, 0, 0, 0); if constexpr (EXPS) { exp2pair<D0 * 4 + 0>(x0, x1, mref); FA_SBAR(); }
    od = __builtin_amdgcn_mfma_f32_32x32x16_bf16(pa1, FA_PK(vr[2], vr[3]), od, 0, 0, 0); if constexpr (EXPS) { exp2pair<D0 * 4 + 1>(x0, x1, mref); FA_SBAR(); }
    od = __builtin_amdgcn_mfma_f32_32x32x16_bf16(pa2, FA_PK(vr[4], vr[5]), od, 0, 0, 0); if constexpr (EXPS) { exp2pair<D0 * 4 + 2>(x0, x1, mref); FA_SBAR(); }
    od = __builtin_amdgcn_mfma_f32_32x32x16_bf16(pa3, FA_PK(vr[6], vr[7]), od, 0, 0, 0); if constexpr (EXPS) { exp2pair<D0 * 4 + 3>(x0, x1, mref); FA_SBAR(); }
#undef FA_PK
}
#define FA_WAITL() do { asm volatile("s_waitcnt lgkmcnt(0)" ::: "memory"); FA_SBAR(); } while (0)
template <bool EXPS> __device__ __forceinline__ void pv_pipe(f32x16* o, s16x4 (&va)[8], s16x4 (&vq)[8], int vb, bf16x8 pa0, bf16x8 pa1, bf16x8 pa2, bf16x8 pa3, f32x16& x0, f32x16& x1, float mref) {
    FA_WAITL(); v_read_group<1>(vq, vb); FA_SBAR(); pv_group<0, EXPS>(o[0], va, pa0, pa1, pa2, pa3, x0, x1, mref);
    FA_WAITL(); v_read_group<2>(va, vb); FA_SBAR(); pv_group<1, EXPS>(o[1], vq, pa0, pa1, pa2, pa3, x0, x1, mref);
    FA_WAITL(); v_read_group<3>(vq, vb); FA_SBAR(); pv_group<2, EXPS>(o[2], va, pa0, pa1, pa2, pa3, x0, x1, mref);
    FA_WAITL(); pv_group<3, EXPS>(o[3], vq, pa0, pa1, pa2, pa3, x0, x1, mref);
}

__device__ __forceinline__ void attn_unit(int bh, int qb, const bf16_t* __restrict__ Q, const bf16_t* __restrict__ Kf, const bf16_t* __restrict__ V,
                                          bf16_t* __restrict__ O, const f32x2* __restrict__ rope, const unsigned* __restrict__ ctl, LAS unsigned char* lds) {
    int tid_ = threadIdx.x; asm volatile("" : "+v"(tid_));
    const int tid = tid_, wid = __builtin_amdgcn_readfirstlane(tid >> 6), lane = tid & 63, r32 = lane & 31, hi = lane >> 5;
    LAS unsigned char* V_lds = lds + OFF_V; LAS unsigned char* K_lds = lds + OFF_K;
    LAS float* wsf = (LAS float*)(lds + OFF_WS) + wid * 64; LAS float* li_l = wsf;
    const int q0 = qb * 256, b = bh >> 3, h = bh & 7;
    const bf16_t* Kh = Kf + (size_t)bh * SEQ * DQK; const bf16_t* Vh = V + (size_t)bh * SEQ * DV;
    unsigned ksrc[3], vsrc[2];
#pragma unroll
    for (int i = 0; i < 3; ++i) { const int q = (wid * 3 + i) * 64 + lane, row = q / 24, chp = q - row * 24, ch = chp ^ ((row >> 1) & 7); ksrc[i] = (unsigned)(row * DQK + ch * 8) * 2u; }
#pragma unroll
    for (int i = 0; i < 2; ++i) { const int q = (wid * 2 + i) * 64 + lane, c8 = q & 3, kklo = (q >> 2) & 7, chi = (q >> 5) & 3, kkhi = q >> 7, kk = kkhi * 8 + kklo;
        const int k = (kk & ~0xC) | ((kk & 4) << 1) | ((kk & 8) >> 1), c = chi * 32 + c8 * 8; vsrc[i] = (unsigned)(k * DV + c) * 2u; }
#define FA_DMA_K(t, slot) do { const char* kb_ = (const char*)Kh + (size_t)(t) * (KVBLK * DQK * 2); _Pragma("unroll") for (int i_ = 0; i_ < 3; ++i_) \
        __builtin_amdgcn_global_load_lds((const unsigned*)(kb_ + ksrc[i_]), (LAS unsigned*)(K_lds + (slot) * SHM_K + (wid * 3 + i_) * 1024), 16, 0, 0); } while (0)
#define FA_DMA_V(t, soff) do { const char* vb_ = (const char*)Vh + (size_t)(t) * (KVBLK * DV * 2); _Pragma("unroll") for (int i_ = 0; i_ < 2; ++i_) \
        __builtin_amdgcn_global_load_lds((const unsigned*)(vb_ + vsrc[i_]), (LAS unsigned*)(V_lds + (soff) + (wid * 2 + i_) * 1024), 16, 0, 0); } while (0)
#define FA_DRAIN_BAR() do { asm volatile("s_waitcnt vmcnt(0)" ::: "memory"); __syncthreads(); } while (0)
    unsigned long long lk_u0 = 0; if (LEAK_ID == 4) lk_u0 = __builtin_amdgcn_s_memrealtime();
    FA_DMA_K(0, 0); FA_DMA_V(0, 0);
    float l_reg = 0.f; f32x16 o[4] = {}; bf16x8 qr[12]; float qn2 = 0.f;
    {   const int l = q0 + wid * QBLK + r32;
        const bf16_t* Qw = Q + ((size_t)bh * SEQ + l) * DQK + hi * 8;
#pragma unroll
        for (int d0 = 0; d0 < 8; ++d0) { const u32x4 w = *(const u32x4*)(Qw + d0 * 16); float f[8]; unpack8(w, f);
#pragma unroll
            for (int j = 0; j < 8; ++j) qn2 += f[j] * f[j];
            qr[d0] = __builtin_bit_cast(bf16x8, w); }
#pragma unroll
        for (int d0 = 8; d0 < 12; ++d0) { float f[8]; unpack8(*(const u32x4*)(Qw + d0 * 16), f);
            const f32x4* cs = (const f32x4*)(rope + l * 32 + 8 * (d0 - 8) + 4 * hi); const f32x4 c0 = cs[0], c1 = cs[1];
            float g[8];
            g[0] = f[0] * c0.x - f[1] * c0.y; g[1] = f[0] * c0.y + f[1] * c0.x; g[2] = f[2] * c0.z - f[3] * c0.w; g[3] = f[2] * c0.w + f[3] * c0.z;
            g[4] = f[4] * c1.x - f[5] * c1.y; g[5] = f[4] * c1.y + f[5] * c1.x; g[6] = f[6] * c1.z - f[7] * c1.w; g[7] = f[6] * c1.w + f[7] * c1.z;
            const u32x4 w = pack8(g); float r[8]; unpack8(w, r);
#pragma unroll
            for (int j = 0; j < 8; ++j) qn2 += r[j] * r[j];
            qr[d0] = __builtin_bit_cast(bf16x8, w); }
    }
    float mref;
    {   auto rr = __builtin_amdgcn_permlane32_swap(__float_as_uint(qn2), __float_as_uint(qn2), false, false);
        qn2 = __uint_as_float(rr[0]) + __uint_as_float(rr[1]);
        float k2 = __uint_as_float(ctl[CW_KRMAX + b]);
#pragma unroll
        for (int j = 0; j < 4; ++j) k2 += __uint_as_float(ctl[CW_KMAX + bh * 4 + j]);
        mref = sqrtf(qn2 * k2) * 1.004f + 0.01f; }
    const int vb0 = (int)(unsigned)(uintptr_t)V_lds + v_rd_base(lane);
    int kb[4];
#pragma unroll
    for (int j = 0; j < 4; ++j) kb[j] = FA_KSWZ(r32, (j * 16 + hi * 8) * 2);
    f32x16 pA0, pA1, pB0, pB1; bf16x8 pa0, pa1, pa2, pa3; constexpr int NT = SEQ / KVBLK;
    int vprev = 0, vcur = SHM_V, vnext = 2 * SHM_V;
#define FA_ROT() do { const int t_ = vprev; vprev = vcur; vcur = vnext; vnext = t_; } while (0)
    FA_DRAIN_BAR();
    FA_DMA_K(1, 1); FA_DMA_V(1, SHM_V);
    s16x4 va[8], vq[8]; unsigned long long lk_acc = 0, lk_t = 0; (void)lk_t;
#define LK_BEG(id) do { if (LEAK_ID == (id)) lk_t = __builtin_amdgcn_s_memrealtime(); } while (0)
#define LK_END(id) do { if (LEAK_ID == (id)) lk_acc += __builtin_amdgcn_s_memrealtime() - lk_t; } while (0)
    qkt(pA0, pA1, K_lds, kb, qr);
#pragma unroll
    for (int r = 0; r < 16; ++r) { pA0[r] = __builtin_amdgcn_exp2f(pA0[r] - mref); pA1[r] = __builtin_amdgcn_exp2f(pA1[r] - mref); }
    FA_DRAIN_BAR();
    LK_BEG(5);
#pragma unroll 1
    for (int t = 1; t + 1 < NT; t += 2) {
        FA_DMA_K(t + 1, 0); FA_DMA_V(t + 1, vnext);
        LK_BEG(2); FA_SBAR(); v_read_group<0>(va, vb0 + vprev); FA_SBAR();
        qkt(pB0, pB1, K_lds + SHM_K, kb, qr);
        sumpack(pA0, pA1, l_reg, pa0, pa1, pa2, pa3); FA_SBAR(); LK_END(2);
        LK_BEG(3); pv_pipe<true>(o, va, vq, vb0 + vprev, pa0, pa1, pa2, pa3, pB0, pB1, mref); LK_END(3);
        LK_BEG(1); FA_DRAIN_BAR(); LK_END(1); FA_ROT();
        if (t + 2 < NT) { FA_DMA_K(t + 2, 1); FA_DMA_V(t + 2, vnext); }
        LK_BEG(2); FA_SBAR(); v_read_group<0>(va, vb0 + vprev); FA_SBAR();
        qkt(pA0, pA1, K_lds, kb, qr);
        sumpack(pB0, pB1, l_reg, pa0, pa1, pa2, pa3); FA_SBAR(); LK_END(2);
        LK_BEG(3); pv_pipe<true>(o, va, vq, vb0 + vprev, pa0, pa1, pa2, pa3, pA0, pA1, mref); LK_END(3);
        LK_BEG(1); FA_DRAIN_BAR(); LK_END(1); FA_ROT();
    }
    LK_END(5);
    FA_SBAR(); v_read_group<0>(va, vb0 + vprev); FA_SBAR();
    qkt(pB0, pB1, K_lds + SHM_K, kb, qr);
    sumpack(pA0, pA1, l_reg, pa0, pa1, pa2, pa3); FA_SBAR();
    pv_pipe<true>(o, va, vq, vb0 + vprev, pa0, pa1, pa2, pa3, pB0, pB1, mref);
    sumpack(pB0, pB1, l_reg, pa0, pa1, pa2, pa3); FA_SBAR();
    v_read_group<0>(va, vb0 + vcur); FA_SBAR();
    pv_pipe<false>(o, va, vq, vb0 + vcur, pa0, pa1, pa2, pa3, pB0, pB1, mref);
    { auto rr = __builtin_amdgcn_permlane32_swap(__float_as_uint(l_reg), __float_as_uint(l_reg), false, false); l_reg = __uint_as_float(rr[0]) + __uint_as_float(rr[1]); }
    if (hi == 0) li_l[r32] = l_reg;
    asm volatile("s_waitcnt lgkmcnt(0)" ::: "memory");
    float rli[16];
#pragma unroll
    for (int r = 0; r < 16; ++r) rli[r] = __builtin_amdgcn_rcpf(li_l[crow(r, hi)]);
    bf16_t* Ow = O + (size_t)(b * SEQ + q0 + wid * QBLK) * D + h * DV;
#pragma unroll
    for (int r = 0; r < 16; ++r) { const int orow = crow(r, hi);
#pragma unroll
        for (int d0 = 0; d0 < 4; ++d0) Ow[(size_t)orow * D + d0 * 32 + r32] = (bf16_t)f2bf(o[d0][r] * rli[r]); }
    if (LEAK_ID == 4) { asm volatile("s_waitcnt vmcnt(0)" ::: "memory"); lk_acc = __builtin_amdgcn_s_memrealtime() - lk_u0; }
    if (LEAK_ID != 0 && blockIdx.x == 0 && wid == 0) { const unsigned long long t0_ = __builtin_amdgcn_s_memrealtime(); while (__builtin_amdgcn_s_memrealtime() - t0_ < lk_acc) __builtin_amdgcn_s_sleep(8); }
    __syncthreads();
#undef FA_DMA_K
#undef FA_DMA_V
#undef FA_DRAIN_BAR
#undef FA_ROT
}
}

__device__ __forceinline__ void fast_attn_phase(Frame& F, LAS unsigned char* ldsL) {
    const bf16_t* Q = (const bf16_t*)(F.ws + WS_Q); const bf16_t* Kf = (const bf16_t*)(F.ws + WS_K); const bf16_t* V = (const bf16_t*)(F.ws + WS_V); bf16_t* O = (bf16_t*)(F.ws + WS_O);
    const f32x2* rope = (const f32x2*)(F.ws + WS_ROPE); const unsigned* ctl = (const unsigned*)(F.ws + WS_CTL);
    if (F.G == 256) { for (int i = 0; i < 2; ++i) fa::attn_unit((F.bid & 7) + 8 * i, F.bid >> 3, Q, Kf, V, O, rope, ctl, ldsL); }
    else { for (int u = F.bid; u < 512; u += F.G) fa::attn_unit(u >> 5, u & 31, Q, Kf, V, O, rope, ctl, ldsL); }
}

__device__ __forceinline__ void route_phase(Frame& F) {
    const float* X = F.out; const float* gn = F.in[I_NFFN] + 1024; const float* mod = (const float*)(F.ws + WS_MOD) + (size_t)1 * 2 * 6144;
    bf16_t* H = (bf16_t*)(F.ws + WS_H); const float* wr = F.in[I_ROUTER];
    unsigned* cnt = (unsigned*)(F.ws + WS_CTL) + CW_CNT; int* list = (int*)(F.ws + WS_LIST); int* tokinfo = (int*)(F.ws + WS_TOKINFO);
    int* le0 = (int*)F.lds; int* le1 = le0 + 64; float* lg0 = (float*)(le1 + 64); float* lg1 = lg0 + 64;
    const int lane = F.lane;
    f32x4 w0[4][4], w1[4][4];
#pragma unroll
    for (int j = 0; j < 4; ++j)
#pragma unroll
        for (int q = 0; q < 4; ++q) { const int k = 4 * lane + 256 * j + q; w0[j][q] = *(const f32x4*)(wr + (size_t)k * 8); w1[j][q] = *(const f32x4*)(wr + (size_t)k * 8 + 4); }
    for (int chunk = F.bid; chunk < T / 64; chunk += F.G) {
        const int row0 = chunk * 64;
        f32x4 cur[4], nxt[4];
        { const f32x4* xr = (const f32x4*)(X + (size_t)(row0 + F.wave * 8) * D) + lane;
#pragma unroll
          for (int j = 0; j < 4; ++j) cur[j] = xr[64 * j]; }
#pragma unroll
        for (int rr = 0; rr < 8; ++rr) {
            const int lr = F.wave * 8 + rr, m = row0 + lr, b = m >> 13;
            if (rr < 7) { const f32x4* xr = (const f32x4*)(X + (size_t)(m + 1) * D) + lane;
#pragma unroll
                for (int j = 0; j < 4; ++j) nxt[j] = xr[64 * j]; }
            float ss = 0.f;
#pragma unroll
            for (int j = 0; j < 4; ++j) ss += (cur[j].x * cur[j].x + cur[j].y * cur[j].y) + (cur[j].z * cur[j].z + cur[j].w * cur[j].w);
            const float rstd = rsqrtf(wave_sum(ss) * (1.0f / D) + RMS_EPS);
            const float* shp = mod + b * 6144 + 3 * 1024; const float* scp = mod + b * 6144 + 4 * 1024;
            u32x2* o8 = (u32x2*)(H + (size_t)m * D) + lane;
            float lg[8];
#pragma unroll
            for (int e = 0; e < 8; ++e) lg[e] = 0.f;
#pragma unroll
            for (int j = 0; j < 4; ++j) {
                const f32x4 g4 = ((const f32x4*)gn)[lane + 64 * j], s4 = ((const f32x4*)shp)[lane + 64 * j], c4 = ((const f32x4*)scp)[lane + 64 * j];
                const float hx[4] = {cur[j].x * rstd * g4.x * (1.0f + c4.x) + s4.x, cur[j].y * rstd * g4.y * (1.0f + c4.y) + s4.y,
                                     cur[j].z * rstd * g4.z * (1.0f + c4.z) + s4.z, cur[j].w * rstd * g4.w * (1.0f + c4.w) + s4.w};
                u32x2 w; w.x = pk2(hx[0], hx[1]); w.y = pk2(hx[2], hx[3]); o8[64 * j] = w;
#pragma unroll
                for (int q = 0; q < 4; ++q) {
                    lg[0] += hx[q] * w0[j][q].x; lg[1] += hx[q] * w0[j][q].y; lg[2] += hx[q] * w0[j][q].z; lg[3] += hx[q] * w0[j][q].w;
                    lg[4] += hx[q] * w1[j][q].x; lg[5] += hx[q] * w1[j][q].y; lg[6] += hx[q] * w1[j][q].z; lg[7] += hx[q] * w1[j][q].w; } }
#pragma unroll
            for (int e = 0; e < 8; ++e) lg[e] = wave_sum(lg[e]);
            int e0 = 0; float v0 = lg[0];
#pragma unroll
            for (int e = 1; e < 8; ++e) if (lg[e] > v0) { v0 = lg[e]; e0 = e; }
            int e1 = -1; float v1 = -3.0e38f;
#pragma unroll
            for (int e = 0; e < 8; ++e) if (e != e0 && lg[e] > v1) { v1 = lg[e]; e1 = e; }
            const float ex = __expf(v1 - v0), g0 = 1.0f / (1.0f + ex), g1 = ex / (1.0f + ex);
            if (lane == 0) { le0[lr] = e0; le1[lr] = e1; lg0[lr] = g0; lg1[lr] = g1; }
#pragma unroll
            for (int j = 0; j < 4; ++j) cur[j] = nxt[j];
        }
        __syncthreads();
        if (F.wave == 0) {
            const int e0 = le0[lane], e1 = le1[lane];
            const unsigned long long lt = (1ull << lane) - 1ull;
            unsigned long long m0[8], m1[8]; unsigned mycnt = 0;
#pragma unroll
            for (int e = 0; e < 8; ++e) { m0[e] = __ballot(e0 == e); m1[e] = __ballot(e1 == e); const unsigned c = (unsigned)(__popcll(m0[e]) + __popcll(m1[e])); if (lane == e) mycnt = c; }
            unsigned base = 0; if (lane < 8) base = atomicAdd(cnt + lane, mycnt);
            int p0 = 0, p1 = 0;
#pragma unroll
            for (int e = 0; e < 8; ++e) { const unsigned be = (unsigned)__shfl((int)base, e);
                if (e0 == e) p0 = (int)be + __popcll(m0[e] & lt);
                if (e1 == e) p1 = (int)be + __popcll(m0[e]) + __popcll(m1[e] & lt); }
            const int tok = row0 + lane;
            list[e0 * T + p0] = tok; list[e1 * T + p1] = tok;
            int* ti = tokinfo + (size_t)tok * 8;
            ti[0] = e0; ti[1] = p0; ti[2] = e1; ti[3] = p1; ((float*)ti)[4] = lg0[lane]; ((float*)ti)[5] = lg1[lane];
        }
        __syncthreads();
    }
}
struct MoEMeta { int rb[9]; int tiles[8]; };
__device__ __forceinline__ void moe_meta(Frame& F, MoEMeta& mm) {
    const unsigned* cnt = (const unsigned*)(F.ws + WS_CTL) + CW_CNT; int acc = 0;
#pragma unroll
    for (int e = 0; e < 8; ++e) { const int c = (int)__builtin_amdgcn_readfirstlane(__hip_atomic_load(cnt + e, __ATOMIC_RELAXED, __HIP_MEMORY_SCOPE_AGENT)); mm.rb[e] = acc; mm.tiles[e] = (c + 255) >> 8; acc += mm.tiles[e] * 256; }
    mm.rb[8] = acc;
}
__device__ __forceinline__ void gather_phase(Frame& F) {
    MoEMeta mm; moe_meta(F, mm);
    const unsigned* cnt = (const unsigned*)(F.ws + WS_CTL) + CW_CNT; const int* list = (const int*)(F.ws + WS_LIST);
    const bf16_t* H = (const bf16_t*)(F.ws + WS_H); bf16_t* XG = (bf16_t*)(F.ws + WS_XG);
    const int gw = F.bid * NWAVES + F.wave, NGW = F.G * NWAVES, lane = F.lane;
#pragma unroll
    for (int e = 0; e < 8; ++e) { const int c = (int)__hip_atomic_load(cnt + e, __ATOMIC_RELAXED, __HIP_MEMORY_SCOPE_AGENT);
        for (int p = gw; p < c; p += NGW) { const int tok = list[e * T + p];
            const u32x4* s = (const u32x4*)(H + (size_t)tok * D) + lane; u32x4* d = (u32x4*)(XG + (size_t)(mm.rb[e] + p) * D) + lane;
            d[0] = s[0]; d[64] = s[64]; } }
}
__device__ __forceinline__ void final_phase(Frame& F) {
    MoEMeta mm; moe_meta(F, mm);
    const int* tokinfo = (const int*)(F.ws + WS_TOKINFO); const bf16_t* YS = (const bf16_t*)(F.ws + WS_XG);
    const float* mod = (const float*)(F.ws + WS_MOD) + (size_t)1 * 2 * 6144; const float* fg = F.in[I_FING];
    const int gw = F.bid * NWAVES + F.wave, NGW = F.G * NWAVES, lane = F.lane;
    for (int m = gw; m < T; m += NGW) {
        const int* ti = tokinfo + (size_t)m * 8; const int e0 = ti[0], p0 = ti[1], e1 = ti[2], p1 = ti[3]; const float g0 = ((const float*)ti)[4], g1 = ((const float*)ti)[5];
        int r0 = 0, r1 = 0;
#pragma unroll
        for (int e = 0; e < 8; ++e) { if (e == e0) r0 = mm.rb[e] + p0; if (e == e1) r1 = mm.rb[e] + p1; }
        const int b = m >> 13; const float* gf = mod + b * 6144 + 5 * 1024;
        float* xr = F.out + (size_t)m * D; f32x4 v[4]; float s = 0.f;
#pragma unroll
        for (int j = 0; j < 4; ++j) { const int c = 4 * lane + 256 * j;
            const f32x4 x = *(const f32x4*)(xr + c), gg = *(const f32x4*)(gf + c);
            const u32x2 y0 = *(const u32x2*)(YS + (size_t)r0 * D + c), y1 = *(const u32x2*)(YS + (size_t)r1 * D + c);
            f32x4 y; y.x = g0 * __uint_as_float(y0.x << 16) + g1 * __uint_as_float(y1.x << 16); y.y = g0 * __uint_as_float(y0.x & 0xffff0000u) + g1 * __uint_as_float(y1.x & 0xffff0000u);
            y.z = g0 * __uint_as_float(y0.y << 16) + g1 * __uint_as_float(y1.y << 16); y.w = g0 * __uint_as_float(y0.y & 0xffff0000u) + g1 * __uint_as_float(y1.y & 0xffff0000u);
            v[j] = (f32x4){x.x + gg.x * y.x, x.y + gg.y * y.y, x.z + gg.z * y.z, x.w + gg.w * y.w};
            s += (v[j].x * v[j].x + v[j].y * v[j].y) + (v[j].z * v[j].z + v[j].w * v[j].w); }
        const float rstd = rsqrtf(wave_sum(s) * (1.0f / D) + RMS_EPS);
#pragma unroll
        for (int j = 0; j < 4; ++j) { const int c = 4 * lane + 256 * j; const f32x4 g4 = *(const f32x4*)(fg + c);
            *(f32x4*)(xr + c) = (f32x4){v[j].x * rstd * g4.x, v[j].y * rstd * g4.y, v[j].z * rstd * g4.z, v[j].w * rstd * g4.w}; }
    }
}


#define XB_TMO      128
#define XB_XCNT(j)  (256  + 64 * (j))
#define XB_XSUB(j)  (1280 + 64 * (j))
#define XB_XGEN(j)  (2304 + 64 * (j))
#define XB_TOP      3328
#define XB_TOPGEN   3392
#define XCD_BAR_WORDS 3456
#define XB_SPIN_CAP (1u << 22)
__device__ __forceinline__ unsigned xb_ld(unsigned* p)              { return __hip_atomic_load(p, __ATOMIC_RELAXED, __HIP_MEMORY_SCOPE_AGENT); }
__device__ __forceinline__ unsigned xb_add(unsigned* p, unsigned v) { return __hip_atomic_fetch_add(p, v, __ATOMIC_RELAXED, __HIP_MEMORY_SCOPE_AGENT); }
__device__ __forceinline__ unsigned xb_xcc_id() { return (unsigned)__builtin_amdgcn_s_getreg((3 << 11) | 20) & 0xFu; }
#define XB_SPIN(cond, bar) do { unsigned _sp = 0; while (cond) { __builtin_amdgcn_s_sleep(1); \
    if ((++_sp & 255u) == 0u) { if (xb_ld(&(bar)[XB_TMO])) break; if (_sp > XB_SPIN_CAP) { atomicAdd(&(bar)[XB_TMO], 1u); break; } } } } while (0)
struct XcdBarrier { unsigned* bar; unsigned x; volatile LAS unsigned* st; };
__device__ __forceinline__ XcdBarrier xcd_barrier_post(unsigned* bar, volatile LAS unsigned* st) {
    XcdBarrier b; b.bar = bar; b.x = xb_xcc_id(); b.st = st;
    if (threadIdx.x == 0) (void)xb_add(&bar[XB_XCNT(b.x)], 1u);
    return b;
}
__device__ __forceinline__ void xcd_barrier_complete(unsigned* bar, unsigned x, unsigned& nloc, unsigned& nx) {
    const unsigned G = gridDim.x * gridDim.y * gridDim.z;
    unsigned sum, cnt, mine, sp = 0u;
    for (;;) {
        sum = 0u; cnt = 0u; mine = 0u;
#pragma unroll
        for (unsigned j = 0; j < 16; ++j) { const unsigned c = xb_ld(&bar[XB_XCNT(j)]); sum += c; cnt += (c > 0u) ? 1u : 0u; mine = (j == x) ? c : mine; }
        if (sum == G) break;
        __builtin_amdgcn_s_sleep(1);
        if ((++sp & 255u) == 0u) { if (xb_ld(&bar[XB_TMO])) break; if (sp > XB_SPIN_CAP) { atomicAdd(&bar[XB_TMO], 1u); break; } }
    }
    nloc = mine > 0u ? mine : 1u; nx = cnt > 0u ? cnt : 1u;
}
__device__ __forceinline__ void xcd_barrier(const XcdBarrier& b) {
    asm volatile("s_waitcnt vmcnt(0)" ::: "memory");
    __syncthreads();
    if (threadIdx.x == 0) {
        unsigned* bar = b.bar;
        __builtin_amdgcn_s_waitcnt(0);
        unsigned nloc = b.st[0], nx = b.st[1];
        if (nloc == 0u) { xcd_barrier_complete(bar, b.x, nloc, nx); b.st[0] = nloc; b.st[1] = nx; }
        const unsigned old = xb_add(&bar[XB_XSUB(b.x)], 1u);
        const unsigned gen = old / nloc;
        if (old + 1u == (gen + 1u) * nloc) {
            __builtin_amdgcn_fence(__ATOMIC_RELEASE, "agent");
            asm volatile("s_waitcnt vmcnt(0)" ::: "memory");
            const unsigned og = xb_add(&bar[XB_TOP], 1u);
            const unsigned tg = og / nx;
            if (og + 1u == (tg + 1u) * nx) xb_add(&bar[XB_TOPGEN], 1u);
            else XB_SPIN(xb_ld(&bar[XB_TOPGEN]) == tg, bar);
            __builtin_amdgcn_fence(__ATOMIC_ACQUIRE, "agent");
            xb_add(&bar[XB_XGEN(b.x)], 1u);
            asm volatile("s_waitcnt vmcnt(0)" ::: "memory");
        } else {
            XB_SPIN(xb_ld(&bar[XB_XGEN(b.x)]) == gen, bar);
            __builtin_amdgcn_fence(__ATOMIC_ACQUIRE, "agent");
            asm volatile("s_waitcnt vmcnt(0)" ::: "memory");
        }
    }
    __syncthreads();
}

constexpr int NPH = 22;
constexpr int LDS_BYTES = 147456;

__global__ void __launch_bounds__(NTHREADS, 2) mega(Args args) {
    extern __shared__ __attribute__((aligned(16))) unsigned char lds[];
    Frame F; F.lds = lds; F.tid = threadIdx.x; F.lane = F.tid & 63; F.wave = __builtin_amdgcn_readfirstlane(F.tid >> 6);
    F.G = gridDim.x; F.bid = blockIdx.x; F.out = args.out; F.ws = args.ws; F.in = args.in;
    unsigned char* ws = args.ws;
    const int lo = args.lo, hi = args.hi;
#if MK_ONE_LAUNCH
    cg::grid_group grid = cg::this_grid();
    volatile LAS unsigned* MISC = (volatile LAS unsigned*)((LAS unsigned char*)lds + LDS_BYTES - 128);
    if (threadIdx.x < 16) MISC[threadIdx.x] = 0u;
    __syncthreads();
    XcdBarrier xbar = xcd_barrier_post((unsigned*)(ws + WS_CTL) + CW_BAR, MISC + 8);
    if (threadIdx.x == 0) { const unsigned x_ = xb_xcc_id(); MISC[0] = x_; MISC[1] = xb_add((unsigned*)(ws + WS_CTL) + CW_XRANK + x_, 1u); }
    __syncthreads();
    const unsigned my_xcc = MISC[0], my_rank = MISC[1];
#define GRID_BAR(k) do { if ((k) == 0) { grid.sync(); \
        { unsigned cnt_[8], pre_ = 0, ok_ = 1, mypre_ = 0; \
          _Pragma("unroll") for (int j_ = 0; j_ < 8; ++j_) { cnt_[j_] = xb_ld((unsigned*)(ws + WS_CTL) + CW_XRANK + j_); if ((unsigned)j_ == my_xcc) mypre_ = pre_; pre_ += cnt_[j_]; ok_ &= (cnt_[j_] * 8u == (unsigned)F.G) ? 1u : 0u; } \
          if (pre_ == (unsigned)F.G && my_xcc < 8u) F.bid = ok_ ? (int)(my_xcc + 8u * my_rank) : (int)(mypre_ + my_rank); } \
        } else xcd_barrier(xbar); } while (0)
#else
#define GRID_BAR(k) do {} while (0)
#endif
#ifndef PHMASK
#define PHMASK 0x3fffff
#endif
#define IN(k) ((((PHMASK) >> (k)) & 1) && lo <= (k) && (k) < hi)
#define SEAM(k) do { if (IN(k) && IN((k) + 1)) GRID_BAR(k); } while (0)
    const float* mod = (const float*)(ws + WS_MOD);
    bf16_t* H = (bf16_t*)(ws + WS_H);

    LAS unsigned char* ldsL = (LAS unsigned char*)lds;
#if FAST_GEMM
#define GEMM_DENSE(A_, lda_, Bt_, K_, M_, N_, EpiT, E_) do { pg8::Gemm g_{A_, Bt_, lda_, K_}; pg8::StaticOrder S_; S_.init(M_, N_, F.G, F.bid); \
        pg8::gemm_phase<pg8::Epi8<EpiT>, pg8::StaticOrder, true>(ldsL, g_, S_, pg8::Epi8<EpiT>{E_}); } while (0)
#define GEMM_DENSE_DUAL(A_, lda_, Bt_, K_, M_, NH_, EpiT, E_) do { pg8::Gemm g_{A_, Bt_, lda_, K_}; pg8::StaticOrder S_; S_.init(M_, 2 * (NH_), F.G, F.bid); \
        pg8::gemm_phase<pg8::Epi8Dual<EpiT>, pg8::StaticOrder, true>(ldsL, g_, S_, pg8::Epi8Dual<EpiT>{E_}); } while (0)
#define GEMM_DIAG(A_, lda_, Bt_, K_, EpiT, E_) do { pg8::Gemm g_{A_, Bt_, lda_, K_}; pg8::DiagOrder S_{128, F.G, F.bid}; \
        pg8::gemm_phase<pg8::Epi8<EpiT>, pg8::DiagOrder, true>(ldsL, g_, S_, pg8::Epi8<EpiT>{E_}); } while (0)
#else
#define GEMM_DENSE(A_, lda_, Bt_, K_, M_, N_, EpiT, E_) naive_gemm<false>(F, A_, lda_, Bt_, K_, M_, N_, E_, BOffNone{})
#define GEMM_DENSE_DUAL(A_, lda_, Bt_, K_, M_, NH_, EpiT, E_) naive_gemm<true>(F, A_, lda_, Bt_, K_, M_, NH_, E_, BOffNone{})
#define GEMM_DIAG(A_, lda_, Bt_, K_, EpiT, E_) naive_gemm<false>(F, A_, lda_, Bt_, K_, 32768, 256, E_, BOffDiag{})
#endif
#define WSB(off) ((bf16_t*)(ws + (off)))
#define BGC(budget) do {} while (0)
    constexpr int BG_P2 = 0, BG_P4 = 0, BG_P5 = 0, BG_P6 = 0, BG_P12 = 0, BG_P14 = 0;
    unsigned long long lkp_acc = 0, lkp_t = 0; (void)lkp_t;
#define LKP_BEG(k) do { if (((LEAK_MASK >> (k)) & 1) || (LEAK_ID == 7 && (k) == 15)) lkp_t = __builtin_amdgcn_s_memrealtime(); } while (0)
#define LKP_END(k) do { if ((LEAK_MASK >> (k)) & 1) lkp_acc += __builtin_amdgcn_s_memrealtime() - lkp_t; } while (0)
    LKP_BEG(0);
    if (IN(0)) for (int rep_ = 0; rep_ < (DUP_PHASE == 0 ? 2 : 1); ++rep_) { p0_prologue(F); } SEAM(0); LKP_END(0);
    LKP_BEG(1);
    if (IN(1)) for (int rep_ = 0; rep_ < (DUP_PHASE == 1 ? 2 : 1); ++rep_) { norm_phase(F, F.in[I_X], F.in[I_NMIX], 0, 0); } SEAM(1); LKP_END(1);
    LKP_BEG(2);
    if (IN(2)) for (int rep_ = 0; rep_ < (DUP_PHASE == 2 ? 2 : 1); ++rep_) { EpiIn E{WSB(WS_UA), WSB(WS_VA), WSB(WS_AC)};
        GEMM_DENSE(H, D, WSB(WS_WIN), D, T, AB_IN, EpiIn, E);
        if (F.G == 256 && F.bid >= 128) BGC(BG_P2); } SEAM(2); LKP_END(2);
    LKP_BEG(3);
    if (IN(3)) for (int rep_ = 0; rep_ < (DUP_PHASE == 3 ? 2 : 1); ++rep_) { EpiS5A E{(float*)(ws + WS_SS)};
        GEMM_DIAG(WSB(WS_AC), 512, WSB(WS_GTA), 256, EpiS5A, E);
        if (F.G == 256) { if (F.bid >= 128) { for (int j = 0; j < 3; ++j) sgu_unit(F, (F.bid - 128) * 3 + j); } else sgu_unit(F, 384 + F.bid); }
        else { for (int u = F.bid; u < 512; u += F.G) sgu_unit(F, u); } } SEAM(3); LKP_END(3);
    LKP_BEG(4);
    if (IN(4)) for (int rep_ = 0; rep_ < (DUP_PHASE == 4 ? 2 : 1); ++rep_) { if (F.wave == 0 && F.bid < 128) { for (int id = F.bid; id < 128; id += F.G) scan_wave(F, id); } else BGC(BG_P4); } SEAM(4); LKP_END(4);
    LKP_BEG(5);
    if (IN(5)) for (int rep_ = 0; rep_ < (DUP_PHASE == 5 ? 2 : 1); ++rep_) { EpiS5C E{WSB(WS_AC), F.in[I_S5D], WSB(WS_YG)};
        GEMM_DIAG(WSB(WS_AC), 512, WSB(WS_BTC), 512, EpiS5C, E);
        if (F.G == 256 && F.bid >= 128) BGC(BG_P5); } SEAM(5); LKP_END(5);
    LKP_BEG(6);
    if (IN(6)) for (int rep_ = 0; rep_ < (DUP_PHASE == 6 ? 2 : 1); ++rep_) { EpiGlu E{WSB(WS_YG), WSB(WS_CAT)};
        GEMM_DENSE(WSB(WS_YG), 512, WSB(WS_WGLU), 512, T, 512, EpiGlu, E);
        if (F.G == 256 && F.bid >= 128) BGC(BG_P6); } SEAM(6); LKP_END(6);
    LKP_BEG(7);
    if (IN(7)) for (int rep_ = 0; rep_ < (DUP_PHASE == 7 ? 2 : 1); ++rep_) { EpiRes E{F.in[I_X], F.out, mod + 2 * 1024};
        GEMM_DENSE(WSB(WS_CAT), D, WSB(WS_WOUT), D, T, D, EpiRes, E); } SEAM(7); LKP_END(7);
    LKP_BEG(8);
    if (IN(8)) for (int rep_ = 0; rep_ < (DUP_PHASE == 8 ? 2 : 1); ++rep_) { norm_phase(F, F.out, F.in[I_NFFN], 0, 3); } SEAM(8); LKP_END(8);
    LKP_BEG(9);
    if (IN(9)) for (int rep_ = 0; rep_ < (DUP_PHASE == 9 ? 2 : 1); ++rep_) { EpiSwiglu E{WSB(WS_HF), D_FF};
        GEMM_DENSE_DUAL(H, D, WSB(WS_W13), D, T, D_FF, EpiSwiglu, E); } SEAM(9); LKP_END(9);
    LKP_BEG(10);
    if (IN(10)) for (int rep_ = 0; rep_ < (DUP_PHASE == 10 ? 2 : 1); ++rep_) { EpiRes E{F.out, F.out, mod + 5 * 1024};
        GEMM_DENSE(WSB(WS_HF), D_FF, WSB(WS_W2), D_FF, T, D, EpiRes, E); } SEAM(10); LKP_END(10);
    LKP_BEG(11);
    if (IN(11)) for (int rep_ = 0; rep_ < (DUP_PHASE == 11 ? 2 : 1); ++rep_) { norm_phase(F, F.out, F.in[I_NMIX] + 1024, 1, 0); } SEAM(11); LKP_END(11);
    LKP_BEG(12);
    if (IN(12)) for (int rep_ = 0; rep_ < (DUP_PHASE == 12 ? 2 : 1); ++rep_) { EpiZ E{(float*)(ws + WS_Z)};
        GEMM_DENSE(H, D, WSB(WS_WMIN), D, T, CINP, EpiZ, E);
        if (F.G == 256 && F.bid >= 192) BGC(BG_P12); } SEAM(12); LKP_END(12);
    LKP_BEG(13);
    if (IN(13)) for (int rep_ = 0; rep_ < (DUP_PHASE == 13 ? 2 : 1); ++rep_) { zsplit_phase(F); } SEAM(13); LKP_END(13);
    LKP_BEG(14);
    if (IN(14)) for (int rep_ = 0; rep_ < (DUP_PHASE == 14 ? 2 : 1); ++rep_) { EpiQ Eq{WSB(WS_Q)};
        GEMM_DENSE(WSB(WS_CQ), QL, WSB(WS_WUQ), QL, T, NH * DQK, EpiQ, Eq);
        EpiKV Ek{WSB(WS_K), WSB(WS_V)};
#if FAST_GEMM
        { pg8::Gemm g_{WSB(WS_CKV), WSB(WS_WUKV), KVL, KVL}; pg8::StaticOrder S_; S_.init(T, NH * 256, F.G, F.bid);
          pg8::gemm_phase<pg8::EpiKVMax, pg8::StaticOrder, true>(ldsL, g_, S_, pg8::EpiKVMax{WSB(WS_K), WSB(WS_V), (unsigned*)(ws + WS_CTL) + CW_KMAX}); (void)Ek; }
#else
        GEMM_DENSE(WSB(WS_CKV), KVL, WSB(WS_WUKV), KVL, T, NH * 256, EpiKV, Ek);
#endif
        if (F.G == 256 && F.bid >= 128) BGC(BG_P14); } SEAM(14); LKP_END(14);
#if FAST_ATTN
    LKP_BEG(15);
    unsigned long long ck_c0 = 0, ck_r0 = 0; if (LEAK_ID == 8) { ck_c0 = __builtin_readcyclecounter(); ck_r0 = __builtin_amdgcn_s_memrealtime(); }
    if (IN(15)) for (int rep_ = 0; rep_ < (DUP_PHASE == 15 ? 2 : 1); ++rep_) { fast_attn_phase(F, ldsL); }
    if (LEAK_ID == 7) { asm volatile("s_waitcnt vmcnt(0) lgkmcnt(0)" ::: "memory"); lkp_acc += __builtin_amdgcn_s_memrealtime() - lkp_t; }
    if (LEAK_ID == 8) { const unsigned long long dc_ = __builtin_readcyclecounter() - ck_c0, dr_ = __builtin_amdgcn_s_memrealtime() - ck_r0; lkp_acc += (dc_ * 1000ull) / (dr_ ? dr_ : 1ull); }
    { unsigned long long tb0_ = 0; if (LEAK_ID == 6) tb0_ = __builtin_amdgcn_s_memrealtime();
      SEAM(15); LKP_END(15);
      if (LEAK_ID == 6 && blockIdx.x == 0 && threadIdx.x == 0) { const unsigned long long d_ = __builtin_amdgcn_s_memrealtime() - tb0_, t0_ = __builtin_amdgcn_s_memrealtime(); while (__builtin_amdgcn_s_memrealtime() - t0_ < d_) __builtin_amdgcn_s_sleep(8); } }
#else
    LKP_BEG(15);
    if (IN(15)) for (int rep_ = 0; rep_ < (DUP_PHASE == 15 ? 2 : 1); ++rep_) { naive_attn_phase(F); } SEAM(15); LKP_END(15);
#endif
    LKP_BEG(16);
    if (IN(16)) for (int rep_ = 0; rep_ < (DUP_PHASE == 16 ? 2 : 1); ++rep_) { EpiRes E{F.out, F.out, mod + 2 * 6144 + 2 * 1024};
        GEMM_DENSE(WSB(WS_O), D, WSB(WS_WO), D, T, D, EpiRes, E); } SEAM(16); LKP_END(16);
    LKP_BEG(17);
    if (IN(17)) for (int rep_ = 0; rep_ < (DUP_PHASE == 17 ? 2 : 1); ++rep_) { route_phase(F); } SEAM(17); LKP_END(17);
    LKP_BEG(18);
    if (IN(18)) for (int rep_ = 0; rep_ < (DUP_PHASE == 18 ? 2 : 1); ++rep_) { gather_phase(F); } SEAM(18); LKP_END(18);
    LKP_BEG(19);
    unsigned long long ck2_c0 = 0, ck2_r0 = 0; if (LEAK_ID == 9) { ck2_c0 = __builtin_readcyclecounter(); ck2_r0 = __builtin_amdgcn_s_memrealtime(); }
    if (IN(19)) for (int rep_ = 0; rep_ < (DUP_PHASE == 19 ? 2 : 1); ++rep_) { MoEMeta mm; moe_meta(F, mm); EpiSwiglu E{WSB(WS_HM), D_FFE};
#if FAST_GEMM
        pg8::MoEOrder S_; { int acc_ = 0;
#pragma unroll
            for (int e = 0; e < 8; ++e) { S_.ub[e] = acc_; S_.tl[e] = mm.tiles[e]; S_.tb[e] = mm.rb[e] >> 8; acc_ += mm.tiles[e] * 28; }
            S_.ub[8] = acc_; S_.nwg = acc_; S_.nN = 28; S_.G = F.G; S_.c = F.bid; }
        pg8::Gemm g_{WSB(WS_XG), WSB(WS_MW13), D, D};
        pg8::gemm_phase<pg8::Epi8Dual<EpiSwiglu>, pg8::MoEOrder, true>(ldsL, g_, S_, pg8::Epi8Dual<EpiSwiglu>{E});
#else
        BOffMoE bo;
#pragma unroll
        for (int e = 0; e < 9; ++e) bo.rb[e] = mm.rb[e];
        bo.nper = 7168;
        naive_gemm<true>(F, WSB(WS_XG), D, WSB(WS_MW13), D, mm.rb[8], D_FFE, E, bo);
#endif
    }
    if (LEAK_ID == 9) { const unsigned long long dc_ = __builtin_readcyclecounter() - ck2_c0, dr_ = __builtin_amdgcn_s_memrealtime() - ck2_r0; lkp_acc += (dc_ * 1000ull) / (dr_ ? dr_ : 1ull); }
    SEAM(19); LKP_END(19);
    LKP_BEG(20);
    if (IN(20)) for (int rep_ = 0; rep_ < (DUP_PHASE == 20 ? 2 : 1); ++rep_) { MoEMeta mm; moe_meta(F, mm); EpiYS E{WSB(WS_XG)};
#if FAST_GEMM
        pg8::MoEOrder S_; { int acc_ = 0;
#pragma unroll
            for (int e = 0; e < 8; ++e) { S_.ub[e] = acc_; S_.tl[e] = mm.tiles[e]; S_.tb[e] = mm.rb[e] >> 8; acc_ += mm.tiles[e] * 4; }
            S_.ub[8] = acc_; S_.nwg = acc_; S_.nN = 4; S_.G = F.G; S_.c = F.bid; }
        pg8::Gemm g_{WSB(WS_HM), WSB(WS_MW2), D_FFE, D_FFE};
        pg8::gemm_phase<pg8::Epi8<EpiYS>, pg8::MoEOrder, true>(ldsL, g_, S_, pg8::Epi8<EpiYS>{E});
#else
        BOffMoE bo;
#pragma unroll
        for (int e = 0; e < 9; ++e) bo.rb[e] = mm.rb[e];
        bo.nper = 1024;
        naive_gemm<false>(F, WSB(WS_HM), D_FFE, WSB(WS_MW2), D_FFE, mm.rb[8], D, E, bo);
#endif
    } SEAM(20); LKP_END(20);
    LKP_BEG(21);
    if (IN(21)) for (int rep_ = 0; rep_ < (DUP_PHASE == 21 ? 2 : 1); ++rep_) { final_phase(F); }
    LKP_END(21);
    if ((LEAK_MASK != 0 || LEAK_ID == 7 || LEAK_ID == 8 || LEAK_ID == 9) && blockIdx.x == 0 && threadIdx.x == 0) { const unsigned long long t0_ = __builtin_amdgcn_s_memrealtime(); while (__builtin_amdgcn_s_memrealtime() - t0_ < lkp_acc) __builtin_amdgcn_s_sleep(8); }
}

extern "C" void kernel_launch(void* const* d_in, const int* in_sizes, int n_in, void* d_out, int out_size, void* d_ws, size_t ws_size, hipStream_t stream) {
    static int grid = 0;
    if (grid == 0) {
        if (n_in != 34 || out_size != T * D || ws_size < WS_END) { fprintf(stderr, "kernel_launch: unexpected shapes n_in %d out %d ws %zu (need %zu)\n", n_in, out_size, ws_size, (size_t)WS_END); grid = -1; return; }
        int dev = 0, cus = 0, per_cu = 0;
        hipGetDevice(&dev); hipDeviceGetAttribute(&cus, hipDeviceAttributeMultiprocessorCount, dev);
        if (hipFuncSetAttribute((const void*)mega, hipFuncAttributeMaxDynamicSharedMemorySize, LDS_BYTES) != hipSuccess) { fprintf(stderr, "hipFuncSetAttribute failed\n"); grid = -1; return; }
        if (hipOccupancyMaxActiveBlocksPerMultiprocessor(&per_cu, (const void*)mega, NTHREADS, LDS_BYTES) != hipSuccess || per_cu < 1) { fprintf(stderr, "occupancy query failed (%d)\n", per_cu); per_cu = 1; }
        (void)hipGetLastError();
        grid = cus * per_cu;
    }
    if (grid < 0) return;
    hipMemsetAsync((char*)d_ws + WS_CTL, 0, CTL_BYTES, stream);
    Args a{};
    for (int i = 0; i < 34; ++i) a.in[i] = (const float*)d_in[i];
    a.out = (float*)d_out; a.ws = (unsigned char*)d_ws;
#if MK_ONE_LAUNCH
    a.lo = 0; a.hi = NPH;
    void* kargs[] = {&a};
    hipError_t e = hipLaunchCooperativeKernel((const void*)mega, dim3(grid), dim3(NTHREADS), kargs, LDS_BYTES, stream);
    if (e != hipSuccess) fprintf(stderr, "cooperative launch failed: %s (grid %d)\n", hipGetErrorString(e), grid);
#else
    for (int ph = 0; ph < NPH; ++ph) { a.lo = ph; a.hi = ph + 1; hipLaunchKernelGGL(mega, dim3(grid), dim3(NTHREADS), LDS_BYTES, stream, a); }
#endif
}
```
